# Optimizing an MI355X kernel written in HIP

```python
import jax, jax.numpy as jnp
from jax import lax
import numpy as np

D_MODEL = 1024
BATCH = 8
SEQ = 8192
DEPTH = 2

CHUNK = 64
HEAD_DIM = 64
SGU_BLOCK = 128
A_GROUPS = 4
A_WIDTH = A_GROUPS * HEAD_DIM
B_HEADS = 6
B_WIDTH = B_HEADS * HEAD_DIM
DECAY_LORA = 64
AAA_LORA = 64
MV_LORA = 32
C_HEADS = 6
C_WIDTH = C_HEADS * HEAD_DIM
LEFT_CHUNKS = 8
BAND = (LEFT_CHUNKS + 1) * CHUNK
REL_CLIP = 256
MIX_WIDTH = A_WIDTH + B_WIDTH + C_WIDTH
A_COLS = 3 * A_WIDTH
B_SHIFT_COLS = 3 * B_WIDTH + DECAY_LORA + AAA_LORA
B_COLS = B_SHIFT_COLS + B_WIDTH
C_COLS = 4 * C_WIDTH
PROJ_COLS = A_COLS + B_COLS + C_COLS
DEEPNORM_ALPHA = (2 * DEPTH) ** 0.25
DEEPNORM_BETA = (8 * DEPTH) ** -0.25
LN_EPS = 1e-5
GN_EPS = 64e-5

kernel_name = 'hybrid_sgu_rwkv7_chunkattn_deepnorm'


def layer_norm(x, g, b, eps=LN_EPS):
    xf = x.astype(jnp.float32)
    mu = jnp.mean(xf, axis=-1, keepdims=True)
    var = jnp.mean(jnp.square(xf - mu), axis=-1, keepdims=True)
    return ((xf - mu) * lax.rsqrt(var + eps)).astype(x.dtype) * g + b


def token_shift(p):
    return jnp.pad(p, ((0, 0), (1, 0), (0, 0)))[:, :-1]


def spatial_gating(u, v, ln_g, ln_b, w_s, b_s):
    bsz, t, _ = u.shape
    nb = t // SGU_BLOCK
    v = layer_norm(v.reshape(bsz, t, A_GROUPS, HEAD_DIM), ln_g.reshape(A_GROUPS, HEAD_DIM), ln_b.reshape(A_GROUPS, HEAD_DIM))
    v = v.reshape(bsz, nb, SGU_BLOCK, A_GROUPS, HEAD_DIM)
    mask = jnp.tril(jnp.ones((SGU_BLOCK, SGU_BLOCK), dtype=bool))
    w = jnp.where(mask[None], w_s, jnp.zeros_like(w_s))
    s = jnp.einsum('gpq,bnqgc->bnpgc', w, v) + b_s.T[None, None, :, :, None]
    return u * s.reshape(bsz, t, A_WIDTH)


def rwkv7_time_mix(p, mu, w0, w2, a0, a2, k_k, k_a, r_k, lnx_g, lnx_b, v_first, vres):
    bsz, t, _ = p.shape
    xs = p + (token_shift(p) - p) * mu
    r, k, v, w_lo, a_lo = jnp.split(xs, [B_WIDTH, 2 * B_WIDTH, 3 * B_WIDTH, 3 * B_WIDTH + DECAY_LORA], axis=-1)
    v_raw = v
    w = -jax.nn.softplus(-(w0 + jnp.tanh(w_lo) @ w2)) - 0.5
    decay = jnp.exp(-jnp.exp(w.astype(jnp.float32)))
    if vres is not None:
        v0, v1, v2 = vres
        v = v + (v_first - v) * jax.nn.sigmoid(v0 + (v @ v1) @ v2)
    a = jax.nn.sigmoid(a0 + a_lo @ a2)
    heads = lambda z: z.reshape(bsz, t, B_HEADS, HEAD_DIM).astype(jnp.float32)
    kk = heads(k * k_k)
    kk = kk / jnp.maximum(jnp.sqrt(jnp.sum(kk * kk, axis=-1, keepdims=True)), 1e-12)
    k = k * (1 + (a - 1) * k_a)
    rh, kh, vh, ah, wh = heads(r), heads(k), heads(v), heads(a), heads(decay)
    a_vec = -kk
    b_vec = kk * ah

    def step(state, inp):
        r_t, w_t, k_t, v_t, a_t, b_t = inp
        sa = jnp.einsum('bhvk,bhk->bhv', state, a_t)
        state = state * w_t[:, :, None, :] + sa[..., None] * b_t[:, :, None, :] + v_t[..., None] * k_t[:, :, None, :]
        return state, jnp.einsum('bhvk,bhk->bhv', state, r_t)

    seq_in = tuple(jnp.moveaxis(z, 1, 0) for z in (rh, wh, kh, vh, a_vec, b_vec))
    s0 = jnp.zeros((bsz, B_HEADS, HEAD_DIM, HEAD_DIM), jnp.float32)
    _, y = lax.scan(step, s0, seq_in)
    y = jnp.moveaxis(y, 0, 1)
    y = layer_norm(y, lnx_g.reshape(B_HEADS, HEAD_DIM), lnx_b.reshape(B_HEADS, HEAD_DIM), eps=GN_EPS)
    y = y + jnp.sum(rh * kh * r_k, axis=-1, keepdims=True) * vh
    return y.reshape(bsz, t, B_WIDTH).astype(p.dtype), v_raw


def chunk_band_attention(q, k, v, rel_table):
    bsz, t, _ = q.shape
    nc = t // CHUNK
    pad = LEFT_CHUNKS * CHUNK
    q = q.reshape(bsz, t, C_HEADS, HEAD_DIM)
    k_pad = jnp.pad(k.reshape(bsz, t, C_HEADS, HEAD_DIM), ((0, 0), (pad, 0), (0, 0), (0, 0)))
    v_pad = jnp.pad(v.reshape(bsz, t, C_HEADS, HEAD_DIM), ((0, 0), (pad, 0), (0, 0), (0, 0)))
    dist = jnp.arange(CHUNK)[:, None] + pad - jnp.arange(BAND)[None, :]
    idx = jnp.clip(dist, -REL_CLIP, REL_CLIP) + REL_CLIP
    bias = rel_table[:, idx].astype(jnp.float32)
    scale = HEAD_DIM ** -0.5

    def one_chunk(n):
        start = n * CHUNK
        qc = lax.dynamic_slice_in_dim(q, start, CHUNK, axis=1)
        kc = lax.dynamic_slice_in_dim(k_pad, start, BAND, axis=1)
        vc = lax.dynamic_slice_in_dim(v_pad, start, BAND, axis=1)
        s = jnp.einsum('bqhd,bkhd->bhqk', qc, kc).astype(jnp.float32) * scale + bias
        valid = (start - pad + jnp.arange(BAND)) >= 0
        s = jnp.where(valid[None, None, None, :], s, -jnp.inf)
        pr = jax.nn.softmax(s, axis=-1).astype(vc.dtype)
        return jnp.einsum('bhqk,bkhd->bqhd', pr, vc)

    out = lax.map(one_chunk, jnp.arange(nc))
    return jnp.moveaxis(out, 0, 1).reshape(bsz, t, C_WIDTH)


def hybrid_layer(x, c, v_first, w_ada, b_ada, w_in, sgu_ln_g, sgu_ln_b, w_spatial, b_spatial, mu_shift, w_decay0, w_decay2, a0, a2, k_k, k_a, r_k, lnx_g, lnx_b, vres, rel_bias, w_out, ln_g, ln_b):
    mod = jax.nn.silu(c) @ w_ada + b_ada
    shift, scale, gate = jnp.split(mod, 3, axis=-1)
    h = x * (1 + scale[:, None, :]) + shift[:, None, :]
    proj = h @ w_in
    pa, pb, pc = jnp.split(proj, [A_COLS, A_COLS + B_COLS], axis=-1)
    u_a, v_a, g_a = jnp.split(pa, 3, axis=-1)
    y_a = jax.nn.silu(g_a) * spatial_gating(u_a, v_a, sgu_ln_g, sgu_ln_b, w_spatial, b_spatial)
    y_b, v_raw = rwkv7_time_mix(pb[..., :B_SHIFT_COLS], mu_shift, w_decay0, w_decay2, a0, a2, k_k, k_a, r_k, lnx_g, lnx_b, v_first, vres)
    y_b = jax.nn.silu(pb[..., B_SHIFT_COLS:]) * y_b
    q_c, k_c, v_c, g_c = jnp.split(pc, 4, axis=-1)
    y_c = jax.nn.silu(g_c) * chunk_band_attention(q_c, k_c, v_c, rel_bias)
    y = jnp.concatenate([y_a, y_b, y_c], axis=-1) @ w_out
    x = layer_norm(DEEPNORM_ALPHA * x + (1 + gate[:, None, :]) * y, ln_g, ln_b)
    return x, v_raw


def setup_inputs(seed: int = 0) -> dict:
    key = jax.random.key(seed)
    ks = jax.random.split(key, 32)
    n = lambda i, shape: jax.random.normal(ks[i], shape, jnp.float32)
    L = DEPTH
    return {
        'x': n(0, (BATCH, SEQ, D_MODEL)),
        'c': n(1, (BATCH, D_MODEL)),
        'w_ada': n(2, (L, D_MODEL, 3 * D_MODEL)) * (0.1 * D_MODEL ** -0.5),
        'b_ada': n(3, (L, 3 * D_MODEL)) * 0.01,
        'w_in': n(4, (L, D_MODEL, PROJ_COLS)) * D_MODEL ** -0.5,
        'sgu_ln_g': 1.0 + 0.02 * n(5, (L, A_WIDTH)),
        'sgu_ln_b': 0.02 * n(6, (L, A_WIDTH)),
        'w_spatial': n(7, (L, A_GROUPS, SGU_BLOCK, SGU_BLOCK)) * SGU_BLOCK ** -0.5,
        'b_spatial': 1.0 + 0.02 * n(8, (L, A_GROUPS, SGU_BLOCK)),
        'mu_shift': jax.random.uniform(ks[9], (L, B_SHIFT_COLS), jnp.float32),
        'w_decay0': jax.random.uniform(ks[10], (L, B_WIDTH), jnp.float32, -6.0, -1.0),
        'w_decay2': n(11, (L, DECAY_LORA, B_WIDTH)) * 0.1,
        'a0': 0.1 * n(12, (L, B_WIDTH)),
        'a2': n(13, (L, AAA_LORA, B_WIDTH)) * (0.5 * AAA_LORA ** -0.5),
        'k_k': 0.85 + 0.02 * n(14, (L, B_WIDTH)),
        'k_a': 1.0 + 0.02 * n(15, (L, B_WIDTH)),
        'r_k': 0.1 * n(16, (L, B_HEADS, HEAD_DIM)),
        'lnx_g': 1.0 + 0.02 * n(17, (L, B_WIDTH)),
        'lnx_b': 0.02 * n(18, (L, B_WIDTH)),
        'v0': 1.0 + 0.1 * n(19, (L - 1, B_WIDTH)),
        'v1': n(20, (L - 1, B_WIDTH, MV_LORA)) * B_WIDTH ** -0.5,
        'v2': n(21, (L - 1, MV_LORA, B_WIDTH)) * (0.1 * MV_LORA ** -0.5),
        'rel_bias': 0.1 * n(22, (L, C_HEADS, 2 * REL_CLIP + 1)),
        'w_out': n(23, (L, MIX_WIDTH, D_MODEL)) * (DEEPNORM_BETA * MIX_WIDTH ** -0.5),
        'ln_g': 1.0 + 0.02 * n(24, (L, D_MODEL)),
        'ln_b': 0.02 * n(25, (L, D_MODEL)),
    }


def reference(x, c, w_ada, b_ada, w_in, sgu_ln_g, sgu_ln_b, w_spatial, b_spatial, mu_shift, w_decay0, w_decay2, a0, a2, k_k, k_a, r_k, lnx_g, lnx_b, v0, v1, v2, rel_bias, w_out, ln_g, ln_b):
    v_first = None
    for i in range(DEPTH):
        vres = (v0[i - 1], v1[i - 1], v2[i - 1]) if i > 0 else None
        x, v_raw = hybrid_layer(x, c, v_first, w_ada[i], b_ada[i], w_in[i], sgu_ln_g[i], sgu_ln_b[i], w_spatial[i], b_spatial[i], mu_shift[i], w_decay0[i], w_decay2[i], a0[i], a2[i], k_k[i], k_a[i], r_k[i], lnx_g[i], lnx_b[i], vres, rel_bias[i], w_out[i], ln_g[i], ln_b[i])
        if i == 0:
            v_first = v_raw
    return x
```

```cpp
#include <hip/hip_runtime.h>
#include <cstdio>
#include <cstdint>
#include <cmath>
#ifndef MK_N_LAUNCHES
#define MK_N_LAUNCHES 14
#endif
namespace pg8 {
#define PG8_LAS __attribute__((address_space(3)))
typedef unsigned short bf16_t;
typedef short bf16x8 __attribute__((ext_vector_type(8)));
typedef float f32x4 __attribute__((ext_vector_type(4)));
typedef unsigned u32x4 __attribute__((ext_vector_type(4)));
constexpr int BM = 256, BK = 64, HALF = 128, HTB = HALF * BK * 2  , STAGE_BYTES = 8 * HTB, NXCD = 8, WGM = 8;

__host__ __device__ __forceinline__ int lds_byte(int r, int c) { const int st = (r >> 4) * 2 + (c >> 5), rr = r & 15, cc = c & 31, ob = rr * 64 + cc * 2; return st * 1024 + (ob ^ (((ob >> 9) & 1) << 5)); }
__host__ __device__ __forceinline__ void stage_rc(int b, int& R, int& C) { const int st = b / 1024, sb = b % 1024, swz = sb ^ (((sb >> 9) & 1) << 5); R = (st >> 1) * 16 + swz / 64; C = (st & 1) * 32 + (swz % 64) / 2; }
__host__ __device__ __forceinline__ int perm32(int rho) { const int n = rho >> 4, i = rho & 15; return 8 * (i >> 2) + 4 * n + (i & 3); }

struct Unit { int pm, pn; };
struct Gemm { const bf16_t* A; const bf16_t* Bt; int M, N, K; };

struct StaticOrder {
    int nM, nN, nwg, G, c;
    __host__ __device__ void init(int M, int N, int G_, int c_) { nM = M / BM; nN = N / BM; nwg = nM * nN; G = G_; c = c_; }
    __host__ __device__ bool next(int i, Unit& u) const {
        const long L = (long)i * G + c; if (L >= nwg) return false;
        int wgid = (int)L; { const int q = nwg / NXCD, r = nwg % NXCD, xcd = wgid % NXCD, off = wgid / NXCD; wgid = (xcd < r ? xcd * (q + 1) : r * (q + 1) + (xcd - r) * q) + off; }
        const int nig = WGM * nN, gid = wgid / nig, fm = gid * WGM, gsz = (nM - fm) < WGM ? (nM - fm) : WGM;
        u.pm = fm + ((wgid % nig) % gsz); u.pn = (wgid % nig) / gsz; return true;
    }
    __device__ __forceinline__ void a_ready(const Unit&) const {}
    __device__ __forceinline__ void done(const Unit&) const {}
};

__device__ __forceinline__ unsigned cvt_pk_bf16(float lo, float hi) { unsigned r; asm volatile("v_cvt_pk_bf16_f32 %0, %1, %2" : "=v"(r) : "v"(lo), "v"(hi)); return r; }
typedef float f32x2 __attribute__((ext_vector_type(2)));
typedef float f32x2 __attribute__((ext_vector_type(2)));
struct EpiProj {
    static constexpr bool PERM = true, AFTER_DRAIN = false;
    bf16_t* pa; bf16_t* pb; bf16_t* pc; float qscale;
    __device__ __forceinline__ void operator()(const f32x4 (&acc)[2][2][4][2], const Unit& u, int wr, int wc, int fr, int fq) const {
        const int row0 = u.pm * BM + wr * 64 + fr;
        bf16_t* base; int ldc, colt; float sc0 = 1.f, sc1 = 1.f;
        if (u.pn < 3) { base = pa; ldc = 768; colt = u.pn * 256; }
        else if (u.pn < 10) { base = pb; ldc = 1664; colt = (u.pn - 3) * 256; }
        else { base = pc; ldc = 1536; colt = (u.pn - 10) * 256; if (u.pn == 10) { sc0 = qscale; sc1 = qscale; } else if (u.pn == 11) { sc0 = qscale; } }
        const bool skip1 = (u.pn == 9);
        const int col0 = colt + wc * 32 + 8 * fq;
#pragma unroll
        for (int ai = 0; ai < 2; ++ai)
#pragma unroll
            for (int m = 0; m < 4; ++m) { bf16_t* rowp = base + (size_t)(row0 + ai * HALF + m * 16) * ldc + col0;
#pragma unroll
                for (int bj = 0; bj < 2; ++bj) { if (bj == 1 && skip1) continue;
                    const float sc = bj ? sc1 : sc0;
                    const f32x4 v0 = acc[ai][bj][m][0] * sc, v1 = acc[ai][bj][m][1] * sc;
                    u32x4 w; w.x = cvt_pk_bf16(v0[0], v0[1]); w.y = cvt_pk_bf16(v0[2], v0[3]); w.z = cvt_pk_bf16(v1[0], v1[1]); w.w = cvt_pk_bf16(v1[2], v1[3]);
                    *(u32x4*)(rowp + bj * HALF) = w; } }
    }
};
struct EpiRes {
    static constexpr bool PERM = false, AFTER_DRAIN = false;
    const float* xres; float* out; const float* gate1;   int layer; const float* rowstat; const float* lng; const float* lnb; float alpha;
    __device__ __forceinline__ void operator()(const f32x4 (&acc)[2][2][4][2], const Unit& u, int wr, int wc, int fr, int fq) const {
        const int b = u.pm >> 5;
        const float* g = gate1 + (size_t)b * 3072;
        const int col0 = u.pn * BM + wc * 32 + 4 * fq;
#pragma unroll
        for (int bj = 0; bj < 2; ++bj)
#pragma unroll
            for (int n = 0; n < 2; ++n) {
                const int c = col0 + bj * HALF + n * 16;
                const f32x4 gv = *(const f32x4*)(g + c) + 1.0f;
                f32x4 lg = (f32x4){1.f, 1.f, 1.f, 1.f}, lb = (f32x4){0.f, 0.f, 0.f, 0.f};
                if (layer) { lg = *(const f32x4*)(lng + c); lb = *(const f32x4*)(lnb + c); }
#pragma unroll
                for (int ai = 0; ai < 2; ++ai)
#pragma unroll
                    for (int m = 0; m < 4; ++m) {
                        const int row = u.pm * BM + ai * HALF + wr * 64 + m * 16 + fr;
                        const size_t off = (size_t)row * 1024 + c;
                        f32x4 xr = *(const f32x4*)(xres + off);
                        if (layer) { const f32x2 st = *(const f32x2*)(rowstat + 2 * (size_t)row); xr = (xr - st.x) * st.y * lg + lb; }
                        const f32x4 o = xr * alpha + gv * acc[ai][bj][m][n];
                        *(f32x4*)(out + off) = o;
                    }
            }
    }
};
template <class Epi, class Sched, bool ALIGN_EPI = false, bool SP2 = false>
__device__ __forceinline__ void gemm_phase(PG8_LAS unsigned char* lds, const Gemm g, const Sched& S, const Epi& E) {
    const int tid = threadIdx.x, wid = __builtin_amdgcn_readfirstlane(tid >> 6), lane = tid & 63, wr = wid >> 2, wc = wid & 3, fr = lane & 15, fq = lane >> 4;
    const int K = g.K, nt = K / BK;
    unsigned voffA[2], voffB[2];
#pragma unroll
    for (int i = 0; i < 2; ++i) { int R, C; stage_rc(tid * 16 + i * 8192, R, C); const int Rb = Epi::PERM ? ((R & ~31) + perm32(R & 31)) : R;
        voffA[i] = (unsigned)(R * K + C) * 2u; voffB[i] = (unsigned)(Rb * K + C) * 2u; }
    const size_t kstep = (size_t)(BK * 2);
    const size_t hstep = (size_t)HALF * K * 2;
    const size_t tstep = 2 * hstep;
    const unsigned ldsw = (unsigned)wid * 1024u;
    const int aoff = lds_byte(wr * 64 + fr, fq * 8), boff = lds_byte(wc * 32 + fr, fq * 8);
#define PG8_SA(b, h) (((b) * 2 + (h)) * HTB)
#define PG8_SB(b, h) ((4 + (b) * 2 + (h)) * HTB)
#define PG8_STAGE(bufoff, gbase, voff) do { _Pragma("unroll") for (int _i = 0; _i < 2; ++_i) \
        __builtin_amdgcn_global_load_lds((const unsigned*)((const char*)(gbase) + (voff)[_i]), (PG8_LAS unsigned*)(lds + (bufoff) + ldsw + _i * 8192), 16, 0, 0); } while (0)
#define PG8_LDA(dst, b, h) do { _Pragma("unroll") for (int m = 0; m < 4; ++m) _Pragma("unroll") for (int k = 0; k < 2; ++k) dst[m][k] = *(const PG8_LAS bf16x8*)(lds + PG8_SA(b, h) + aoff + m * 2048 + k * 1024); } while (0)
#define PG8_LDB(dst, b, h) do { _Pragma("unroll") for (int n = 0; n < 2; ++n) _Pragma("unroll") for (int k = 0; k < 2; ++k) dst[n][k] = *(const PG8_LAS bf16x8*)(lds + PG8_SB(b, h) + boff + n * 2048 + k * 1024); } while (0)
#define PG8_MMA(ai, bj, At, Bt) do { __builtin_amdgcn_s_setprio(1); _Pragma("unroll") for (int m = 0; m < 4; ++m) _Pragma("unroll") for (int n = 0; n < 2; ++n) _Pragma("unroll") for (int k = 0; k < 2; ++k) \
        acc[ai][bj][m][n] = __builtin_amdgcn_mfma_f32_16x16x32_bf16(Bt[n][k], At[m][k], acc[ai][bj][m][n], 0, 0, 0); __builtin_amdgcn_s_setprio(0); } while (0)
#define PG8_WAIT_V(n) asm volatile("s_waitcnt vmcnt(" #n ")" ::: "memory")
#define PG8_WAIT_L(n) asm volatile("s_waitcnt lgkmcnt(" #n ")" ::: "memory")
#define PG8_BAR __builtin_amdgcn_s_barrier()
#define PG8_SCHED __builtin_amdgcn_sched_barrier(0)
    Unit cur, nxt; int ui = 0;
    if (!S.next(0, cur)) return;
    f32x4 acc[2][2][4][2];
#pragma unroll
    for (int a = 0; a < 2; ++a)
#pragma unroll
        for (int b = 0; b < 2; ++b)
#pragma unroll
            for (int m = 0; m < 4; ++m)
#pragma unroll
                for (int n = 0; n < 2; ++n) acc[a][b][m][n] = (f32x4){0.f, 0.f, 0.f, 0.f};
    bf16x8 At[4][2], B0[2][2], B1[2][2];
    const char* cA = (const char*)g.A + (size_t)cur.pm * tstep; const char* cB = (const char*)g.Bt + (size_t)cur.pn * tstep;
    S.a_ready(cur);
    if constexpr (SP2) {
        PG8_STAGE(PG8_SB(0, 0), cB, voffB); PG8_STAGE(PG8_SB(0, 1), cB + hstep, voffB); PG8_STAGE(PG8_SA(0, 0), cA, voffA); PG8_STAGE(PG8_SA(0, 1), cA + hstep, voffA);
        if (wr == 1) PG8_BAR;
        PG8_WAIT_V(2); PG8_BAR;
        PG8_STAGE(PG8_SB(1, 0), cB + kstep, voffB); PG8_STAGE(PG8_SA(1, 0), cA + kstep, voffA); PG8_STAGE(PG8_SB(1, 1), cB + hstep + kstep, voffB);
        PG8_WAIT_V(6); PG8_BAR;
    } else {
        PG8_STAGE(PG8_SB(0, 0), cB, voffB); PG8_STAGE(PG8_SA(0, 0), cA, voffA); PG8_STAGE(PG8_SB(0, 1), cB + hstep, voffB); PG8_STAGE(PG8_SA(0, 1), cA + hstep, voffA);
        if (wr == 1) PG8_BAR;
        PG8_WAIT_V(4); PG8_BAR;
        PG8_STAGE(PG8_SB(1, 0), cB + kstep, voffB); PG8_STAGE(PG8_SA(1, 0), cA + kstep, voffA); PG8_STAGE(PG8_SB(1, 1), cB + hstep + kstep, voffB);
        PG8_WAIT_V(6); PG8_BAR;
    }
    for (;;) {
        const bool has_next = S.next(ui + 1, nxt);
        const char* nA = has_next ? (const char*)g.A + (size_t)nxt.pm * tstep : cA; const char* nB = has_next ? (const char*)g.Bt + (size_t)nxt.pn * tstep : cB;
        for (int t = 0; t < nt; t += 2) {
            const bool last = (t == nt - 2);
            const char* a1 = cA + (size_t)(t + 1) * kstep;
            const char* a2 = last ? nA : cA + (size_t)(t + 2) * kstep; const char* b2 = last ? nB : cB + (size_t)(t + 2) * kstep;
            const char* a3 = a2 + kstep; const char* b3 = b2 + kstep;
            if (last && has_next) S.a_ready(nxt);
            if constexpr (SP2) {
            PG8_LDB(B0, 0, 0); PG8_LDB(B1, 0, 1); PG8_SCHED; PG8_LDA(At, 0, 0); PG8_STAGE(PG8_SA(1, 1), a1 + hstep, voffA);
            PG8_WAIT_V(8); PG8_WAIT_L(0); PG8_BAR; PG8_MMA(0, 0, At, B0); PG8_MMA(0, 1, At, B1); PG8_BAR; PG8_SCHED;
            PG8_LDA(At, 0, 1); PG8_STAGE(PG8_SB(0, 0), b2, voffB); PG8_STAGE(PG8_SB(0, 1), b2 + hstep, voffB); PG8_STAGE(PG8_SA(0, 0), a2, voffA);
            PG8_WAIT_V(8); PG8_WAIT_L(0); PG8_BAR; PG8_MMA(1, 0, At, B0); PG8_MMA(1, 1, At, B1); PG8_BAR; PG8_SCHED;
            PG8_LDB(B0, 1, 0); PG8_LDB(B1, 1, 1); PG8_SCHED; PG8_LDA(At, 1, 0); PG8_STAGE(PG8_SA(0, 1), a2 + hstep, voffA);
            PG8_WAIT_V(8); PG8_WAIT_L(0); PG8_BAR; PG8_MMA(0, 0, At, B0); PG8_MMA(0, 1, At, B1); PG8_BAR; PG8_SCHED;
            PG8_LDA(At, 1, 1); PG8_STAGE(PG8_SB(1, 0), b3, voffB); PG8_STAGE(PG8_SB(1, 1), b3 + hstep, voffB); PG8_STAGE(PG8_SA(1, 0), a3, voffA);
            PG8_WAIT_V(8); PG8_WAIT_L(0); PG8_BAR; PG8_MMA(1, 0, At, B0); PG8_MMA(1, 1, At, B1); PG8_BAR; PG8_SCHED;
            } else {
            PG8_LDB(B0, 0, 0); PG8_SCHED; PG8_LDA(At, 0, 0); PG8_STAGE(PG8_SA(1, 1), a1 + hstep, voffA);
            PG8_WAIT_L(8); PG8_BAR; PG8_WAIT_L(0); PG8_MMA(0, 0, At, B0); PG8_BAR; PG8_SCHED;
            PG8_LDB(B1, 0, 1); PG8_STAGE(PG8_SB(0, 0), b2, voffB);
            PG8_BAR; PG8_WAIT_L(0); PG8_MMA(0, 1, At, B1); PG8_BAR;
            PG8_LDA(At, 0, 1); PG8_STAGE(PG8_SA(0, 0), a2, voffA);
            PG8_BAR; PG8_WAIT_L(0); PG8_MMA(1, 0, At, B0); PG8_BAR; PG8_SCHED;
            PG8_STAGE(PG8_SB(0, 1), b2 + hstep, voffB);
            PG8_WAIT_V(6); PG8_BAR; PG8_MMA(1, 1, At, B1); PG8_BAR;
            PG8_LDB(B0, 1, 0); PG8_SCHED; PG8_LDA(At, 1, 0); PG8_STAGE(PG8_SA(0, 1), a2 + hstep, voffA);
            PG8_WAIT_L(8); PG8_BAR; PG8_WAIT_L(0); PG8_MMA(0, 0, At, B0); PG8_BAR; PG8_SCHED;
            PG8_LDB(B1, 1, 1); PG8_STAGE(PG8_SB(1, 0), b3, voffB);
            PG8_BAR; PG8_WAIT_L(0); PG8_MMA(0, 1, At, B1); PG8_BAR;
            PG8_LDA(At, 1, 1); PG8_STAGE(PG8_SA(1, 0), a3, voffA);
            PG8_BAR; PG8_WAIT_L(0); PG8_MMA(1, 0, At, B0); PG8_BAR; PG8_SCHED;
            PG8_STAGE(PG8_SB(1, 1), b3 + hstep, voffB);
            PG8_WAIT_V(6); PG8_BAR; PG8_MMA(1, 1, At, B1); PG8_BAR;
            }
        }
        if constexpr (ALIGN_EPI) { if (wr == 0) PG8_BAR; }
        if constexpr (!Epi::AFTER_DRAIN) { E(acc, cur, wr, wc, fr, fq); S.done(cur); }
        if (!has_next) break;
#pragma unroll
        for (int a = 0; a < 2; ++a)
#pragma unroll
            for (int b = 0; b < 2; ++b)
#pragma unroll
                for (int m = 0; m < 4; ++m)
#pragma unroll
                    for (int n = 0; n < 2; ++n) acc[a][b][m][n] = (f32x4){0.f, 0.f, 0.f, 0.f};
        cur = nxt; cA = nA; cB = nB; ++ui;
        if constexpr (ALIGN_EPI) { if (wr == 1) PG8_BAR; }
    }
    PG8_WAIT_V(0);
    if constexpr (!ALIGN_EPI) { if (wr == 0) PG8_BAR; }
    PG8_BAR;
    if constexpr (Epi::AFTER_DRAIN) { E.fused(acc, cur, wr, wc, fr, fq, lds, wid, lane); S.done(cur); }
#undef PG8_SA
#undef PG8_SB
#undef PG8_STAGE
#undef PG8_LDA
#undef PG8_LDB
#undef PG8_MMA
#undef PG8_WAIT_V
#undef PG8_WAIT_L
#undef PG8_BAR
#undef PG8_SCHED
}
}
#define GAS __attribute__((address_space(1)))
#define LAS __attribute__((address_space(3)))
typedef unsigned short bf16;
typedef unsigned v4u __attribute__((ext_vector_type(4)));
typedef float f32x4 __attribute__((ext_vector_type(4)));
typedef short bf16x8 __attribute__((ext_vector_type(8)));
typedef GAS unsigned gu32;
typedef GAS unsigned long long gu64;
#define RLX_AGENT __ATOMIC_RELAXED, __HIP_MEMORY_SCOPE_AGENT
#define LDS_WAIT() asm volatile("s_waitcnt lgkmcnt(0)" ::: "memory")
#define VM_WAIT() asm volatile("s_waitcnt vmcnt(0)" ::: "memory")
__device__ __forceinline__ unsigned long long rt() { return __builtin_amdgcn_s_memrealtime(); }
__device__ __forceinline__ unsigned f2bf(float f) { unsigned u = __builtin_bit_cast(unsigned, f); return (u + 0x7fffu + ((u >> 16) & 1u)) >> 16; }
__device__ __forceinline__ unsigned pk2(float lo, float hi) { return f2bf(lo) | (f2bf(hi) << 16); }

#define XB_TMO      128
#define XB_XCNT(j)  (256  + 64 * (j))
#define XB_XSUB(j)  (1280 + 64 * (j))
#define XB_XGEN(j)  (2304 + 64 * (j))
#define XB_TOP      3328
#define XB_TOPGEN   3392
#define XCD_BAR_WORDS 3456
#define XB_SPIN_CAP (1u << 18)

__device__ __forceinline__ unsigned xb_ld(unsigned* p)              { return __hip_atomic_load(p, __ATOMIC_RELAXED, __HIP_MEMORY_SCOPE_AGENT); }
__device__ __forceinline__ unsigned xb_add(unsigned* p, unsigned v) { return __hip_atomic_fetch_add(p, v, __ATOMIC_RELAXED, __HIP_MEMORY_SCOPE_AGENT); }
__device__ __forceinline__ unsigned xb_xcc_id() { return (unsigned)__builtin_amdgcn_s_getreg((3 << 11) | 20) & 0xFu; }
#define XB_SPIN(cond, bar) do { unsigned _sp = 0; while (cond) { __builtin_amdgcn_s_sleep(1); \
    if ((++_sp & 255u) == 0u) { if (xb_ld(&(bar)[XB_TMO])) break; if (_sp > XB_SPIN_CAP) { atomicAdd(&(bar)[XB_TMO], 1u); break; } } } } while (0)

struct XcdBarrier {
    unsigned* bar; unsigned x;
    volatile LAS unsigned* st;
};

__device__ __forceinline__ XcdBarrier xcd_barrier_post(unsigned* bar, volatile LAS unsigned* st) {
    XcdBarrier b; b.bar = bar; b.x = xb_xcc_id(); b.st = st;
    if (threadIdx.x == 0) (void)xb_add(&bar[XB_XCNT(b.x)], 1u);
    return b;
}
__device__ __forceinline__ void xcd_barrier_complete(unsigned* bar, unsigned x, unsigned& nloc, unsigned& nx) {
    const unsigned G = gridDim.x * gridDim.y * gridDim.z;
    unsigned sum, cnt, mine, sp = 0u;
    for (;;) {
        sum = 0u; cnt = 0u; mine = 0u;
#pragma unroll
        for (unsigned j = 0; j < 16; ++j) { const unsigned c = xb_ld(&bar[XB_XCNT(j)]); sum += c; cnt += (c > 0u) ? 1u : 0u; mine = (j == x) ? c : mine; }
        if (sum == G) break;
        __builtin_amdgcn_s_sleep(1);
        if ((++sp & 255u) == 0u) { if (xb_ld(&bar[XB_TMO])) break; if (sp > XB_SPIN_CAP) { atomicAdd(&bar[XB_TMO], 1u); break; } }
    }
    nloc = mine > 0u ? mine : 1u; nx = cnt > 0u ? cnt : 1u;
}

__device__ __forceinline__ void xcd_barrier(const XcdBarrier& b) {
    asm volatile("s_waitcnt vmcnt(0)" ::: "memory");
    __syncthreads();
    if (threadIdx.x == 0) {
        unsigned* bar = b.bar;
        __builtin_amdgcn_s_waitcnt(0);
        unsigned nloc = b.st[0], nx = b.st[1];
        if (nloc == 0u) { xcd_barrier_complete(bar, b.x, nloc, nx); b.st[0] = nloc; b.st[1] = nx; }
        const unsigned old = xb_add(&bar[XB_XSUB(b.x)], 1u);
        const unsigned gen = old / nloc;
        if (old + 1u == (gen + 1u) * nloc) {
            __builtin_amdgcn_fence(__ATOMIC_RELEASE, "agent");
            asm volatile("s_waitcnt vmcnt(0)" ::: "memory");
            const unsigned og = xb_add(&bar[XB_TOP], 1u);
            const unsigned tg = og / nx;
            if (og + 1u == (tg + 1u) * nx) xb_add(&bar[XB_TOPGEN], 1u);
            else XB_SPIN(xb_ld(&bar[XB_TOPGEN]) == tg, bar);
            __builtin_amdgcn_fence(__ATOMIC_ACQUIRE, "agent");
            xb_add(&bar[XB_XGEN(b.x)], 1u);
            asm volatile("s_waitcnt vmcnt(0)" ::: "memory");
        } else {
            XB_SPIN(xb_ld(&bar[XB_XGEN(b.x)]) == gen, bar);
            __builtin_amdgcn_fence(__ATOMIC_ACQUIRE, "agent");
            asm volatile("s_waitcnt vmcnt(0)" ::: "memory");
        }
    }
    __syncthreads();
}

constexpr int NWAVES = 8, NTHR = 512;
constexpr int BATCH = 8, T = 8192, D = 1024, M = BATCH * T, DEPTH = 2;
constexpr int NPROJ = 3968, NPAD = 4096;
constexpr int HD = 64, BH = 6, CH = 6;
constexpr int PA_LD = 768, PB_LD = 1664, PC_LD = 1536;
constexpr int BSHIFT = 1280;
constexpr float LN_EPS = 1e-5f, GN_EPS = 64e-5f;
constexpr float DN_ALPHA = 1.4142135623730951f;
constexpr float LOG2E = 1.4426950408889634f;
constexpr float QSCALE = 0.125f * LOG2E;

#ifndef MK_N_LAUNCHES
#define MK_N_LAUNCHES 1
#endif
constexpr int N_PHASES = 16;

constexpr size_t MiB = 1u << 20;
constexpr size_t WS_CTL = 0, CTL_ZERO_BYTES = 1 * MiB;
constexpr size_t WS_WIN = 2 * MiB;
constexpr size_t WS_WOUT = 18 * MiB;
constexpr size_t WS_ROWSTAT = 23 * MiB;
constexpr size_t WS_XN = 32 * MiB;
constexpr size_t WS_PA = 160 * MiB;
constexpr size_t WS_PC = 256 * MiB;
constexpr size_t WS_PB = 448 * MiB;
constexpr size_t WS_OPS = 656 * MiB;
constexpr size_t WS_END = 944 * MiB;
constexpr int CW_BAR = 4096;
constexpr int CW_MOD = 16384;
static_assert((CW_MOD + 49152) * 4 <= (int)CTL_ZERO_BYTES, "ctl region");

constexpr int RING_OFF = 0, RING_BYTES = 131072;
constexpr int LDSCTL_OFF = RING_BYTES, MISC_OFF = LDSCTL_OFF + 320;
constexpr int LDS_BYTES = 147456;

struct Frame {
    LAS unsigned char* lds;
    volatile LAS unsigned* MISC;
    gu32* ctl;
    int tid, lane, wave, vcu, G;
    float* out; unsigned char* ws;
};
struct Args { const float* in[26]; float* out; unsigned char* ws; int ph_lo, ph_hi, li, pad; };
#define INP(k) (A.in[k])
__device__ __forceinline__ float bf2f(unsigned short h) { return __builtin_bit_cast(float, (unsigned)h << 16); }
__device__ __forceinline__ float bflo(unsigned u) { return __builtin_bit_cast(float, u << 16); }
__device__ __forceinline__ float bfhi(unsigned u) { return __builtin_bit_cast(float, u & 0xffff0000u); }
__device__ __forceinline__ float silu_f(float x) { return x / (1.0f + __expf(-x)); }
__device__ __forceinline__ float sigmoid_f(float x) { return 1.0f / (1.0f + __expf(-x)); }
__device__ __forceinline__ float wave_sum(float v) {
#pragma unroll
    for (int o = 1; o < 64; o <<= 1) v += __shfl_xor(v, o);
    return v;
}
__device__ __forceinline__ float wave_max(float v) {
#pragma unroll
    for (int o = 1; o < 64; o <<= 1) v = fmaxf(v, __shfl_xor(v, o));
    return v;
}

__device__ __forceinline__ void p0_transpose_item(const float* W, int K, int N, bf16* WT, int shift_from, int shift, LAS float* scr, int item, int lane) {
    const int nblk = N / 32, kb = item / nblk, nb = item % nblk, k0 = 64 * kb, n0 = 32 * nb;
#pragma unroll 8
    for (int i = 0; i < 32; ++i) { const int kk = 2 * i + (lane >> 5); scr[kk * 33 + (lane & 31)] = W[(size_t)(k0 + kk) * N + n0 + (lane & 31)]; }
    LDS_WAIT(); asm volatile("" ::: "memory");
    const int c = lane & 7;
    const int r0 = n0 + (n0 >= shift_from ? shift : 0);
#pragma unroll
    for (int j = 0; j < 4; ++j) { const int n = (lane >> 3) + 8 * j; const LAS float* s = scr + (8 * c) * 33 + n;
        v4u o; o.x = pk2(s[0 * 33], s[1 * 33]); o.y = pk2(s[2 * 33], s[3 * 33]); o.z = pk2(s[4 * 33], s[5 * 33]); o.w = pk2(s[6 * 33], s[7 * 33]);
        *(GAS v4u*)(WT + (size_t)(r0 + n) * K + k0 + 8 * c) = o; }
    LDS_WAIT(); asm volatile("" ::: "memory");
}
__device__ __forceinline__ void p0_prologue(Frame& F, const Args& A) {
    LAS float* scr = (LAS float*)(F.lds + RING_OFF + F.wave * 16384);
    const int gw = F.vcu * NWAVES + F.wave, NGW = F.G * NWAVES;
    constexpr int I_IN = (D / 64) * (NPROJ / 32);
    constexpr int I_OUT = (D / 64) * (D / 32);
    constexpr int I_MOD = 48 * 16;
    constexpr int NITEMS = 2 * (I_IN + I_OUT + I_MOD);
    float* mod = (float*)(F.ws + WS_CTL) + CW_MOD;
    for (int it = gw; it < NITEMS; it += NGW) {
        int r = it;
        if (r < 2 * I_IN) { const int l = r / I_IN; p0_transpose_item(A.in[4] + (size_t)l * D * NPROJ, D, NPROJ, (bf16*)(F.ws + WS_WIN) + (size_t)l * NPAD * D, 2432, 128, scr, r % I_IN, F.lane); continue; }
        r -= 2 * I_IN;
        if (r < 2 * I_OUT) { const int l = r / I_OUT; p0_transpose_item(A.in[23] + (size_t)l * D * D, D, D, (bf16*)(F.ws + WS_WOUT) + (size_t)l * D * D, 1 << 30, 0, scr, r % I_OUT, F.lane); continue; }
        r -= 2 * I_OUT;
        {
            const int l = r / I_MOD, rem = r % I_MOD, jb = rem / 16, ib = rem % 16, i0 = ib * 64, j = jb * 64 + F.lane;
#pragma unroll
            for (int b = 0; b < 8; ++b) scr[b * 64 + F.lane] = silu_f(A.in[1][b * D + i0 + F.lane]);
            LDS_WAIT(); asm volatile("" ::: "memory");
            float acc[8];
#pragma unroll
            for (int b = 0; b < 8; ++b) acc[b] = 0.f;
            const float* wa = A.in[2] + (size_t)l * D * 3072 + (size_t)i0 * 3072 + j;
#pragma unroll 4
            for (int i = 0; i < 64; ++i) { const float wv = wa[(size_t)i * 3072];
#pragma unroll
                for (int b = 0; b < 8; ++b) acc[b] += scr[b * 64 + i] * wv; }
            const float bb = (ib == 0) ? A.in[3][l * 3072 + j] : 0.f;
#pragma unroll
            for (int b = 0; b < 8; ++b) atomicAdd(&mod[(l * 8 + b) * 3072 + j], acc[b] + bb);
            LDS_WAIT(); asm volatile("" ::: "memory");
        }
    }
    for (int l = 0; l < 2; ++l) {
        v4u* z = (v4u*)((bf16*)(F.ws + WS_WIN) + (size_t)l * NPAD * D + (size_t)2432 * D);
        const int n16 = 128 * D * 2 / 16;
        for (int i = F.vcu * NTHR + F.tid; i < n16; i += F.G * NTHR) z[i] = (v4u){0u, 0u, 0u, 0u};
    }
}

__device__ __forceinline__ void p1a_xn(Frame& F, const Args& A, int layer) {
    const int gw = F.vcu * NWAVES + F.wave, NGW = F.G * NWAVES;
    const float* src = layer ? F.out : A.in[0];
    const float* mod = (const float*)(F.ws + WS_CTL) + CW_MOD + (size_t)layer * 8 * 3072;
    float* rowstat = (float*)(F.ws + WS_ROWSTAT);
    bf16* XN = (bf16*)(F.ws + WS_XN);
    const float* lng = A.in[24]; const float* lnb = A.in[25];
    for (int m = gw; m < M; m += NGW) {
        const int b = m / T;
        const GAS f32x4* xr = (const GAS f32x4*)(src + (size_t)m * D) + F.lane;
        f32x4 v[4];
#pragma unroll
        for (int j = 0; j < 4; ++j) v[j] = xr[64 * j];
        if (layer) {
            float s = 0.f;
#pragma unroll
            for (int j = 0; j < 4; ++j) s += (v[j].x + v[j].y) + (v[j].z + v[j].w);
            const float mean = wave_sum(s) * (1.f / D); float s2 = 0.f;
#pragma unroll
            for (int j = 0; j < 4; ++j) { v[j] = v[j] - mean; s2 += (v[j].x * v[j].x + v[j].y * v[j].y) + (v[j].z * v[j].z + v[j].w * v[j].w); }
            const float rstd = 1.f / sqrtf(wave_sum(s2) * (1.f / D) + LN_EPS);
            if (F.lane == 0) { rowstat[2 * (size_t)m] = mean; rowstat[2 * (size_t)m + 1] = rstd; }
#pragma unroll
            for (int j = 0; j < 4; ++j) { const f32x4 g = *((const f32x4*)lng + F.lane + 64 * j), bb = *((const f32x4*)lnb + F.lane + 64 * j); v[j] = v[j] * rstd * g + bb; }
        }
        const f32x4* sh = (const f32x4*)(mod + (size_t)b * 3072) + F.lane;
        const f32x4* sc = (const f32x4*)(mod + (size_t)b * 3072 + 1024) + F.lane;
        GAS unsigned long long* o8 = (GAS unsigned long long*)(XN + (size_t)m * D) + F.lane;
#pragma unroll
        for (int j = 0; j < 4; ++j) { const f32x4 h = v[j] * (sc[64 * j] + 1.0f) + sh[64 * j];
            o8[64 * j] = (unsigned long long)pk2(h.x, h.y) | ((unsigned long long)pk2(h.z, h.w) << 32); }
    }
}
__device__ __forceinline__ void p4_final(Frame& F, const Args& A) {
    const int gw = F.vcu * NWAVES + F.wave, NGW = F.G * NWAVES;
    const float* lng = A.in[24] + D; const float* lnb = A.in[25] + D;
    for (int m = gw; m < M; m += NGW) {
        GAS f32x4* xr = (GAS f32x4*)(F.out + (size_t)m * D) + F.lane;
        f32x4 v[4]; float s = 0.f;
#pragma unroll
        for (int j = 0; j < 4; ++j) { v[j] = xr[64 * j]; s += (v[j].x + v[j].y) + (v[j].z + v[j].w); }
        const float mean = wave_sum(s) * (1.f / D); float s2 = 0.f;
#pragma unroll
        for (int j = 0; j < 4; ++j) { v[j] = v[j] - mean; s2 += (v[j].x * v[j].x + v[j].y * v[j].y) + (v[j].z * v[j].z + v[j].w * v[j].w); }
        const float rstd = 1.f / sqrtf(wave_sum(s2) * (1.f / D) + LN_EPS);
#pragma unroll
        for (int j = 0; j < 4; ++j) { const f32x4 g = *((const f32x4*)lng + F.lane + 64 * j), bb = *((const f32x4*)lnb + F.lane + 64 * j); xr[64 * j] = v[j] * rstd * g + bb; }
    }
}

__device__ __forceinline__ void sgu_unit_simple(Frame& F, const Args& A, int layer, int nb) {
    LAS float* vln = (LAS float*)(F.lds + RING_OFF);
    const bf16* PA = (const bf16*)(F.ws + WS_PA);
    bf16* Y = (bf16*)(F.ws + WS_XN);
    const float* lng = A.in[5] + layer * 256; const float* lnb = A.in[6] + layer * 256;
    const float* wsp = A.in[7] + (size_t)layer * 4 * 128 * 128; const float* bsp = A.in[8] + layer * 4 * 128;
    const size_t m0 = (size_t)nb * 128;
    __syncthreads();
    {
        const int tt = F.tid >> 2, g = F.tid & 3;
        const v4u* src = (const v4u*)(PA + (m0 + tt) * PA_LD + 256 + g * 64);
        float x[64];
#pragma unroll
        for (int i = 0; i < 8; ++i) { const v4u u = src[i]; x[8 * i + 0] = bflo(u.x); x[8 * i + 1] = bfhi(u.x); x[8 * i + 2] = bflo(u.y); x[8 * i + 3] = bfhi(u.y);
            x[8 * i + 4] = bflo(u.z); x[8 * i + 5] = bfhi(u.z); x[8 * i + 6] = bflo(u.w); x[8 * i + 7] = bfhi(u.w); }
        float s = 0.f;
#pragma unroll
        for (int i = 0; i < 64; ++i) s += x[i];
        const float mean = s * (1.f / 64.f); float q = 0.f;
#pragma unroll
        for (int i = 0; i < 64; ++i) { x[i] -= mean; q += x[i] * x[i]; }
        const float rstd = 1.f / sqrtf(q * (1.f / 64.f) + LN_EPS);
#pragma unroll
        for (int i = 0; i < 64; ++i) vln[tt * 256 + g * 64 + i] = x[i] * rstd * lng[g * 64 + i] + lnb[g * 64 + i];
    }
    __syncthreads();
    {
        const int col = F.tid & 255, ph = F.tid >> 8, g = col >> 6;
        for (int p = 64 * ph; p < 64 * ph + 64; ++p) {
            const float* wr = wsp + ((size_t)g * 128 + p) * 128;
            float acc = 0.f;
            for (int q = 0; q <= p; ++q) acc += wr[q] * vln[q * 256 + col];
            const float s = acc + bsp[g * 128 + p];
            const float u = bf2f(PA[(m0 + p) * PA_LD + col]), gt = bf2f(PA[(m0 + p) * PA_LD + 512 + col]);
            Y[(m0 + p) * D + col] = (bf16)f2bf(silu_f(gt) * u * s);
        }
    }
    __syncthreads();
}

__device__ __forceinline__ void attn_item_simple(Frame& F, const Args& A, int layer, int m, int h) {
    LAS float* wq = (LAS float*)(F.lds + RING_OFF + F.wave * 4096);
    LAS float* wp = wq + 64;
    const bf16* PC = (const bf16*)(F.ws + WS_PC);
    bf16* Y = (bf16*)(F.ws + WS_XN);
    const float* tab = A.in[22] + ((size_t)layer * CH + h) * 513;
    const int t = m % T, n = t >> 6; const size_t mb = (size_t)(m - t);
    const int j0 = (n >= 8 ? n - 8 : 0) * 64, j1 = (n + 1) * 64, cnt = j1 - j0;
    wq[F.lane] = bf2f(PC[(size_t)m * PC_LD + h * 64 + F.lane]);
    LDS_WAIT(); asm volatile("" ::: "memory");
    float sc[9]; float mx = -INFINITY;
#pragma unroll
    for (int rd = 0; rd < 9; ++rd) {
        const int jj = rd * 64 + F.lane; float s = -INFINITY;
        if (jj < cnt) {
            const int kp = j0 + jj;
            const v4u* kr = (const v4u*)(PC + (mb + kp) * PC_LD + 384 + h * 64);
            float dot = 0.f;
#pragma unroll
            for (int i = 0; i < 8; ++i) { const v4u u = kr[i]; const LAS float* q = wq + 8 * i;
                dot += q[0] * bflo(u.x) + q[1] * bfhi(u.x) + q[2] * bflo(u.y) + q[3] * bfhi(u.y) + q[4] * bflo(u.z) + q[5] * bfhi(u.z) + q[6] * bflo(u.w) + q[7] * bfhi(u.w); }
            int dist = t - kp; dist = dist < -256 ? -256 : (dist > 256 ? 256 : dist);
            s = dot + tab[dist + 256] * LOG2E;
        }
        sc[rd] = s; mx = fmaxf(mx, s);
    }
    mx = wave_max(mx);
    float sum = 0.f;
#pragma unroll
    for (int rd = 0; rd < 9; ++rd) { const float p = exp2f(sc[rd] - mx); sum += p; wp[rd * 64 + F.lane] = p; }
    sum = wave_sum(sum);
    LDS_WAIT(); asm volatile("" ::: "memory");
    const bf16* vb = PC + (mb + j0) * PC_LD + 768 + h * 64 + F.lane;
    float o = 0.f;
    for (int jj = 0; jj < cnt; ++jj) o += wp[jj] * bf2f(vb[(size_t)jj * PC_LD]);
    o /= sum;
    const float g = bf2f(PC[(size_t)m * PC_LD + 1152 + h * 64 + F.lane]);
    Y[(size_t)m * D + 640 + h * 64 + F.lane] = (bf16)f2bf(silu_f(g) * o);
    LDS_WAIT(); asm volatile("" ::: "memory");
}

__device__ __forceinline__ float softplus_f(float x) { return fmaxf(x, 0.f) + log1pf(__expf(-fabsf(x))); }
__device__ __forceinline__ void rwkv_pre_simple(Frame& F, const Args& A, int layer) {
    LAS float* lw = (LAS float*)(F.lds + RING_OFF);
    LAS float* la = lw + 64;
    LAS float* vs = la + 64;
    LAS float* h1 = vs + 384;
    LAS float* k2 = h1 + 32;
    const bf16* PB = (const bf16*)(F.ws + WS_PB);
    bf16* OPS = (bf16*)(F.ws + WS_OPS);
    const float* mu = A.in[9] + layer * BSHIFT;
    const float* w0 = A.in[10] + layer * 384; const float* w2 = A.in[11] + (size_t)layer * 64 * 384;
    const float* a0 = A.in[12] + layer * 384; const float* a2 = A.in[13] + (size_t)layer * 64 * 384;
    const float* kkp = A.in[14] + layer * 384; const float* kap = A.in[15] + layer * 384;
    const float* v0 = A.in[19]; const float* v1 = A.in[20]; const float* v2 = A.in[21];
    const int per = M / F.G;
    const int tid = F.tid;
    for (int m = F.vcu * per; m < (F.vcu + 1) * per; ++m) {
        const int t = m % T, b = m / T;
        const bf16* pc = PB + (size_t)m * PB_LD; const bf16* pp = pc - PB_LD;
        float xr = 0.f, xk = 0.f, xv = 0.f;
        if (tid < 384) {
            const float c0 = bf2f(pc[tid]), c1 = bf2f(pc[384 + tid]), c2 = bf2f(pc[768 + tid]);
            const float p0 = t ? bf2f(pp[tid]) : 0.f, p1 = t ? bf2f(pp[384 + tid]) : 0.f, p2 = t ? bf2f(pp[768 + tid]) : 0.f;
            xr = c0 + (p0 - c0) * mu[tid]; xk = c1 + (p1 - c1) * mu[384 + tid]; xv = c2 + (p2 - c2) * mu[768 + tid];
            vs[tid] = xv;
        } else {
            const int i = tid - 384, col = 1152 + i;
            const float c0 = bf2f(pc[col]), p0 = t ? bf2f(pp[col]) : 0.f;
            const float xl = c0 + (p0 - c0) * mu[col];
            if (i < 64) lw[i] = tanhf(xl); else la[i - 64] = xl;
        }
        __syncthreads();
        float wlin = 0.f, alin = 0.f;
        if (tid < 384) {
#pragma unroll 8
            for (int i = 0; i < 64; ++i) { wlin += lw[i] * w2[i * 384 + tid]; alin += la[i] * a2[i * 384 + tid]; }
        } else if (layer && tid < 384 + 32) {
            const int n = tid - 384; float acc = 0.f;
            for (int j = 0; j < 384; ++j) acc += vs[j] * v1[j * 32 + n];
            h1[n] = acc;
        }
        float kk = 0.f;
        if (tid < 384) { kk = xk * kkp[tid]; k2[tid] = kk * kk; }
        __syncthreads();
        if (tid < 384) {
            const int hh = tid >> 6, cc = tid & 63;
            const size_t oidx = ((size_t)(b * BH + hh) * T + t) * 384 + cc;
            if (layer) {
                float vl = 0.f;
#pragma unroll 8
                for (int n = 0; n < 32; ++n) vl += h1[n] * v2[n * 384 + tid];
                const float vf = bf2f(OPS[oidx + 3 * 64]);
                xv = xv + (vf - xv) * sigmoid_f(v0[tid] + vl);
            }
            const float w = -softplus_f(-(w0[tid] + wlin)) - 0.5f;
            const float dw = -expm1f(-__expf(w));
            const float a = sigmoid_f(a0[tid] + alin);
            float hs = 0.f;
#pragma unroll 8
            for (int i = 0; i < 64; ++i) hs += k2[hh * 64 + i];
            const float kn = kk / fmaxf(sqrtf(hs), 1e-12f);
            const float kq = xk * (1.f + (a - 1.f) * kap[tid]);
            OPS[oidx] = (bf16)f2bf(xr); OPS[oidx + 64] = (bf16)f2bf(dw); OPS[oidx + 128] = (bf16)f2bf(kq);
            OPS[oidx + 192] = (bf16)f2bf(xv); OPS[oidx + 256] = (bf16)f2bf(-kn); OPS[oidx + 320] = (bf16)f2bf(kn * a);
        }
        __syncthreads();
    }
}

__device__ __forceinline__ float allred32(float x) {
    x += __shfl_xor(x, 1); x += __shfl_xor(x, 2); x += __shfl_xor(x, 4); x += __shfl_xor(x, 8); x += __shfl_xor(x, 16);
    return x;
}
__device__ __forceinline__ void rwkv_scan_simple(Frame& F, int unit) {
    const int bh = unit >> 2, qt = unit & 3, b = bh / BH, h = bh % BH;
    const int row = 16 * qt + 2 * F.wave + (F.lane >> 5), kp = F.lane & 31;
    const unsigned* op = (const unsigned*)(F.ws + WS_OPS) + (size_t)bh * T * 192;
    unsigned char* yb = F.ws + WS_PB + (size_t)b * T * (PB_LD * 2) + (size_t)(h * 64 + row) * 4;
    float s0 = 0.f, s1 = 0.f, ykeep = 0.f;
    for (int t0 = 0; t0 < T; t0 += 32) {
#pragma unroll 4
        for (int tt = 0; tt < 32; ++tt) {
            const unsigned* o = op + (size_t)(t0 + tt) * 192;
            const unsigned ur = o[kp], udw = o[32 + kp], uk = o[64 + kp], ua = o[128 + kp], ub = o[160 + kp];
            const float vv = bf2f(((const unsigned short*)(o + 96))[row]);
            const float sa = allred32(s0 * bflo(ua) + s1 * bfhi(ua));
            s0 = s0 * (1.f - bflo(udw)) + (sa * bflo(ub) + vv * bflo(uk));
            s1 = s1 * (1.f - bfhi(udw)) + (sa * bfhi(ub) + vv * bfhi(uk));
            const float y = allred32(s0 * bflo(ur) + s1 * bfhi(ur));
            if (kp == tt) ykeep = y;
        }
        *(float*)(yb + (size_t)(t0 + kp) * (PB_LD * 2)) = ykeep;
    }
}
__device__ __forceinline__ void rwkv_post_simple(Frame& F, const Args& A, int layer) {
    const unsigned char* PBb = F.ws + WS_PB;
    const bf16* OPS = (const bf16*)(F.ws + WS_OPS);
    bf16* Y = (bf16*)(F.ws + WS_XN);
    const float* rk = A.in[16] + layer * 384; const float* lg = A.in[17] + layer * 384; const float* lb = A.in[18] + layer * 384;
    const int sub = F.lane & 7;
    const long ngrp = (long)M * BH;
    for (long gi = ((long)F.vcu * NTHR + F.tid) >> 3; gi < ngrp; gi += ((long)F.G * NTHR) >> 3) {
        const int m = (int)(gi / BH), h = (int)(gi % BH), t = m % T, b = m / T;
        const unsigned char* prow = PBb + (size_t)m * (PB_LD * 2);
        const f32x4 y0 = *(const f32x4*)(prow + (h * 64 + sub * 8) * 4), y1 = *(const f32x4*)(prow + (h * 64 + sub * 8) * 4 + 16);
        float y[8] = {y0.x, y0.y, y0.z, y0.w, y1.x, y1.y, y1.z, y1.w};
        const size_t oidx = ((size_t)(b * BH + h) * T + t) * 384 + sub * 8;
        const v4u ur = *(const v4u*)(OPS + oidx), uk = *(const v4u*)(OPS + oidx + 128), uv = *(const v4u*)(OPS + oidx + 192);
        const v4u ug = *(const v4u*)(prow + (1280 + h * 64 + sub * 8) * 2);
        float r[8] = {bflo(ur.x), bfhi(ur.x), bflo(ur.y), bfhi(ur.y), bflo(ur.z), bfhi(ur.z), bflo(ur.w), bfhi(ur.w)};
        float k[8] = {bflo(uk.x), bfhi(uk.x), bflo(uk.y), bfhi(uk.y), bflo(uk.z), bfhi(uk.z), bflo(uk.w), bfhi(uk.w)};
        float v[8] = {bflo(uv.x), bfhi(uv.x), bflo(uv.y), bfhi(uv.y), bflo(uv.z), bfhi(uv.z), bflo(uv.w), bfhi(uv.w)};
        float g[8] = {bflo(ug.x), bfhi(ug.x), bflo(ug.y), bfhi(ug.y), bflo(ug.z), bfhi(ug.z), bflo(ug.w), bfhi(ug.w)};
        float s = 0.f, bon = 0.f;
#pragma unroll
        for (int i = 0; i < 8; ++i) { s += y[i]; bon += r[i] * k[i] * rk[h * 64 + sub * 8 + i]; }
        s += __shfl_xor(s, 1); s += __shfl_xor(s, 2); s += __shfl_xor(s, 4);
        bon += __shfl_xor(bon, 1); bon += __shfl_xor(bon, 2); bon += __shfl_xor(bon, 4);
        const float mean = s * (1.f / 64.f); float q = 0.f;
#pragma unroll
        for (int i = 0; i < 8; ++i) { y[i] -= mean; q += y[i] * y[i]; }
        q += __shfl_xor(q, 1); q += __shfl_xor(q, 2); q += __shfl_xor(q, 4);
        const float rstd = 1.f / sqrtf(q * (1.f / 64.f) + GN_EPS);
        float o[8];
#pragma unroll
        for (int i = 0; i < 8; ++i) { const int c = h * 64 + sub * 8 + i; o[i] = silu_f(g[i]) * (y[i] * rstd * lg[c] + lb[c] + bon * v[i]); }
        v4u w; w.x = pk2(o[0], o[1]); w.y = pk2(o[2], o[3]); w.z = pk2(o[4], o[5]); w.w = pk2(o[6], o[7]);
        *(v4u*)(Y + (size_t)m * D + 256 + h * 64 + sub * 8) = w;
    }
}


#define IN(k) (lo <= (k) && (k) < hi)
#define SEAM(k) do { if (IN(k) && IN((k) + 1)) xcd_barrier(bar); } while (0)
template <int layer> __device__ __forceinline__ void layer_phases(Frame& F, const Args& args, const int lo, const int hi, const XcdBarrier& bar) {
    constexpr int pb = 1 + 6 * layer;
    const float* mod = (const float*)(F.ws + WS_CTL) + CW_MOD + (size_t)layer * 8 * 3072;
    if (IN(pb + 0)) { p1a_xn(F, args, layer); } SEAM(pb + 0);
    if (IN(pb + 1)) {
        pg8::Gemm g{(const pg8::bf16_t*)(F.ws + WS_XN), (const pg8::bf16_t*)(F.ws + WS_WIN) + (size_t)layer * NPAD * D, M, NPAD, D};
        pg8::StaticOrder S; S.init(M, NPAD, F.G, (int)blockIdx.x);
        pg8::EpiProj E{(pg8::bf16_t*)(F.ws + WS_PA), (pg8::bf16_t*)(F.ws + WS_PB), (pg8::bf16_t*)(F.ws + WS_PC), QSCALE};
        pg8::gemm_phase<pg8::EpiProj, pg8::StaticOrder, true, true>(F.lds + RING_OFF, g, S, E);
    } SEAM(pb + 1);
    if (IN(pb + 2)) {
        rwkv_pre_simple(F, args, layer);
        for (int nb = F.vcu; nb < M / 128; nb += F.G) sgu_unit_simple(F, args, layer, nb);
        { const long gw = (long)F.vcu * NWAVES + F.wave, NGW = (long)F.G * NWAVES;
          for (long it = gw; it < (long)M * CH; it += NGW) attn_item_simple(F, args, layer, (int)(it / CH), (int)(it % CH)); }
    } SEAM(pb + 2);
    if (IN(pb + 3)) { if (F.vcu < 192) rwkv_scan_simple(F, F.vcu); } SEAM(pb + 3);
    if (IN(pb + 4)) { rwkv_post_simple(F, args, layer); } SEAM(pb + 4);
    if (IN(pb + 5)) {
        pg8::Gemm g{(const pg8::bf16_t*)(F.ws + WS_XN), (const pg8::bf16_t*)(F.ws + WS_WOUT) + (size_t)layer * D * D, M, D, D};
        pg8::StaticOrder S; S.init(M, D, F.G, (int)blockIdx.x);
        pg8::EpiRes E{layer ? (const float*)F.out : args.in[0], F.out, mod + 2048, layer, (const float*)(F.ws + WS_ROWSTAT), args.in[24], args.in[25], DN_ALPHA};
        pg8::gemm_phase<pg8::EpiRes, pg8::StaticOrder, true, true>(F.lds + RING_OFF, g, S, E);
    } SEAM(pb + 5);
}
__global__ void __launch_bounds__(NTHR, 2) fwd_kernel(Args args) {
    extern __shared__ __attribute__((aligned(16))) unsigned char lds[];
    Frame F;
    F.lds = (LAS unsigned char*)lds;
    F.MISC = (volatile LAS unsigned*)(F.lds + MISC_OFF);
    F.tid = threadIdx.x; F.lane = F.tid & 63; F.wave = __builtin_amdgcn_readfirstlane(F.tid >> 6);
    F.G = gridDim.x; { const int bx = blockIdx.x; F.vcu = (F.G % 8 == 0) ? (bx % 8) * (F.G / 8) + bx / 8 : bx; }
    F.out = args.out; F.ws = args.ws;
    F.ctl = (gu32*)(args.ws + WS_CTL);
    for (int u = F.tid; u < (LDS_BYTES - LDSCTL_OFF) / 4; u += NTHR) ((LAS unsigned*)(F.lds + LDSCTL_OFF))[u] = 0u;
    __syncthreads();
    const int lo = args.ph_lo, hi = args.ph_hi;
    XcdBarrier bar; bar.bar = (unsigned*)(F.ctl + CW_BAR); bar.x = 0; bar.st = nullptr;
    if (hi - lo > 1) bar = xcd_barrier_post((unsigned*)(F.ctl + CW_BAR), F.MISC + 8);

    if (IN(0)) { p0_prologue(F, args); } SEAM(0);
    layer_phases<0>(F, args, lo, hi, bar);
    layer_phases<1>(F, args, lo, hi, bar);
    if (IN(13)) { p4_final(F, args); }
#undef IN
#undef SEAM
}

extern "C" void kernel_launch(void* const* d_in, const int* in_sizes, int n_in, void* d_out, int out_size, void* d_ws, size_t ws_size, hipStream_t stream) {
    static int grid = 0;
    if (grid == 0) {
        if (n_in != 26 || in_sizes[0] != M * D || out_size != M * D || ws_size < WS_END) { fprintf(stderr, "kernel_launch: unexpected shapes: n_in %d in0 %d out %d ws %zu (need %zu)\n", n_in, n_in > 0 ? in_sizes[0] : -1, out_size, ws_size, (size_t)WS_END); grid = -1; return; }
        int dev = 0, cus = 0;
        if (hipGetDevice(&dev) != hipSuccess || hipDeviceGetAttribute(&cus, hipDeviceAttributeMultiprocessorCount, dev) != hipSuccess) { grid = -1; return; }
        if (hipFuncSetAttribute((const void*)fwd_kernel, hipFuncAttributeMaxDynamicSharedMemorySize, LDS_BYTES) != hipSuccess) { fprintf(stderr, "kernel_launch: hipFuncSetAttribute failed\n"); grid = -1; return; }
        int per_cu = 0;
        if (hipOccupancyMaxActiveBlocksPerMultiprocessor(&per_cu, (const void*)fwd_kernel, NTHR, LDS_BYTES) != hipSuccess || per_cu < 1) fprintf(stderr, "kernel_launch: occupancy query says %d\n", per_cu);
        (void)hipGetLastError();
        grid = cus;
        if (grid != 256) fprintf(stderr, "kernel_launch: grid %d != 256\n", grid);
    }
    if (grid < 0) return;
    if (hipMemsetAsync((char*)d_ws + WS_CTL, 0, CTL_ZERO_BYTES, stream) != hipSuccess) return;
    Args a{};
    for (int i = 0; i < 26; ++i) a.in[i] = (const float*)d_in[i];
    a.out = (float*)d_out; a.ws = (unsigned char*)d_ws;
    if (MK_N_LAUNCHES == 1) {
        a.ph_lo = 0; a.ph_hi = 14; a.li = 0;
        hipLaunchKernelGGL(fwd_kernel, dim3(grid), dim3(NTHR), LDS_BYTES, stream, a);
    } else {
        for (int p = 0; p < 14; ++p) { a.ph_lo = p; a.ph_hi = p + 1; a.li = p;
            hipLaunchKernelGGL(fwd_kernel, dim3(grid), dim3(NTHR), LDS_BYTES, stream, a); }
    }
}
```

```cpp
#include <hip/hip_runtime.h>
#include <cstdio>
#include <cstdint>
#include <cmath>
#ifndef MK_N_LAUNCHES
#define MK_N_LAUNCHES 1
#endif
namespace pg8 {
#define PG8_LAS __attribute__((address_space(3)))
typedef unsigned short bf16_t;
typedef short bf16x8 __attribute__((ext_vector_type(8)));
typedef float f32x4 __attribute__((ext_vector_type(4)));
typedef unsigned u32x4 __attribute__((ext_vector_type(4)));
constexpr int BM = 256, BK = 64, HALF = 128, HTB = HALF * BK * 2  , STAGE_BYTES = 8 * HTB, NXCD = 8, WGM = 8;

__host__ __device__ __forceinline__ int lds_byte(int r, int c) { const int st = (r >> 4) * 2 + (c >> 5), rr = r & 15, cc = c & 31, ob = rr * 64 + cc * 2; return st * 1024 + (ob ^ (((ob >> 9) & 1) << 5)); }
__host__ __device__ __forceinline__ void stage_rc(int b, int& R, int& C) { const int st = b / 1024, sb = b % 1024, swz = sb ^ (((sb >> 9) & 1) << 5); R = (st >> 1) * 16 + swz / 64; C = (st & 1) * 32 + (swz % 64) / 2; }
__host__ __device__ __forceinline__ int perm32(int rho) { const int n = rho >> 4, i = rho & 15; return 8 * (i >> 2) + 4 * n + (i & 3); }

struct Unit { int pm, pn; };
struct Gemm { const bf16_t* A; const bf16_t* Bt; int M, N, K; };

struct StaticOrder {
    int nM, nN, nwg, G, c;
    __host__ __device__ void init(int M, int N, int G_, int c_) { nM = M / BM; nN = N / BM; nwg = nM * nN; G = G_; c = c_; }
    __host__ __device__ bool next(int i, Unit& u) const {
        const long L = (long)i * G + c; if (L >= nwg) return false;
        int wgid = (int)L; { const int q = nwg / NXCD, r = nwg % NXCD, xcd = wgid % NXCD, off = wgid / NXCD; wgid = (xcd < r ? xcd * (q + 1) : r * (q + 1) + (xcd - r) * q) + off; }
        const int nig = WGM * nN, gid = wgid / nig, fm = gid * WGM, gsz = (nM - fm) < WGM ? (nM - fm) : WGM;
        u.pm = fm + ((wgid % nig) % gsz); u.pn = (wgid % nig) / gsz; return true;
    }
    __device__ __forceinline__ void a_ready(const Unit&) const {}
    __device__ __forceinline__ void done(const Unit&) const {}
};

__device__ __forceinline__ unsigned cvt_pk_bf16(float lo, float hi) { unsigned r; asm volatile("v_cvt_pk_bf16_f32 %0, %1, %2" : "=v"(r) : "v"(lo), "v"(hi)); return r; }
typedef float f32x2 __attribute__((ext_vector_type(2)));
typedef float f32x2 __attribute__((ext_vector_type(2)));
struct EpiProj {
    static constexpr bool PERM = true, AFTER_DRAIN = false;
    bf16_t* pa; bf16_t* pb; bf16_t* pc; float qscale;
    __device__ __forceinline__ void operator()(const f32x4 (&acc)[2][2][4][2], const Unit& u, int wr, int wc, int fr, int fq) const {
        const int row0 = u.pm * BM + wr * 64 + fr;
        bf16_t* base; int ldc, colt; float sc0 = 1.f, sc1 = 1.f;
        if (u.pn < 3) { base = pa; ldc = 768; colt = u.pn * 256; }
        else if (u.pn < 10) { base = pb; ldc = 1664; colt = (u.pn - 3) * 256; }
        else { base = pc; ldc = 1536; colt = (u.pn - 10) * 256; if (u.pn == 10) { sc0 = qscale; sc1 = qscale; } else if (u.pn == 11) { sc0 = qscale; } }
        const bool skip1 = (u.pn == 9);
        const int col0 = colt + wc * 32 + 8 * fq;
#pragma unroll
        for (int ai = 0; ai < 2; ++ai)
#pragma unroll
            for (int m = 0; m < 4; ++m) { bf16_t* rowp = base + (size_t)(row0 + ai * HALF + m * 16) * ldc + col0;
#pragma unroll
                for (int bj = 0; bj < 2; ++bj) { if (bj == 1 && skip1) continue;
                    const float sc = bj ? sc1 : sc0;
                    const f32x4 v0 = acc[ai][bj][m][0] * sc, v1 = acc[ai][bj][m][1] * sc;
                    u32x4 w; w.x = cvt_pk_bf16(v0[0], v0[1]); w.y = cvt_pk_bf16(v0[2], v0[3]); w.z = cvt_pk_bf16(v1[0], v1[1]); w.w = cvt_pk_bf16(v1[2], v1[3]);
                    *(u32x4*)(rowp + bj * HALF) = w; } }
    }
};
struct EpiRes {
    static constexpr bool PERM = false, AFTER_DRAIN = false;
    const float* xres; float* out; const float* gate1;   int layer; const float* rowstat; const float* lng; const float* lnb; float alpha;
    __device__ __forceinline__ void operator()(const f32x4 (&acc)[2][2][4][2], const Unit& u, int wr, int wc, int fr, int fq) const {
        const int b = u.pm >> 5;
        const float* g = gate1 + (size_t)b * 3072;
        const int col0 = u.pn * BM + wc * 32 + 4 * fq;
#pragma unroll
        for (int bj = 0; bj < 2; ++bj)
#pragma unroll
            for (int n = 0; n < 2; ++n) {
                const int c = col0 + bj * HALF + n * 16;
                const f32x4 gv = *(const f32x4*)(g + c) + 1.0f;
                f32x4 lg = (f32x4){1.f, 1.f, 1.f, 1.f}, lb = (f32x4){0.f, 0.f, 0.f, 0.f};
                if (layer) { lg = *(const f32x4*)(lng + c); lb = *(const f32x4*)(lnb + c); }
#pragma unroll
                for (int ai = 0; ai < 2; ++ai)
#pragma unroll
                    for (int m = 0; m < 4; ++m) {
                        const int row = u.pm * BM + ai * HALF + wr * 64 + m * 16 + fr;
                        const size_t off = (size_t)row * 1024 + c;
                        f32x4 xr = *(const f32x4*)(xres + off);
                        if (layer) { const f32x2 st = *(const f32x2*)(rowstat + 2 * (size_t)row); xr = (xr - st.x) * st.y * lg + lb; }
                        const f32x4 o = xr * alpha + gv * acc[ai][bj][m][n];
                        *(f32x4*)(out + off) = o;
                    }
            }
    }
};
template <class Epi, class Sched, bool ALIGN_EPI = false, bool SP2 = false>
__device__ __forceinline__ void gemm_phase(PG8_LAS unsigned char* lds, const Gemm g, const Sched& S, const Epi& E) {
    const int tid = threadIdx.x, wid = __builtin_amdgcn_readfirstlane(tid >> 6), lane = tid & 63, wr = wid >> 2, wc = wid & 3, fr = lane & 15, fq = lane >> 4;
    const int K = g.K, nt = K / BK;
    unsigned voffA[2], voffB[2];
#pragma unroll
    for (int i = 0; i < 2; ++i) { int R, C; stage_rc(tid * 16 + i * 8192, R, C); const int Rb = Epi::PERM ? ((R & ~31) + perm32(R & 31)) : R;
        voffA[i] = (unsigned)(R * K + C) * 2u; voffB[i] = (unsigned)(Rb * K + C) * 2u; }
    const size_t kstep = (size_t)(BK * 2);
    const size_t hstep = (size_t)HALF * K * 2;
    const size_t tstep = 2 * hstep;
    const unsigned ldsw = (unsigned)wid * 1024u;
    const int aoff = lds_byte(wr * 64 + fr, fq * 8), boff = lds_byte(wc * 32 + fr, fq * 8);
#define PG8_SA(b, h) (((b) * 2 + (h)) * HTB)
#define PG8_SB(b, h) ((4 + (b) * 2 + (h)) * HTB)
#define PG8_STAGE(bufoff, gbase, voff) do { _Pragma("unroll") for (int _i = 0; _i < 2; ++_i) \
        __builtin_amdgcn_global_load_lds((const unsigned*)((const char*)(gbase) + (voff)[_i]), (PG8_LAS unsigned*)(lds + (bufoff) + ldsw + _i * 8192), 16, 0, 0); } while (0)
#define PG8_LDA(dst, b, h) do { _Pragma("unroll") for (int m = 0; m < 4; ++m) _Pragma("unroll") for (int k = 0; k < 2; ++k) dst[m][k] = *(const PG8_LAS bf16x8*)(lds + PG8_SA(b, h) + aoff + m * 2048 + k * 1024); } while (0)
#define PG8_LDB(dst, b, h) do { _Pragma("unroll") for (int n = 0; n < 2; ++n) _Pragma("unroll") for (int k = 0; k < 2; ++k) dst[n][k] = *(const PG8_LAS bf16x8*)(lds + PG8_SB(b, h) + boff + n * 2048 + k * 1024); } while (0)
#define PG8_MMA(ai, bj, At, Bt) do { __builtin_amdgcn_s_setprio(1); _Pragma("unroll") for (int m = 0; m < 4; ++m) _Pragma("unroll") for (int n = 0; n < 2; ++n) _Pragma("unroll") for (int k = 0; k < 2; ++k) \
        acc[ai][bj][m][n] = __builtin_amdgcn_mfma_f32_16x16x32_bf16(Bt[n][k], At[m][k], acc[ai][bj][m][n], 0, 0, 0); __builtin_amdgcn_s_setprio(0); } while (0)
#define PG8_WAIT_V(n) asm volatile("s_waitcnt vmcnt(" #n ")" ::: "memory")
#define PG8_WAIT_L(n) asm volatile("s_waitcnt lgkmcnt(" #n ")" ::: "memory")
#define PG8_BAR __builtin_amdgcn_s_barrier()
#define PG8_SCHED __builtin_amdgcn_sched_barrier(0)
    Unit cur, nxt; int ui = 0;
    if (!S.next(0, cur)) return;
    f32x4 acc[2][2][4][2];
#pragma unroll
    for (int a = 0; a < 2; ++a)
#pragma unroll
        for (int b = 0; b < 2; ++b)
#pragma unroll
            for (int m = 0; m < 4; ++m)
#pragma unroll
                for (int n = 0; n < 2; ++n) acc[a][b][m][n] = (f32x4){0.f, 0.f, 0.f, 0.f};
    bf16x8 At[4][2], B0[2][2], B1[2][2];
    const char* cA = (const char*)g.A + (size_t)cur.pm * tstep; const char* cB = (const char*)g.Bt + (size_t)cur.pn * tstep;
    S.a_ready(cur);
    if constexpr (SP2) {
        PG8_STAGE(PG8_SB(0, 0), cB, voffB); PG8_STAGE(PG8_SB(0, 1), cB + hstep, voffB); PG8_STAGE(PG8_SA(0, 0), cA, voffA); PG8_STAGE(PG8_SA(0, 1), cA + hstep, voffA);
        if (wr == 1) PG8_BAR;
        PG8_WAIT_V(2); PG8_BAR;
        PG8_STAGE(PG8_SB(1, 0), cB + kstep, voffB); PG8_STAGE(PG8_SA(1, 0), cA + kstep, voffA); PG8_STAGE(PG8_SB(1, 1), cB + hstep + kstep, voffB);
        PG8_WAIT_V(6); PG8_BAR;
    } else {
        PG8_STAGE(PG8_SB(0, 0), cB, voffB); PG8_STAGE(PG8_SA(0, 0), cA, voffA); PG8_STAGE(PG8_SB(0, 1), cB + hstep, voffB); PG8_STAGE(PG8_SA(0, 1), cA + hstep, voffA);
        if (wr == 1) PG8_BAR;
        PG8_WAIT_V(4); PG8_BAR;
        PG8_STAGE(PG8_SB(1, 0), cB + kstep, voffB); PG8_STAGE(PG8_SA(1, 0), cA + kstep, voffA); PG8_STAGE(PG8_SB(1, 1), cB + hstep + kstep, voffB);
        PG8_WAIT_V(6); PG8_BAR;
    }
    for (;;) {
        const bool has_next = S.next(ui + 1, nxt);
        const char* nA = has_next ? (const char*)g.A + (size_t)nxt.pm * tstep : cA; const char* nB = has_next ? (const char*)g.Bt + (size_t)nxt.pn * tstep : cB;
        for (int t = 0; t < nt; t += 2) {
            const bool last = (t == nt - 2);
            const char* a1 = cA + (size_t)(t + 1) * kstep;
            const char* a2 = last ? nA : cA + (size_t)(t + 2) * kstep; const char* b2 = last ? nB : cB + (size_t)(t + 2) * kstep;
            const char* a3 = a2 + kstep; const char* b3 = b2 + kstep;
            if (last && has_next) S.a_ready(nxt);
            if constexpr (SP2) {
            PG8_LDB(B0, 0, 0); PG8_LDB(B1, 0, 1); PG8_SCHED; PG8_LDA(At, 0, 0); PG8_STAGE(PG8_SA(1, 1), a1 + hstep, voffA);
            PG8_WAIT_V(8); PG8_WAIT_L(0); PG8_BAR; PG8_MMA(0, 0, At, B0); PG8_MMA(0, 1, At, B1); PG8_BAR; PG8_SCHED;
            PG8_LDA(At, 0, 1); PG8_STAGE(PG8_SB(0, 0), b2, voffB); PG8_STAGE(PG8_SB(0, 1), b2 + hstep, voffB); PG8_STAGE(PG8_SA(0, 0), a2, voffA);
            PG8_WAIT_V(8); PG8_WAIT_L(0); PG8_BAR; PG8_MMA(1, 0, At, B0); PG8_MMA(1, 1, At, B1); PG8_BAR; PG8_SCHED;
            PG8_LDB(B0, 1, 0); PG8_LDB(B1, 1, 1); PG8_SCHED; PG8_LDA(At, 1, 0); PG8_STAGE(PG8_SA(0, 1), a2 + hstep, voffA);
            PG8_WAIT_V(8); PG8_WAIT_L(0); PG8_BAR; PG8_MMA(0, 0, At, B0); PG8_MMA(0, 1, At, B1); PG8_BAR; PG8_SCHED;
            PG8_LDA(At, 1, 1); PG8_STAGE(PG8_SB(1, 0), b3, voffB); PG8_STAGE(PG8_SB(1, 1), b3 + hstep, voffB); PG8_STAGE(PG8_SA(1, 0), a3, voffA);
            PG8_WAIT_V(8); PG8_WAIT_L(0); PG8_BAR; PG8_MMA(1, 0, At, B0); PG8_MMA(1, 1, At, B1); PG8_BAR; PG8_SCHED;
            } else {
            PG8_LDB(B0, 0, 0); PG8_SCHED; PG8_LDA(At, 0, 0); PG8_STAGE(PG8_SA(1, 1), a1 + hstep, voffA);
            PG8_WAIT_L(8); PG8_BAR; PG8_WAIT_L(0); PG8_MMA(0, 0, At, B0); PG8_BAR; PG8_SCHED;
            PG8_LDB(B1, 0, 1); PG8_STAGE(PG8_SB(0, 0), b2, voffB);
            PG8_BAR; PG8_WAIT_L(0); PG8_MMA(0, 1, At, B1); PG8_BAR;
            PG8_LDA(At, 0, 1); PG8_STAGE(PG8_SA(0, 0), a2, voffA);
            PG8_BAR; PG8_WAIT_L(0); PG8_MMA(1, 0, At, B0); PG8_BAR; PG8_SCHED;
            PG8_STAGE(PG8_SB(0, 1), b2 + hstep, voffB);
            PG8_WAIT_V(6); PG8_BAR; PG8_MMA(1, 1, At, B1); PG8_BAR;
            PG8_LDB(B0, 1, 0); PG8_SCHED; PG8_LDA(At, 1, 0); PG8_STAGE(PG8_SA(0, 1), a2 + hstep, voffA);
            PG8_WAIT_L(8); PG8_BAR; PG8_WAIT_L(0); PG8_MMA(0, 0, At, B0); PG8_BAR; PG8_SCHED;
            PG8_LDB(B1, 1, 1); PG8_STAGE(PG8_SB(1, 0), b3, voffB);
            PG8_BAR; PG8_WAIT_L(0); PG8_MMA(0, 1, At, B1); PG8_BAR;
            PG8_LDA(At, 1, 1); PG8_STAGE(PG8_SA(1, 0), a3, voffA);
            PG8_BAR; PG8_WAIT_L(0); PG8_MMA(1, 0, At, B0); PG8_BAR; PG8_SCHED;
            PG8_STAGE(PG8_SB(1, 1), b3 + hstep, voffB);
            PG8_WAIT_V(6); PG8_BAR; PG8_MMA(1, 1, At, B1); PG8_BAR;
            }
        }
        if constexpr (ALIGN_EPI) { if (wr == 0) PG8_BAR; }
        if constexpr (!Epi::AFTER_DRAIN) { E(acc, cur, wr, wc, fr, fq); S.done(cur); }
        if (!has_next) break;
#pragma unroll
        for (int a = 0; a < 2; ++a)
#pragma unroll
            for (int b = 0; b < 2; ++b)
#pragma unroll
                for (int m = 0; m < 4; ++m)
#pragma unroll
                    for (int n = 0; n < 2; ++n) acc[a][b][m][n] = (f32x4){0.f, 0.f, 0.f, 0.f};
        cur = nxt; cA = nA; cB = nB; ++ui;
        if constexpr (ALIGN_EPI) { if (wr == 1) PG8_BAR; }
    }
    PG8_WAIT_V(0);
    if constexpr (!ALIGN_EPI) { if (wr == 0) PG8_BAR; }
    PG8_BAR;
    if constexpr (Epi::AFTER_DRAIN) { E.fused(acc, cur, wr, wc, fr, fq, lds, wid, lane); S.done(cur); }
#undef PG8_SA
#undef PG8_SB
#undef PG8_STAGE
#undef PG8_LDA
#undef PG8_LDB
#undef PG8_MMA
#undef PG8_WAIT_V
#undef PG8_WAIT_L
#undef PG8_BAR
#undef PG8_SCHED
}
}
#define GAS __attribute__((address_space(1)))
#define LAS __attribute__((address_space(3)))
typedef unsigned short bf16;
typedef unsigned v4u __attribute__((ext_vector_type(4)));
typedef float f32x4 __attribute__((ext_vector_type(4)));
typedef short bf16x8 __attribute__((ext_vector_type(8)));
typedef GAS unsigned gu32;
typedef GAS unsigned long long gu64;
#define RLX_AGENT __ATOMIC_RELAXED, __HIP_MEMORY_SCOPE_AGENT
#define LDS_WAIT() asm volatile("s_waitcnt lgkmcnt(0)" ::: "memory")
#define VM_WAIT() asm volatile("s_waitcnt vmcnt(0)" ::: "memory")
__device__ __forceinline__ unsigned long long rt() { return __builtin_amdgcn_s_memrealtime(); }
__device__ __forceinline__ unsigned f2bf(float f) { unsigned u = __builtin_bit_cast(unsigned, f); return (u + 0x7fffu + ((u >> 16) & 1u)) >> 16; }
__device__ __forceinline__ unsigned pk2(float lo, float hi) { return f2bf(lo) | (f2bf(hi) << 16); }

#define XB_TMO      128
#define XB_XCNT(j)  (256  + 64 * (j))
#define XB_XSUB(j)  (1280 + 64 * (j))
#define XB_XGEN(j)  (2304 + 64 * (j))
#define XB_TOP      3328
#define XB_TOPGEN   3392
#define XCD_BAR_WORDS 3456
#define XB_SPIN_CAP (1u << 18)

__device__ __forceinline__ unsigned xb_ld(unsigned* p)              { return __hip_atomic_load(p, __ATOMIC_RELAXED, __HIP_MEMORY_SCOPE_AGENT); }
__device__ __forceinline__ unsigned xb_add(unsigned* p, unsigned v) { return __hip_atomic_fetch_add(p, v, __ATOMIC_RELAXED, __HIP_MEMORY_SCOPE_AGENT); }
__device__ __forceinline__ unsigned xb_xcc_id() { return (unsigned)__builtin_amdgcn_s_getreg((3 << 11) | 20) & 0xFu; }
#define XB_SPIN(cond, bar) do { unsigned _sp = 0; while (cond) { __builtin_amdgcn_s_sleep(1); \
    if ((++_sp & 255u) == 0u) { if (xb_ld(&(bar)[XB_TMO])) break; if (_sp > XB_SPIN_CAP) { atomicAdd(&(bar)[XB_TMO], 1u); break; } } } } while (0)

struct XcdBarrier {
    unsigned* bar; unsigned x;
    volatile LAS unsigned* st;
};

__device__ __forceinline__ XcdBarrier xcd_barrier_post(unsigned* bar, volatile LAS unsigned* st) {
    XcdBarrier b; b.bar = bar; b.x = xb_xcc_id(); b.st = st;
    if (threadIdx.x == 0) (void)xb_add(&bar[XB_XCNT(b.x)], 1u);
    return b;
}
__device__ __forceinline__ void xcd_barrier_complete(unsigned* bar, unsigned x, unsigned& nloc, unsigned& nx) {
    const unsigned G = gridDim.x * gridDim.y * gridDim.z;
    unsigned sum, cnt, mine, sp = 0u;
    for (;;) {
        sum = 0u; cnt = 0u; mine = 0u;
#pragma unroll
        for (unsigned j = 0; j < 16; ++j) { const unsigned c = xb_ld(&bar[XB_XCNT(j)]); sum += c; cnt += (c > 0u) ? 1u : 0u; mine = (j == x) ? c : mine; }
        if (sum == G) break;
        __builtin_amdgcn_s_sleep(1);
        if ((++sp & 255u) == 0u) { if (xb_ld(&bar[XB_TMO])) break; if (sp > XB_SPIN_CAP) { atomicAdd(&bar[XB_TMO], 1u); break; } }
    }
    nloc = mine > 0u ? mine : 1u; nx = cnt > 0u ? cnt : 1u;
}

__device__ __forceinline__ void xcd_barrier(const XcdBarrier& b) {
    asm volatile("s_waitcnt vmcnt(0)" ::: "memory");
    __syncthreads();
    if (threadIdx.x == 0) {
        unsigned* bar = b.bar;
        __builtin_amdgcn_s_waitcnt(0);
        unsigned nloc = b.st[0], nx = b.st[1];
        if (nloc == 0u) { xcd_barrier_complete(bar, b.x, nloc, nx); b.st[0] = nloc; b.st[1] = nx; }
        const unsigned old = xb_add(&bar[XB_XSUB(b.x)], 1u);
        const unsigned gen = old / nloc;
        if (old + 1u == (gen + 1u) * nloc) {
            __builtin_amdgcn_fence(__ATOMIC_RELEASE, "agent");
            asm volatile("s_waitcnt vmcnt(0)" ::: "memory");
            const unsigned og = xb_add(&bar[XB_TOP], 1u);
            const unsigned tg = og / nx;
            if (og + 1u == (tg + 1u) * nx) xb_add(&bar[XB_TOPGEN], 1u);
            else XB_SPIN(xb_ld(&bar[XB_TOPGEN]) == tg, bar);
            __builtin_amdgcn_fence(__ATOMIC_ACQUIRE, "agent");
            xb_add(&bar[XB_XGEN(b.x)], 1u);
            asm volatile("s_waitcnt vmcnt(0)" ::: "memory");
        } else {
            XB_SPIN(xb_ld(&bar[XB_XGEN(b.x)]) == gen, bar);
            __builtin_amdgcn_fence(__ATOMIC_ACQUIRE, "agent");
            asm volatile("s_waitcnt vmcnt(0)" ::: "memory");
        }
    }
    __syncthreads();
}

constexpr int NWAVES = 8, NTHR = 512;
constexpr int BATCH = 8, T = 8192, D = 1024, M = BATCH * T, DEPTH = 2;
constexpr int NPROJ = 3968, NPAD = 4096;
constexpr int HD = 64, BH = 6, CH = 6;
constexpr int PA_LD = 768, PB_LD = 1664, PC_LD = 1536;
constexpr int BSHIFT = 1280;
constexpr float LN_EPS = 1e-5f, GN_EPS = 64e-5f;
constexpr float DN_ALPHA = 1.4142135623730951f;
constexpr float LOG2E = 1.4426950408889634f;
constexpr float QSCALE = 0.125f * LOG2E;

#ifndef MK_N_LAUNCHES
#define MK_N_LAUNCHES 1
#endif
constexpr int N_PHASES = 16;

constexpr size_t MiB = 1u << 20;
constexpr size_t WS_CTL = 0, CTL_ZERO_BYTES = 1 * MiB;
constexpr size_t WS_WIN = 2 * MiB;
constexpr size_t WS_WOUT = 18 * MiB;
constexpr size_t WS_ROWSTAT = 23 * MiB;
constexpr size_t WS_XN = 32 * MiB;
constexpr size_t WS_PA = 160 * MiB;
constexpr size_t WS_PC = 256 * MiB;
constexpr size_t WS_PB = 448 * MiB;
constexpr size_t WS_OPS = 656 * MiB;
constexpr size_t WS_END = 944 * MiB;
constexpr int CW_BAR = 4096;
constexpr int CW_MOD = 16384;
static_assert((CW_MOD + 49152) * 4 <= (int)CTL_ZERO_BYTES, "ctl region");

constexpr int RING_OFF = 0, RING_BYTES = 131072;
constexpr int LDSCTL_OFF = RING_BYTES, MISC_OFF = LDSCTL_OFF + 320;
constexpr int LDS_BYTES = 147456;

struct Frame {
    LAS unsigned char* lds;
    volatile LAS unsigned* MISC;
    gu32* ctl;
    int tid, lane, wave, vcu, G;
    float* out; unsigned char* ws;
};
struct Args { const float* in[26]; float* out; unsigned char* ws; int ph_lo, ph_hi, li, pad; };
#define INP(k) (A.in[k])
__device__ __forceinline__ float bf2f(unsigned short h) { return __builtin_bit_cast(float, (unsigned)h << 16); }
__device__ __forceinline__ float bflo(unsigned u) { return __builtin_bit_cast(float, u << 16); }
__device__ __forceinline__ float bfhi(unsigned u) { return __builtin_bit_cast(float, u & 0xffff0000u); }
__device__ __forceinline__ float silu_f(float x) { return x / (1.0f + __expf(-x)); }
__device__ __forceinline__ float sigmoid_f(float x) { return 1.0f / (1.0f + __expf(-x)); }
__device__ __forceinline__ float wave_sum(float v) {
#pragma unroll
    for (int o = 1; o < 64; o <<= 1) v += __shfl_xor(v, o);
    return v;
}
__device__ __forceinline__ float wave_max(float v) {
#pragma unroll
    for (int o = 1; o < 64; o <<= 1) v = fmaxf(v, __shfl_xor(v, o));
    return v;
}

__device__ __forceinline__ void p0_transpose_item(const float* W, int K, int N, bf16* WT, int shift_from, int shift, LAS float* scr, int item, int lane) {
    const int nblk = N / 32, kb = item / nblk, nb = item % nblk, k0 = 64 * kb, n0 = 32 * nb;
#pragma unroll 8
    for (int i = 0; i < 32; ++i) { const int kk = 2 * i + (lane >> 5); scr[kk * 33 + (lane & 31)] = W[(size_t)(k0 + kk) * N + n0 + (lane & 31)]; }
    LDS_WAIT(); asm volatile("" ::: "memory");
    const int c = lane & 7;
    const int r0 = n0 + (n0 >= shift_from ? shift : 0);
#pragma unroll
    for (int j = 0; j < 4; ++j) { const int n = (lane >> 3) + 8 * j; const LAS float* s = scr + (8 * c) * 33 + n;
        v4u o; o.x = pk2(s[0 * 33], s[1 * 33]); o.y = pk2(s[2 * 33], s[3 * 33]); o.z = pk2(s[4 * 33], s[5 * 33]); o.w = pk2(s[6 * 33], s[7 * 33]);
        *(GAS v4u*)(WT + (size_t)(r0 + n) * K + k0 + 8 * c) = o; }
    LDS_WAIT(); asm volatile("" ::: "memory");
}
__device__ __forceinline__ void p0_prologue(Frame& F, const Args& A) {
    LAS float* scr = (LAS float*)(F.lds + RING_OFF + F.wave * 16384);
    const int gw = F.vcu * NWAVES + F.wave, NGW = F.G * NWAVES;
    constexpr int I_IN = (D / 64) * (NPROJ / 32);
    constexpr int I_OUT = (D / 64) * (D / 32);
    constexpr int I_MOD = 48 * 16;
    constexpr int NITEMS = 2 * (I_IN + I_OUT + I_MOD);
    float* mod = (float*)(F.ws + WS_CTL) + CW_MOD;
    for (int it = gw; it < NITEMS; it += NGW) {
        int r = it;
        if (r < 2 * I_IN) { const int l = r / I_IN; p0_transpose_item(A.in[4] + (size_t)l * D * NPROJ, D, NPROJ, (bf16*)(F.ws + WS_WIN) + (size_t)l * NPAD * D, 2432, 128, scr, r % I_IN, F.lane); continue; }
        r -= 2 * I_IN;
        if (r < 2 * I_OUT) { const int l = r / I_OUT; p0_transpose_item(A.in[23] + (size_t)l * D * D, D, D, (bf16*)(F.ws + WS_WOUT) + (size_t)l * D * D, 1 << 30, 0, scr, r % I_OUT, F.lane); continue; }
        r -= 2 * I_OUT;
        {
            const int l = r / I_MOD, rem = r % I_MOD, jb = rem / 16, ib = rem % 16, i0 = ib * 64, j = jb * 64 + F.lane;
#pragma unroll
            for (int b = 0; b < 8; ++b) scr[b * 64 + F.lane] = silu_f(A.in[1][b * D + i0 + F.lane]);
            LDS_WAIT(); asm volatile("" ::: "memory");
            float acc[8];
#pragma unroll
            for (int b = 0; b < 8; ++b) acc[b] = 0.f;
            const float* wa = A.in[2] + (size_t)l * D * 3072 + (size_t)i0 * 3072 + j;
#pragma unroll 4
            for (int i = 0; i < 64; ++i) { const float wv = wa[(size_t)i * 3072];
#pragma unroll
                for (int b = 0; b < 8; ++b) acc[b] += scr[b * 64 + i] * wv; }
            const float bb = (ib == 0) ? A.in[3][l * 3072 + j] : 0.f;
#pragma unroll
            for (int b = 0; b < 8; ++b) atomicAdd(&mod[(l * 8 + b) * 3072 + j], acc[b] + bb);
            LDS_WAIT(); asm volatile("" ::: "memory");
        }
    }
    for (int l = 0; l < 2; ++l) {
        v4u* z = (v4u*)((bf16*)(F.ws + WS_WIN) + (size_t)l * NPAD * D + (size_t)2432 * D);
        const int n16 = 128 * D * 2 / 16;
        for (int i = F.vcu * NTHR + F.tid; i < n16; i += F.G * NTHR) z[i] = (v4u){0u, 0u, 0u, 0u};
    }
}

__device__ __forceinline__ void p1a_xn(Frame& F, const Args& A, int layer) {
    const int gw = F.vcu * NWAVES + F.wave, NGW = F.G * NWAVES;
    const float* src = layer ? F.out : A.in[0];
    const float* mod = (const float*)(F.ws + WS_CTL) + CW_MOD + (size_t)layer * 8 * 3072;
    float* rowstat = (float*)(F.ws + WS_ROWSTAT);
    bf16* XN = (bf16*)(F.ws + WS_XN);
    const float* lng = A.in[24]; const float* lnb = A.in[25];
    for (int m = gw; m < M; m += NGW) {
        const int b = m / T;
        const GAS f32x4* xr = (const GAS f32x4*)(src + (size_t)m * D) + F.lane;
        f32x4 v[4];
#pragma unroll
        for (int j = 0; j < 4; ++j) v[j] = xr[64 * j];
        if (layer) {
            float s = 0.f;
#pragma unroll
            for (int j = 0; j < 4; ++j) s += (v[j].x + v[j].y) + (v[j].z + v[j].w);
            const float mean = wave_sum(s) * (1.f / D); float s2 = 0.f;
#pragma unroll
            for (int j = 0; j < 4; ++j) { v[j] = v[j] - mean; s2 += (v[j].x * v[j].x + v[j].y * v[j].y) + (v[j].z * v[j].z + v[j].w * v[j].w); }
            const float rstd = 1.f / sqrtf(wave_sum(s2) * (1.f / D) + LN_EPS);
            if (F.lane == 0) { rowstat[2 * (size_t)m] = mean; rowstat[2 * (size_t)m + 1] = rstd; }
#pragma unroll
            for (int j = 0; j < 4; ++j) { const f32x4 g = *((const f32x4*)lng + F.lane + 64 * j), bb = *((const f32x4*)lnb + F.lane + 64 * j); v[j] = v[j] * rstd * g + bb; }
        }
        const f32x4* sh = (const f32x4*)(mod + (size_t)b * 3072) + F.lane;
        const f32x4* sc = (const f32x4*)(mod + (size_t)b * 3072 + 1024) + F.lane;
        GAS unsigned long long* o8 = (GAS unsigned long long*)(XN + (size_t)m * D) + F.lane;
#pragma unroll
        for (int j = 0; j < 4; ++j) { const f32x4 h = v[j] * (sc[64 * j] + 1.0f) + sh[64 * j];
            o8[64 * j] = (unsigned long long)pk2(h.x, h.y) | ((unsigned long long)pk2(h.z, h.w) << 32); }
    }
}
__device__ __forceinline__ void p4_final(Frame& F, const Args& A) {
    const int gw = F.vcu * NWAVES + F.wave, NGW = F.G * NWAVES;
    const float* lng = A.in[24] + D; const float* lnb = A.in[25] + D;
    for (int m = gw; m < M; m += NGW) {
        GAS f32x4* xr = (GAS f32x4*)(F.out + (size_t)m * D) + F.lane;
        f32x4 v[4]; float s = 0.f;
#pragma unroll
        for (int j = 0; j < 4; ++j) { v[j] = xr[64 * j]; s += (v[j].x + v[j].y) + (v[j].z + v[j].w); }
        const float mean = wave_sum(s) * (1.f / D); float s2 = 0.f;
#pragma unroll
        for (int j = 0; j < 4; ++j) { v[j] = v[j] - mean; s2 += (v[j].x * v[j].x + v[j].y * v[j].y) + (v[j].z * v[j].z + v[j].w * v[j].w); }
        const float rstd = 1.f / sqrtf(wave_sum(s2) * (1.f / D) + LN_EPS);
#pragma unroll
        for (int j = 0; j < 4; ++j) { const f32x4 g = *((const f32x4*)lng + F.lane + 64 * j), bb = *((const f32x4*)lnb + F.lane + 64 * j); xr[64 * j] = v[j] * rstd * g + bb; }
    }
}

__device__ __forceinline__ void sgu_unit_simple(Frame& F, const Args& A, int layer, int nb) {
    LAS float* vln = (LAS float*)(F.lds + RING_OFF);
    const bf16* PA = (const bf16*)(F.ws + WS_PA);
    bf16* Y = (bf16*)(F.ws + WS_XN);
    const float* lng = A.in[5] + layer * 256; const float* lnb = A.in[6] + layer * 256;
    const float* wsp = A.in[7] + (size_t)layer * 4 * 128 * 128; const float* bsp = A.in[8] + layer * 4 * 128;
    const size_t m0 = (size_t)nb * 128;
    __syncthreads();
    {
        const int tt = F.tid >> 2, g = F.tid & 3;
        const v4u* src = (const v4u*)(PA + (m0 + tt) * PA_LD + 256 + g * 64);
        float x[64];
#pragma unroll
        for (int i = 0; i < 8; ++i) { const v4u u = src[i]; x[8 * i + 0] = bflo(u.x); x[8 * i + 1] = bfhi(u.x); x[8 * i + 2] = bflo(u.y); x[8 * i + 3] = bfhi(u.y);
            x[8 * i + 4] = bflo(u.z); x[8 * i + 5] = bfhi(u.z); x[8 * i + 6] = bflo(u.w); x[8 * i + 7] = bfhi(u.w); }
        float s = 0.f;
#pragma unroll
        for (int i = 0; i < 64; ++i) s += x[i];
        const float mean = s * (1.f / 64.f); float q = 0.f;
#pragma unroll
        for (int i = 0; i < 64; ++i) { x[i] -= mean; q += x[i] * x[i]; }
        const float rstd = 1.f / sqrtf(q * (1.f / 64.f) + LN_EPS);
#pragma unroll
        for (int i = 0; i < 64; ++i) vln[tt * 256 + g * 64 + i] = x[i] * rstd * lng[g * 64 + i] + lnb[g * 64 + i];
    }
    __syncthreads();
    {
        const int col = F.tid & 255, ph = F.tid >> 8, g = col >> 6;
        for (int p = 64 * ph; p < 64 * ph + 64; ++p) {
            const float* wr = wsp + ((size_t)g * 128 + p) * 128;
            float acc = 0.f;
            for (int q = 0; q <= p; ++q) acc += wr[q] * vln[q * 256 + col];
            const float s = acc + bsp[g * 128 + p];
            const float u = bf2f(PA[(m0 + p) * PA_LD + col]), gt = bf2f(PA[(m0 + p) * PA_LD + 512 + col]);
            Y[(m0 + p) * D + col] = (bf16)f2bf(silu_f(gt) * u * s);
        }
    }
    __syncthreads();
}

__device__ __forceinline__ void attn_item_simple(Frame& F, const Args& A, int layer, int m, int h) {
    LAS float* wq = (LAS float*)(F.lds + RING_OFF + F.wave * 4096);
    LAS float* wp = wq + 64;
    const bf16* PC = (const bf16*)(F.ws + WS_PC);
    bf16* Y = (bf16*)(F.ws + WS_XN);
    const float* tab = A.in[22] + ((size_t)layer * CH + h) * 513;
    const int t = m % T, n = t >> 6; const size_t mb = (size_t)(m - t);
    const int j0 = (n >= 8 ? n - 8 : 0) * 64, j1 = (n + 1) * 64, cnt = j1 - j0;
    wq[F.lane] = bf2f(PC[(size_t)m * PC_LD + h * 64 + F.lane]);
    LDS_WAIT(); asm volatile("" ::: "memory");
    float sc[9]; float mx = -INFINITY;
#pragma unroll
    for (int rd = 0; rd < 9; ++rd) {
        const int jj = rd * 64 + F.lane; float s = -INFINITY;
        if (jj < cnt) {
            const int kp = j0 + jj;
            const v4u* kr = (const v4u*)(PC + (mb + kp) * PC_LD + 384 + h * 64);
            float dot = 0.f;
#pragma unroll
            for (int i = 0; i < 8; ++i) { const v4u u = kr[i]; const LAS float* q = wq + 8 * i;
                dot += q[0] * bflo(u.x) + q[1] * bfhi(u.x) + q[2] * bflo(u.y) + q[3] * bfhi(u.y) + q[4] * bflo(u.z) + q[5] * bfhi(u.z) + q[6] * bflo(u.w) + q[7] * bfhi(u.w); }
            int dist = t - kp; dist = dist < -256 ? -256 : (dist > 256 ? 256 : dist);
            s = dot + tab[dist + 256] * LOG2E;
        }
        sc[rd] = s; mx = fmaxf(mx, s);
    }
    mx = wave_max(mx);
    float sum = 0.f;
#pragma unroll
    for (int rd = 0; rd < 9; ++rd) { const float p = exp2f(sc[rd] - mx); sum += p; wp[rd * 64 + F.lane] = p; }
    sum = wave_sum(sum);
    LDS_WAIT(); asm volatile("" ::: "memory");
    const bf16* vb = PC + (mb + j0) * PC_LD + 768 + h * 64 + F.lane;
    float o = 0.f;
    for (int jj = 0; jj < cnt; ++jj) o += wp[jj] * bf2f(vb[(size_t)jj * PC_LD]);
    o /= sum;
    const float g = bf2f(PC[(size_t)m * PC_LD + 1152 + h * 64 + F.lane]);
    Y[(size_t)m * D + 640 + h * 64 + F.lane] = (bf16)f2bf(silu_f(g) * o);
    LDS_WAIT(); asm volatile("" ::: "memory");
}

__device__ __forceinline__ float softplus_f(float x) { return fmaxf(x, 0.f) + log1pf(__expf(-fabsf(x))); }
__device__ __forceinline__ void rwkv_pre_simple(Frame& F, const Args& A, int layer) {
    LAS float* lw = (LAS float*)(F.lds + RING_OFF);
    LAS float* la = lw + 64;
    LAS float* vs = la + 64;
    LAS float* h1 = vs + 384;
    LAS float* k2 = h1 + 32;
    const bf16* PB = (const bf16*)(F.ws + WS_PB);
    bf16* OPS = (bf16*)(F.ws + WS_OPS);
    const float* mu = A.in[9] + layer * BSHIFT;
    const float* w0 = A.in[10] + layer * 384; const float* w2 = A.in[11] + (size_t)layer * 64 * 384;
    const float* a0 = A.in[12] + layer * 384; const float* a2 = A.in[13] + (size_t)layer * 64 * 384;
    const float* kkp = A.in[14] + layer * 384; const float* kap = A.in[15] + layer * 384;
    const float* v0 = A.in[19]; const float* v1 = A.in[20]; const float* v2 = A.in[21];
    const int per = M / F.G;
    const int tid = F.tid;
    for (int m = F.vcu * per; m < (F.vcu + 1) * per; ++m) {
        const int t = m % T, b = m / T;
        const bf16* pc = PB + (size_t)m * PB_LD; const bf16* pp = pc - PB_LD;
        float xr = 0.f, xk = 0.f, xv = 0.f;
        if (tid < 384) {
            const float c0 = bf2f(pc[tid]), c1 = bf2f(pc[384 + tid]), c2 = bf2f(pc[768 + tid]);
            const float p0 = t ? bf2f(pp[tid]) : 0.f, p1 = t ? bf2f(pp[384 + tid]) : 0.f, p2 = t ? bf2f(pp[768 + tid]) : 0.f;
            xr = c0 + (p0 - c0) * mu[tid]; xk = c1 + (p1 - c1) * mu[384 + tid]; xv = c2 + (p2 - c2) * mu[768 + tid];
            vs[tid] = xv;
        } else {
            const int i = tid - 384, col = 1152 + i;
            const float c0 = bf2f(pc[col]), p0 = t ? bf2f(pp[col]) : 0.f;
            const float xl = c0 + (p0 - c0) * mu[col];
            if (i < 64) lw[i] = tanhf(xl); else la[i - 64] = xl;
        }
        __syncthreads();
        float wlin = 0.f, alin = 0.f;
        if (tid < 384) {
#pragma unroll 8
            for (int i = 0; i < 64; ++i) { wlin += lw[i] * w2[i * 384 + tid]; alin += la[i] * a2[i * 384 + tid]; }
        } else if (layer && tid < 384 + 32) {
            const int n = tid - 384; float acc = 0.f;
            for (int j = 0; j < 384; ++j) acc += vs[j] * v1[j * 32 + n];
            h1[n] = acc;
        }
        float kk = 0.f;
        if (tid < 384) { kk = xk * kkp[tid]; k2[tid] = kk * kk; }
        __syncthreads();
        if (tid < 384) {
            const int hh = tid >> 6, cc = tid & 63;
            const size_t oidx = ((size_t)(b * BH + hh) * T + t) * 384 + cc;
            if (layer) {
                float vl = 0.f;
#pragma unroll 8
                for (int n = 0; n < 32; ++n) vl += h1[n] * v2[n * 384 + tid];
                const float vf = bf2f(OPS[oidx + 3 * 64]);
                xv = xv + (vf - xv) * sigmoid_f(v0[tid] + vl);
            }
            const float w = -softplus_f(-(w0[tid] + wlin)) - 0.5f;
            const float dw = -expm1f(-__expf(w));
            const float a = sigmoid_f(a0[tid] + alin);
            float hs = 0.f;
#pragma unroll 8
            for (int i = 0; i < 64; ++i) hs += k2[hh * 64 + i];
            const float kn = kk / fmaxf(sqrtf(hs), 1e-12f);
            const float kq = xk * (1.f + (a - 1.f) * kap[tid]);
            OPS[oidx] = (bf16)f2bf(xr); OPS[oidx + 64] = (bf16)f2bf(dw); OPS[oidx + 128] = (bf16)f2bf(kq);
            OPS[oidx + 192] = (bf16)f2bf(xv); OPS[oidx + 256] = (bf16)f2bf(-kn); OPS[oidx + 320] = (bf16)f2bf(kn * a);
        }
        __syncthreads();
    }
}

__device__ __forceinline__ float allred32(float x) {
    x += __shfl_xor(x, 1); x += __shfl_xor(x, 2); x += __shfl_xor(x, 4); x += __shfl_xor(x, 8); x += __shfl_xor(x, 16);
    return x;
}
__device__ __forceinline__ void rwkv_scan_simple(Frame& F, int unit) {
    const int bh = unit >> 2, qt = unit & 3, b = bh / BH, h = bh % BH;
    const int row = 16 * qt + 2 * F.wave + (F.lane >> 5), kp = F.lane & 31;
    const unsigned* op = (const unsigned*)(F.ws + WS_OPS) + (size_t)bh * T * 192;
    unsigned char* yb = F.ws + WS_PB + (size_t)b * T * (PB_LD * 2) + (size_t)(h * 64 + row) * 4;
    float s0 = 0.f, s1 = 0.f, ykeep = 0.f;
    for (int t0 = 0; t0 < T; t0 += 32) {
#pragma unroll 4
        for (int tt = 0; tt < 32; ++tt) {
            const unsigned* o = op + (size_t)(t0 + tt) * 192;
            const unsigned ur = o[kp], udw = o[32 + kp], uk = o[64 + kp], ua = o[128 + kp], ub = o[160 + kp];
            const float vv = bf2f(((const unsigned short*)(o + 96))[row]);
            const float sa = allred32(s0 * bflo(ua) + s1 * bfhi(ua));
            s0 = s0 * (1.f - bflo(udw)) + (sa * bflo(ub) + vv * bflo(uk));
            s1 = s1 * (1.f - bfhi(udw)) + (sa * bfhi(ub) + vv * bfhi(uk));
            const float y = allred32(s0 * bflo(ur) + s1 * bfhi(ur));
            if (kp == tt) ykeep = y;
        }
        *(float*)(yb + (size_t)(t0 + kp) * (PB_LD * 2)) = ykeep;
    }
}
__device__ __forceinline__ void rwkv_post_simple(Frame& F, const Args& A, int layer) {
    const unsigned char* PBb = F.ws + WS_PB;
    const bf16* OPS = (const bf16*)(F.ws + WS_OPS);
    bf16* Y = (bf16*)(F.ws + WS_XN);
    const float* rk = A.in[16] + layer * 384; const float* lg = A.in[17] + layer * 384; const float* lb = A.in[18] + layer * 384;
    const int sub = F.lane & 7;
    const long ngrp = (long)M * BH;
    for (long gi = ((long)F.vcu * NTHR + F.tid) >> 3; gi < ngrp; gi += ((long)F.G * NTHR) >> 3) {
        const int m = (int)(gi / BH), h = (int)(gi % BH), t = m % T, b = m / T;
        const unsigned char* prow = PBb + (size_t)m * (PB_LD * 2);
        const f32x4 y0 = *(const f32x4*)(prow + (h * 64 + sub * 8) * 4), y1 = *(const f32x4*)(prow + (h * 64 + sub * 8) * 4 + 16);
        float y[8] = {y0.x, y0.y, y0.z, y0.w, y1.x, y1.y, y1.z, y1.w};
        const size_t oidx = ((size_t)(b * BH + h) * T + t) * 384 + sub * 8;
        const v4u ur = *(const v4u*)(OPS + oidx), uk = *(const v4u*)(OPS + oidx + 128), uv = *(const v4u*)(OPS + oidx + 192);
        const v4u ug = *(const v4u*)(prow + (1280 + h * 64 + sub * 8) * 2);
        float r[8] = {bflo(ur.x), bfhi(ur.x), bflo(ur.y), bfhi(ur.y), bflo(ur.z), bfhi(ur.z), bflo(ur.w), bfhi(ur.w)};
        float k[8] = {bflo(uk.x), bfhi(uk.x), bflo(uk.y), bfhi(uk.y), bflo(uk.z), bfhi(uk.z), bflo(uk.w), bfhi(uk.w)};
        float v[8] = {bflo(uv.x), bfhi(uv.x), bflo(uv.y), bfhi(uv.y), bflo(uv.z), bfhi(uv.z), bflo(uv.w), bfhi(uv.w)};
        float g[8] = {bflo(ug.x), bfhi(ug.x), bflo(ug.y), bfhi(ug.y), bflo(ug.z), bfhi(ug.z), bflo(ug.w), bfhi(ug.w)};
        float s = 0.f, bon = 0.f;
#pragma unroll
        for (int i = 0; i < 8; ++i) { s += y[i]; bon += r[i] * k[i] * rk[h * 64 + sub * 8 + i]; }
        s += __shfl_xor(s, 1); s += __shfl_xor(s, 2); s += __shfl_xor(s, 4);
        bon += __shfl_xor(bon, 1); bon += __shfl_xor(bon, 2); bon += __shfl_xor(bon, 4);
        const float mean = s * (1.f / 64.f); float q = 0.f;
#pragma unroll
        for (int i = 0; i < 8; ++i) { y[i] -= mean; q += y[i] * y[i]; }
        q += __shfl_xor(q, 1); q += __shfl_xor(q, 2); q += __shfl_xor(q, 4);
        const float rstd = 1.f / sqrtf(q * (1.f / 64.f) + GN_EPS);
        float o[8];
#pragma unroll
        for (int i = 0; i < 8; ++i) { const int c = h * 64 + sub * 8 + i; o[i] = silu_f(g[i]) * (y[i] * rstd * lg[c] + lb[c] + bon * v[i]); }
        v4u w; w.x = pk2(o[0], o[1]); w.y = pk2(o[2], o[3]); w.z = pk2(o[4], o[5]); w.w = pk2(o[6], o[7]);
        *(v4u*)(Y + (size_t)m * D + 256 + h * 64 + sub * 8) = w;
    }
}


#define IN(k) (lo <= (k) && (k) < hi)
#define SEAM(k) do { if (IN(k) && IN((k) + 1)) xcd_barrier(bar); } while (0)
template <int layer> __device__ __forceinline__ void layer_phases(Frame& F, const Args& args, const int lo, const int hi, const XcdBarrier& bar) {
    constexpr int pb = 1 + 6 * layer;
    const float* mod = (const float*)(F.ws + WS_CTL) + CW_MOD + (size_t)layer * 8 * 3072;
    if (IN(pb + 0)) { p1a_xn(F, args, layer); } SEAM(pb + 0);
    if (IN(pb + 1)) {
        pg8::Gemm g{(const pg8::bf16_t*)(F.ws + WS_XN), (const pg8::bf16_t*)(F.ws + WS_WIN) + (size_t)layer * NPAD * D, M, NPAD, D};
        pg8::StaticOrder S; S.init(M, NPAD, F.G, (int)blockIdx.x);
        pg8::EpiProj E{(pg8::bf16_t*)(F.ws + WS_PA), (pg8::bf16_t*)(F.ws + WS_PB), (pg8::bf16_t*)(F.ws + WS_PC), QSCALE};
        pg8::gemm_phase<pg8::EpiProj, pg8::StaticOrder, true, true>(F.lds + RING_OFF, g, S, E);
    } SEAM(pb + 1);
    if (IN(pb + 2)) {
        rwkv_pre_simple(F, args, layer);
        for (int nb = F.vcu; nb < M / 128; nb += F.G) sgu_unit_simple(F, args, layer, nb);
        { const long gw = (long)F.vcu * NWAVES + F.wave, NGW = (long)F.G * NWAVES;
          for (long it = gw; it < (long)M * CH; it += NGW) attn_item_simple(F, args, layer, (int)(it / CH), (int)(it % CH)); }
    } SEAM(pb + 2);
    if (IN(pb + 3)) { if (F.vcu < 192) rwkv_scan_simple(F, F.vcu); } SEAM(pb + 3);
    if (IN(pb + 4)) { rwkv_post_simple(F, args, layer); } SEAM(pb + 4);
    if (IN(pb + 5)) {
        pg8::Gemm g{(const pg8::bf16_t*)(F.ws + WS_XN), (const pg8::bf16_t*)(F.ws + WS_WOUT) + (size_t)layer * D * D, M, D, D};
        pg8::StaticOrder S; S.init(M, D, F.G, (int)blockIdx.x);
        pg8::EpiRes E{layer ? (const float*)F.out : args.in[0], F.out, mod + 2048, layer, (const float*)(F.ws + WS_ROWSTAT), args.in[24], args.in[25], DN_ALPHA};
        pg8::gemm_phase<pg8::EpiRes, pg8::StaticOrder, true, true>(F.lds + RING_OFF, g, S, E);
    } SEAM(pb + 5);
}
__global__ void __launch_bounds__(NTHR, 2) fwd_kernel(Args args) {
    extern __shared__ __attribute__((aligned(16))) unsigned char lds[];
    Frame F;
    F.lds = (LAS unsigned char*)lds;
    F.MISC = (volatile LAS unsigned*)(F.lds + MISC_OFF);
    F.tid = threadIdx.x; F.lane = F.tid & 63; F.wave = __builtin_amdgcn_readfirstlane(F.tid >> 6);
    F.G = gridDim.x; { const int bx = blockIdx.x; F.vcu = (F.G % 8 == 0) ? (bx % 8) * (F.G / 8) + bx / 8 : bx; }
    F.out = args.out; F.ws = args.ws;
    F.ctl = (gu32*)(args.ws + WS_CTL);
    for (int u = F.tid; u < (LDS_BYTES - LDSCTL_OFF) / 4; u += NTHR) ((LAS unsigned*)(F.lds + LDSCTL_OFF))[u] = 0u;
    __syncthreads();
    const int lo = args.ph_lo, hi = args.ph_hi;
    XcdBarrier bar; bar.bar = (unsigned*)(F.ctl + CW_BAR); bar.x = 0; bar.st = nullptr;
    if (hi - lo > 1) bar = xcd_barrier_post((unsigned*)(F.ctl + CW_BAR), F.MISC + 8);

    if (IN(0)) { p0_prologue(F, args); } SEAM(0);
    layer_phases<0>(F, args, lo, hi, bar);
    layer_phases<1>(F, args, lo, hi, bar);
    if (IN(13)) { p4_final(F, args); }
#undef IN
#undef SEAM
}

extern "C" void kernel_launch(void* const* d_in, const int* in_sizes, int n_in, void* d_out, int out_size, void* d_ws, size_t ws_size, hipStream_t stream) {
    static int grid = 0;
    if (grid == 0) {
        if (n_in != 26 || in_sizes[0] != M * D || out_size != M * D || ws_size < WS_END) { fprintf(stderr, "kernel_launch: unexpected shapes: n_in %d in0 %d out %d ws %zu (need %zu)\n", n_in, n_in > 0 ? in_sizes[0] : -1, out_size, ws_size, (size_t)WS_END); grid = -1; return; }
        int dev = 0, cus = 0;
        if (hipGetDevice(&dev) != hipSuccess || hipDeviceGetAttribute(&cus, hipDeviceAttributeMultiprocessorCount, dev) != hipSuccess) { grid = -1; return; }
        if (hipFuncSetAttribute((const void*)fwd_kernel, hipFuncAttributeMaxDynamicSharedMemorySize, LDS_BYTES) != hipSuccess) { fprintf(stderr, "kernel_launch: hipFuncSetAttribute failed\n"); grid = -1; return; }
        int per_cu = 0;
        if (hipOccupancyMaxActiveBlocksPerMultiprocessor(&per_cu, (const void*)fwd_kernel, NTHR, LDS_BYTES) != hipSuccess || per_cu < 1) fprintf(stderr, "kernel_launch: occupancy query says %d\n", per_cu);
        (void)hipGetLastError();
        grid = cus;
        if (grid != 256) fprintf(stderr, "kernel_launch: grid %d != 256\n", grid);
    }
    if (grid < 0) return;
    if (hipMemsetAsync((char*)d_ws + WS_CTL, 0, CTL_ZERO_BYTES, stream) != hipSuccess) return;
    Args a{};
    for (int i = 0; i < 26; ++i) a.in[i] = (const float*)d_in[i];
    a.out = (float*)d_out; a.ws = (unsigned char*)d_ws;
    if (MK_N_LAUNCHES == 1) {
        a.ph_lo = 0; a.ph_hi = 14; a.li = 0;
        hipLaunchKernelGGL(fwd_kernel, dim3(grid), dim3(NTHR), LDS_BYTES, stream, a);
    } else {
        for (int p = 0; p < 14; ++p) { a.ph_lo = p; a.ph_hi = p + 1; a.li = p;
            hipLaunchKernelGGL(fwd_kernel, dim3(grid), dim3(NTHR), LDS_BYTES, stream, a); }
    }
}
```

```cpp
#include <hip/hip_runtime.h>
#include <cstdio>
#include <cstdint>
#include <cmath>
#ifndef MK_N_LAUNCHES
#define MK_N_LAUNCHES 1
#endif
namespace pg8 {
#define PG8_LAS __attribute__((address_space(3)))
typedef unsigned short bf16_t;
typedef short bf16x8 __attribute__((ext_vector_type(8)));
typedef float f32x4 __attribute__((ext_vector_type(4)));
typedef unsigned u32x4 __attribute__((ext_vector_type(4)));
constexpr int BM = 256, BK = 64, HALF = 128, HTB = HALF * BK * 2  , STAGE_BYTES = 8 * HTB, NXCD = 8, WGM = 8;

__host__ __device__ __forceinline__ int lds_byte(int r, int c) { const int st = (r >> 4) * 2 + (c >> 5), rr = r & 15, cc = c & 31, ob = rr * 64 + cc * 2; return st * 1024 + (ob ^ (((ob >> 9) & 1) << 5)); }
__host__ __device__ __forceinline__ void stage_rc(int b, int& R, int& C) { const int st = b / 1024, sb = b % 1024, swz = sb ^ (((sb >> 9) & 1) << 5); R = (st >> 1) * 16 + swz / 64; C = (st & 1) * 32 + (swz % 64) / 2; }
__host__ __device__ __forceinline__ int perm32(int rho) { const int n = rho >> 4, i = rho & 15; return 8 * (i >> 2) + 4 * n + (i & 3); }

struct Unit { int pm, pn; };
struct Gemm { const bf16_t* A; const bf16_t* Bt; int M, N, K; };

struct StaticOrder {
    int nM, nN, nwg, G, c;
    __host__ __device__ void init(int M, int N, int G_, int c_) { nM = M / BM; nN = N / BM; nwg = nM * nN; G = G_; c = c_; }
    __host__ __device__ bool next(int i, Unit& u) const {
        const long L = (long)i * G + c; if (L >= nwg) return false;
        int wgid = (int)L; { const int q = nwg / NXCD, r = nwg % NXCD, xcd = wgid % NXCD, off = wgid / NXCD; wgid = (xcd < r ? xcd * (q + 1) : r * (q + 1) + (xcd - r) * q) + off; }
        const int nig = WGM * nN, gid = wgid / nig, fm = gid * WGM, gsz = (nM - fm) < WGM ? (nM - fm) : WGM;
        u.pm = fm + ((wgid % nig) % gsz); u.pn = (wgid % nig) / gsz; return true;
    }
    __device__ __forceinline__ void a_ready(const Unit&) const {}
    __device__ __forceinline__ void done(const Unit&) const {}
};

__device__ __forceinline__ unsigned cvt_pk_bf16(float lo, float hi) { unsigned r; asm volatile("v_cvt_pk_bf16_f32 %0, %1, %2" : "=v"(r) : "v"(lo), "v"(hi)); return r; }
typedef float f32x2 __attribute__((ext_vector_type(2)));
typedef float f32x2 __attribute__((ext_vector_type(2)));
struct EpiProj {
    static constexpr bool PERM = true, AFTER_DRAIN = false;
    bf16_t* pa; bf16_t* pb; bf16_t* pc; float qscale;
    __device__ __forceinline__ void operator()(const f32x4 (&acc)[2][2][4][2], const Unit& u, int wr, int wc, int fr, int fq) const {
        const int row0 = u.pm * BM + wr * 64 + fr;
        bf16_t* base; int ldc, colt; float sc0 = 1.f, sc1 = 1.f;
        if (u.pn < 3) { base = pa; ldc = 768; colt = u.pn * 256; }
        else if (u.pn < 10) { base = pb; ldc = 1664; colt = (u.pn - 3) * 256; }
        else { base = pc; ldc = 1536; colt = (u.pn - 10) * 256; if (u.pn == 10) { sc0 = qscale; sc1 = qscale; } else if (u.pn == 11) { sc0 = qscale; } }
        const bool skip1 = (u.pn == 9);
        const int col0 = colt + wc * 32 + 8 * fq;
#pragma unroll
        for (int ai = 0; ai < 2; ++ai)
#pragma unroll
            for (int m = 0; m < 4; ++m) { bf16_t* rowp = base + (size_t)(row0 + ai * HALF + m * 16) * ldc + col0;
#pragma unroll
                for (int bj = 0; bj < 2; ++bj) { if (bj == 1 && skip1) continue;
                    const float sc = bj ? sc1 : sc0;
                    const f32x4 v0 = acc[ai][bj][m][0] * sc, v1 = acc[ai][bj][m][1] * sc;
                    u32x4 w; w.x = cvt_pk_bf16(v0[0], v0[1]); w.y = cvt_pk_bf16(v0[2], v0[3]); w.z = cvt_pk_bf16(v1[0], v1[1]); w.w = cvt_pk_bf16(v1[2], v1[3]);
                    *(u32x4*)(rowp + bj * HALF) = w; } }
    }
};
struct EpiRes {
    static constexpr bool PERM = false, AFTER_DRAIN = false;
    const float* xres; float* out; const float* gate1;   int layer; const float* rowstat; const float* lng; const float* lnb; float alpha;
    __device__ __forceinline__ void operator()(const f32x4 (&acc)[2][2][4][2], const Unit& u, int wr, int wc, int fr, int fq) const {
        const int b = u.pm >> 5;
        const float* g = gate1 + (size_t)b * 3072;
        const int col0 = u.pn * BM + wc * 32 + 4 * fq;
#pragma unroll
        for (int bj = 0; bj < 2; ++bj)
#pragma unroll
            for (int n = 0; n < 2; ++n) {
                const int c = col0 + bj * HALF + n * 16;
                const f32x4 gv = *(const f32x4*)(g + c) + 1.0f;
                f32x4 lg = (f32x4){1.f, 1.f, 1.f, 1.f}, lb = (f32x4){0.f, 0.f, 0.f, 0.f};
                if (layer) { lg = *(const f32x4*)(lng + c); lb = *(const f32x4*)(lnb + c); }
#pragma unroll
                for (int ai = 0; ai < 2; ++ai)
#pragma unroll
                    for (int m = 0; m < 4; ++m) {
                        const int row = u.pm * BM + ai * HALF + wr * 64 + m * 16 + fr;
                        const size_t off = (size_t)row * 1024 + c;
                        f32x4 xr = *(const f32x4*)(xres + off);
                        if (layer) { const f32x2 st = *(const f32x2*)(rowstat + 2 * (size_t)row); xr = (xr - st.x) * st.y * lg + lb; }
                        const f32x4 o = xr * alpha + gv * acc[ai][bj][m][n];
                        *(f32x4*)(out + off) = o;
                    }
            }
    }
};
template <class Epi, class Sched, bool ALIGN_EPI = false, bool SP2 = false>
__device__ __forceinline__ void gemm_phase(PG8_LAS unsigned char* lds, const Gemm g, const Sched& S, const Epi& E) {
    const int tid = threadIdx.x, wid = __builtin_amdgcn_readfirstlane(tid >> 6), lane = tid & 63, wr = wid >> 2, wc = wid & 3, fr = lane & 15, fq = lane >> 4;
    const int K = g.K, nt = K / BK;
    unsigned voffA[2], voffB[2];
#pragma unroll
    for (int i = 0; i < 2; ++i) { int R, C; stage_rc(tid * 16 + i * 8192, R, C); const int Rb = Epi::PERM ? ((R & ~31) + perm32(R & 31)) : R;
        voffA[i] = (unsigned)(R * K + C) * 2u; voffB[i] = (unsigned)(Rb * K + C) * 2u; }
    const size_t kstep = (size_t)(BK * 2);
    const size_t hstep = (size_t)HALF * K * 2;
    const size_t tstep = 2 * hstep;
    const unsigned ldsw = (unsigned)wid * 1024u;
    const int aoff = lds_byte(wr * 64 + fr, fq * 8), boff = lds_byte(wc * 32 + fr, fq * 8);
#define PG8_SA(b, h) (((b) * 2 + (h)) * HTB)
#define PG8_SB(b, h) ((4 + (b) * 2 + (h)) * HTB)
#define PG8_STAGE(bufoff, gbase, voff) do { _Pragma("unroll") for (int _i = 0; _i < 2; ++_i) \
        __builtin_amdgcn_global_load_lds((const unsigned*)((const char*)(gbase) + (voff)[_i]), (PG8_LAS unsigned*)(lds + (bufoff) + ldsw + _i * 8192), 16, 0, 0); } while (0)
#define PG8_LDA(dst, b, h) do { _Pragma("unroll") for (int m = 0; m < 4; ++m) _Pragma("unroll") for (int k = 0; k < 2; ++k) dst[m][k] = *(const PG8_LAS bf16x8*)(lds + PG8_SA(b, h) + aoff + m * 2048 + k * 1024); } while (0)
#define PG8_LDB(dst, b, h) do { _Pragma("unroll") for (int n = 0; n < 2; ++n) _Pragma("unroll") for (int k = 0; k < 2; ++k) dst[n][k] = *(const PG8_LAS bf16x8*)(lds + PG8_SB(b, h) + boff + n * 2048 + k * 1024); } while (0)
#define PG8_MMA(ai, bj, At, Bt) do { __builtin_amdgcn_s_setprio(1); _Pragma("unroll") for (int m = 0; m < 4; ++m) _Pragma("unroll") for (int n = 0; n < 2; ++n) _Pragma("unroll") for (int k = 0; k < 2; ++k) \
        acc[ai][bj][m][n] = __builtin_amdgcn_mfma_f32_16x16x32_bf16(Bt[n][k], At[m][k], acc[ai][bj][m][n], 0, 0, 0); __builtin_amdgcn_s_setprio(0); } while (0)
#define PG8_WAIT_V(n) asm volatile("s_waitcnt vmcnt(" #n ")" ::: "memory")
#define PG8_WAIT_L(n) asm volatile("s_waitcnt lgkmcnt(" #n ")" ::: "memory")
#define PG8_BAR __builtin_amdgcn_s_barrier()
#define PG8_SCHED __builtin_amdgcn_sched_barrier(0)
    Unit cur, nxt; int ui = 0;
    if (!S.next(0, cur)) return;
    f32x4 acc[2][2][4][2];
#pragma unroll
    for (int a = 0; a < 2; ++a)
#pragma unroll
        for (int b = 0; b < 2; ++b)
#pragma unroll
            for (int m = 0; m < 4; ++m)
#pragma unroll
                for (int n = 0; n < 2; ++n) acc[a][b][m][n] = (f32x4){0.f, 0.f, 0.f, 0.f};
    bf16x8 At[4][2], B0[2][2], B1[2][2];
    const char* cA = (const char*)g.A + (size_t)cur.pm * tstep; const char* cB = (const char*)g.Bt + (size_t)cur.pn * tstep;
    S.a_ready(cur);
    if constexpr (SP2) {
        PG8_STAGE(PG8_SB(0, 0), cB, voffB); PG8_STAGE(PG8_SB(0, 1), cB + hstep, voffB); PG8_STAGE(PG8_SA(0, 0), cA, voffA); PG8_STAGE(PG8_SA(0, 1), cA + hstep, voffA);
        if (wr == 1) PG8_BAR;
        PG8_WAIT_V(2); PG8_BAR;
        PG8_STAGE(PG8_SB(1, 0), cB + kstep, voffB); PG8_STAGE(PG8_SA(1, 0), cA + kstep, voffA); PG8_STAGE(PG8_SB(1, 1), cB + hstep + kstep, voffB);
        PG8_WAIT_V(6); PG8_BAR;
    } else {
        PG8_STAGE(PG8_SB(0, 0), cB, voffB); PG8_STAGE(PG8_SA(0, 0), cA, voffA); PG8_STAGE(PG8_SB(0, 1), cB + hstep, voffB); PG8_STAGE(PG8_SA(0, 1), cA + hstep, voffA);
        if (wr == 1) PG8_BAR;
        PG8_WAIT_V(4); PG8_BAR;
        PG8_STAGE(PG8_SB(1, 0), cB + kstep, voffB); PG8_STAGE(PG8_SA(1, 0), cA + kstep, voffA); PG8_STAGE(PG8_SB(1, 1), cB + hstep + kstep, voffB);
        PG8_WAIT_V(6); PG8_BAR;
    }
    for (;;) {
        const bool has_next = S.next(ui + 1, nxt);
        const char* nA = has_next ? (const char*)g.A + (size_t)nxt.pm * tstep : cA; const char* nB = has_next ? (const char*)g.Bt + (size_t)nxt.pn * tstep : cB;
        for (int t = 0; t < nt; t += 2) {
            const bool last = (t == nt - 2);
            const char* a1 = cA + (size_t)(t + 1) * kstep;
            const char* a2 = last ? nA : cA + (size_t)(t + 2) * kstep; const char* b2 = last ? nB : cB + (size_t)(t + 2) * kstep;
            const char* a3 = a2 + kstep; const char* b3 = b2 + kstep;
            if (last && has_next) S.a_ready(nxt);
            if constexpr (SP2) {
            PG8_LDB(B0, 0, 0); PG8_LDB(B1, 0, 1); PG8_SCHED; PG8_LDA(At, 0, 0); PG8_STAGE(PG8_SA(1, 1), a1 + hstep, voffA);
            PG8_WAIT_V(8); PG8_WAIT_L(0); PG8_BAR; PG8_MMA(0, 0, At, B0); PG8_MMA(0, 1, At, B1); PG8_BAR; PG8_SCHED;
            PG8_LDA(At, 0, 1); PG8_STAGE(PG8_SB(0, 0), b2, voffB); PG8_STAGE(PG8_SB(0, 1), b2 + hstep, voffB); PG8_STAGE(PG8_SA(0, 0), a2, voffA);
            PG8_WAIT_V(8); PG8_WAIT_L(0); PG8_BAR; PG8_MMA(1, 0, At, B0); PG8_MMA(1, 1, At, B1); PG8_BAR; PG8_SCHED;
            PG8_LDB(B0, 1, 0); PG8_LDB(B1, 1, 1); PG8_SCHED; PG8_LDA(At, 1, 0); PG8_STAGE(PG8_SA(0, 1), a2 + hstep, voffA);
            PG8_WAIT_V(8); PG8_WAIT_L(0); PG8_BAR; PG8_MMA(0, 0, At, B0); PG8_MMA(0, 1, At, B1); PG8_BAR; PG8_SCHED;
            PG8_LDA(At, 1, 1); PG8_STAGE(PG8_SB(1, 0), b3, voffB); PG8_STAGE(PG8_SB(1, 1), b3 + hstep, voffB); PG8_STAGE(PG8_SA(1, 0), a3, voffA);
            PG8_WAIT_V(8); PG8_WAIT_L(0); PG8_BAR; PG8_MMA(1, 0, At, B0); PG8_MMA(1, 1, At, B1); PG8_BAR; PG8_SCHED;
            } else {
            PG8_LDB(B0, 0, 0); PG8_SCHED; PG8_LDA(At, 0, 0); PG8_STAGE(PG8_SA(1, 1), a1 + hstep, voffA);
            PG8_WAIT_L(8); PG8_BAR; PG8_WAIT_L(0); PG8_MMA(0, 0, At, B0); PG8_BAR; PG8_SCHED;
            PG8_LDB(B1, 0, 1); PG8_STAGE(PG8_SB(0, 0), b2, voffB);
            PG8_BAR; PG8_WAIT_L(0); PG8_MMA(0, 1, At, B1); PG8_BAR;
            PG8_LDA(At, 0, 1); PG8_STAGE(PG8_SA(0, 0), a2, voffA);
            PG8_BAR; PG8_WAIT_L(0); PG8_MMA(1, 0, At, B0); PG8_BAR; PG8_SCHED;
            PG8_STAGE(PG8_SB(0, 1), b2 + hstep, voffB);
            PG8_WAIT_V(6); PG8_BAR; PG8_MMA(1, 1, At, B1); PG8_BAR;
            PG8_LDB(B0, 1, 0); PG8_SCHED; PG8_LDA(At, 1, 0); PG8_STAGE(PG8_SA(0, 1), a2 + hstep, voffA);
            PG8_WAIT_L(8); PG8_BAR; PG8_WAIT_L(0); PG8_MMA(0, 0, At, B0); PG8_BAR; PG8_SCHED;
            PG8_LDB(B1, 1, 1); PG8_STAGE(PG8_SB(1, 0), b3, voffB);
            PG8_BAR; PG8_WAIT_L(0); PG8_MMA(0, 1, At, B1); PG8_BAR;
            PG8_LDA(At, 1, 1); PG8_STAGE(PG8_SA(1, 0), a3, voffA);
            PG8_BAR; PG8_WAIT_L(0); PG8_MMA(1, 0, At, B0); PG8_BAR; PG8_SCHED;
            PG8_STAGE(PG8_SB(1, 1), b3 + hstep, voffB);
            PG8_WAIT_V(6); PG8_BAR; PG8_MMA(1, 1, At, B1); PG8_BAR;
            }
        }
        if constexpr (ALIGN_EPI) { if (wr == 0) PG8_BAR; }
        if constexpr (!Epi::AFTER_DRAIN) { E(acc, cur, wr, wc, fr, fq); S.done(cur); }
        if (!has_next) break;
#pragma unroll
        for (int a = 0; a < 2; ++a)
#pragma unroll
            for (int b = 0; b < 2; ++b)
#pragma unroll
                for (int m = 0; m < 4; ++m)
#pragma unroll
                    for (int n = 0; n < 2; ++n) acc[a][b][m][n] = (f32x4){0.f, 0.f, 0.f, 0.f};
        cur = nxt; cA = nA; cB = nB; ++ui;
        if constexpr (ALIGN_EPI) { if (wr == 1) PG8_BAR; }
    }
    PG8_WAIT_V(0);
    if constexpr (!ALIGN_EPI) { if (wr == 0) PG8_BAR; }
    PG8_BAR;
    if constexpr (Epi::AFTER_DRAIN) { E.fused(acc, cur, wr, wc, fr, fq, lds, wid, lane); S.done(cur); }
#undef PG8_SA
#undef PG8_SB
#undef PG8_STAGE
#undef PG8_LDA
#undef PG8_LDB
#undef PG8_MMA
#undef PG8_WAIT_V
#undef PG8_WAIT_L
#undef PG8_BAR
#undef PG8_SCHED
}
}
#define GAS __attribute__((address_space(1)))
#define LAS __attribute__((address_space(3)))
typedef unsigned short bf16;
typedef unsigned v4u __attribute__((ext_vector_type(4)));
typedef float f32x4 __attribute__((ext_vector_type(4)));
typedef short bf16x8 __attribute__((ext_vector_type(8)));
typedef GAS unsigned gu32;
typedef GAS unsigned long long gu64;
#define RLX_AGENT __ATOMIC_RELAXED, __HIP_MEMORY_SCOPE_AGENT
#define LDS_WAIT() asm volatile("s_waitcnt lgkmcnt(0)" ::: "memory")
#define VM_WAIT() asm volatile("s_waitcnt vmcnt(0)" ::: "memory")
__device__ __forceinline__ unsigned long long rt() { return __builtin_amdgcn_s_memrealtime(); }
__device__ __forceinline__ unsigned f2bf(float f) { unsigned u = __builtin_bit_cast(unsigned, f); return (u + 0x7fffu + ((u >> 16) & 1u)) >> 16; }
__device__ __forceinline__ unsigned pk2(float lo, float hi) { return f2bf(lo) | (f2bf(hi) << 16); }

#define XB_TMO      128
#define XB_XCNT(j)  (256  + 64 * (j))
#define XB_XSUB(j)  (1280 + 64 * (j))
#define XB_XGEN(j)  (2304 + 64 * (j))
#define XB_TOP      3328
#define XB_TOPGEN   3392
#define XCD_BAR_WORDS 3456
#define XB_SPIN_CAP (1u << 18)

__device__ __forceinline__ unsigned xb_ld(unsigned* p)              { return __hip_atomic_load(p, __ATOMIC_RELAXED, __HIP_MEMORY_SCOPE_AGENT); }
__device__ __forceinline__ unsigned xb_add(unsigned* p, unsigned v) { return __hip_atomic_fetch_add(p, v, __ATOMIC_RELAXED, __HIP_MEMORY_SCOPE_AGENT); }
__device__ __forceinline__ unsigned xb_xcc_id() { return (unsigned)__builtin_amdgcn_s_getreg((3 << 11) | 20) & 0xFu; }
#define XB_SPIN(cond, bar) do { unsigned _sp = 0; while (cond) { __builtin_amdgcn_s_sleep(1); \
    if ((++_sp & 255u) == 0u) { if (xb_ld(&(bar)[XB_TMO])) break; if (_sp > XB_SPIN_CAP) { atomicAdd(&(bar)[XB_TMO], 1u); break; } } } } while (0)

struct XcdBarrier {
    unsigned* bar; unsigned x;
    volatile LAS unsigned* st;
};

__device__ __forceinline__ XcdBarrier xcd_barrier_post(unsigned* bar, volatile LAS unsigned* st) {
    XcdBarrier b; b.bar = bar; b.x = xb_xcc_id(); b.st = st;
    if (threadIdx.x == 0) (void)xb_add(&bar[XB_XCNT(b.x)], 1u);
    return b;
}
__device__ __forceinline__ void xcd_barrier_complete(unsigned* bar, unsigned x, unsigned& nloc, unsigned& nx) {
    const unsigned G = gridDim.x * gridDim.y * gridDim.z;
    unsigned sum, cnt, mine, sp = 0u;
    for (;;) {
        sum = 0u; cnt = 0u; mine = 0u;
#pragma unroll
        for (unsigned j = 0; j < 16; ++j) { const unsigned c = xb_ld(&bar[XB_XCNT(j)]); sum += c; cnt += (c > 0u) ? 1u : 0u; mine = (j == x) ? c : mine; }
        if (sum == G) break;
        __builtin_amdgcn_s_sleep(1);
        if ((++sp & 255u) == 0u) { if (xb_ld(&bar[XB_TMO])) break; if (sp > XB_SPIN_CAP) { atomicAdd(&bar[XB_TMO], 1u); break; } }
    }
    nloc = mine > 0u ? mine : 1u; nx = cnt > 0u ? cnt : 1u;
}

__device__ __forceinline__ void xcd_barrier(const XcdBarrier& b) {
    asm volatile("s_waitcnt vmcnt(0)" ::: "memory");
    __syncthreads();
    if (threadIdx.x == 0) {
        unsigned* bar = b.bar;
        __builtin_amdgcn_s_waitcnt(0);
        unsigned nloc = b.st[0], nx = b.st[1];
        if (nloc == 0u) { xcd_barrier_complete(bar, b.x, nloc, nx); b.st[0] = nloc; b.st[1] = nx; }
        const unsigned old = xb_add(&bar[XB_XSUB(b.x)], 1u);
        const unsigned gen = old / nloc;
        if (old + 1u == (gen + 1u) * nloc) {
            __builtin_amdgcn_fence(__ATOMIC_RELEASE, "agent");
            asm volatile("s_waitcnt vmcnt(0)" ::: "memory");
            const unsigned og = xb_add(&bar[XB_TOP], 1u);
            const unsigned tg = og / nx;
            if (og + 1u == (tg + 1u) * nx) xb_add(&bar[XB_TOPGEN], 1u);
            else XB_SPIN(xb_ld(&bar[XB_TOPGEN]) == tg, bar);
            __builtin_amdgcn_fence(__ATOMIC_ACQUIRE, "agent");
            xb_add(&bar[XB_XGEN(b.x)], 1u);
            asm volatile("s_waitcnt vmcnt(0)" ::: "memory");
        } else {
            XB_SPIN(xb_ld(&bar[XB_XGEN(b.x)]) == gen, bar);
            __builtin_amdgcn_fence(__ATOMIC_ACQUIRE, "agent");
            asm volatile("s_waitcnt vmcnt(0)" ::: "memory");
        }
    }
    __syncthreads();
}

constexpr int NWAVES = 8, NTHR = 512;
constexpr int BATCH = 8, T = 8192, D = 1024, M = BATCH * T, DEPTH = 2;
constexpr int NPROJ = 3968, NPAD = 4096;
constexpr int HD = 64, BH = 6, CH = 6;
constexpr int PA_LD = 768, PB_LD = 1664, PC_LD = 1536;
constexpr int BSHIFT = 1280;
constexpr float LN_EPS = 1e-5f, GN_EPS = 64e-5f;
constexpr float DN_ALPHA = 1.4142135623730951f;
constexpr float LOG2E = 1.4426950408889634f;
constexpr float QSCALE = 0.125f * LOG2E;

#ifndef MK_N_LAUNCHES
#define MK_N_LAUNCHES 1
#endif
constexpr int N_PHASES = 16;

constexpr size_t MiB = 1u << 20;
constexpr size_t WS_CTL = 0, CTL_ZERO_BYTES = 1 * MiB;
constexpr size_t WS_WIN = 2 * MiB;
constexpr size_t WS_WOUT = 18 * MiB;
constexpr size_t WS_ROWSTAT = 23 * MiB;
constexpr size_t WS_XN = 32 * MiB;
constexpr size_t WS_PA = 160 * MiB;
constexpr size_t WS_PC = 256 * MiB;
constexpr size_t WS_PB = 448 * MiB;
constexpr size_t WS_OPS = 656 * MiB;
constexpr size_t WS_END = 944 * MiB;
constexpr int CW_BAR = 4096;
constexpr int CW_MOD = 16384;
static_assert((CW_MOD + 49152) * 4 <= (int)CTL_ZERO_BYTES, "ctl region");

constexpr int RING_OFF = 0, RING_BYTES = 131072;
constexpr int LDSCTL_OFF = RING_BYTES, MISC_OFF = LDSCTL_OFF + 320;
constexpr int LDS_BYTES = 147456;

struct Frame {
    LAS unsigned char* lds;
    volatile LAS unsigned* MISC;
    gu32* ctl;
    int tid, lane, wave, vcu, G;
    float* out; unsigned char* ws;
};
struct Args { const float* in[26]; float* out; unsigned char* ws; int ph_lo, ph_hi, li, pad; };
#define INP(k) (A.in[k])
__device__ __forceinline__ float bf2f(unsigned short h) { return __builtin_bit_cast(float, (unsigned)h << 16); }
__device__ __forceinline__ float bflo(unsigned u) { return __builtin_bit_cast(float, u << 16); }
__device__ __forceinline__ float bfhi(unsigned u) { return __builtin_bit_cast(float, u & 0xffff0000u); }
__device__ __forceinline__ float silu_f(float x) { return x / (1.0f + __expf(-x)); }
__device__ __forceinline__ float sigmoid_f(float x) { return 1.0f / (1.0f + __expf(-x)); }
__device__ __forceinline__ float wave_sum(float v) {
#pragma unroll
    for (int o = 1; o < 64; o <<= 1) v += __shfl_xor(v, o);
    return v;
}
__device__ __forceinline__ float wave_max(float v) {
#pragma unroll
    for (int o = 1; o < 64; o <<= 1) v = fmaxf(v, __shfl_xor(v, o));
    return v;
}

__device__ __forceinline__ void p0_transpose_item(const float* W, int K, int N, bf16* WT, int shift_from, int shift, LAS float* scr, int item, int lane) {
    const int nblk = N / 32, kb = item / nblk, nb = item % nblk, k0 = 64 * kb, n0 = 32 * nb;
#pragma unroll 8
    for (int i = 0; i < 32; ++i) { const int kk = 2 * i + (lane >> 5); scr[kk * 33 + (lane & 31)] = W[(size_t)(k0 + kk) * N + n0 + (lane & 31)]; }
    LDS_WAIT(); asm volatile("" ::: "memory");
    const int c = lane & 7;
    const int r0 = n0 + (n0 >= shift_from ? shift : 0);
#pragma unroll
    for (int j = 0; j < 4; ++j) { const int n = (lane >> 3) + 8 * j; const LAS float* s = scr + (8 * c) * 33 + n;
        v4u o; o.x = pk2(s[0 * 33], s[1 * 33]); o.y = pk2(s[2 * 33], s[3 * 33]); o.z = pk2(s[4 * 33], s[5 * 33]); o.w = pk2(s[6 * 33], s[7 * 33]);
        *(GAS v4u*)(WT + (size_t)(r0 + n) * K + k0 + 8 * c) = o; }
    LDS_WAIT(); asm volatile("" ::: "memory");
}
__device__ __forceinline__ void p0_prologue(Frame& F, const Args& A) {
    LAS float* scr = (LAS float*)(F.lds + RING_OFF + F.wave * 16384);
    const int gw = F.vcu * NWAVES + F.wave, NGW = F.G * NWAVES;
    constexpr int I_IN = (D / 64) * (NPROJ / 32);
    constexpr int I_OUT = (D / 64) * (D / 32);
    constexpr int I_MOD = 48 * 16;
    constexpr int NITEMS = 2 * (I_IN + I_OUT + I_MOD);
    float* mod = (float*)(F.ws + WS_CTL) + CW_MOD;
    for (int it = gw; it < NITEMS; it += NGW) {
        int r = it;
        if (r < 2 * I_IN) { const int l = r / I_IN; p0_transpose_item(A.in[4] + (size_t)l * D * NPROJ, D, NPROJ, (bf16*)(F.ws + WS_WIN) + (size_t)l * NPAD * D, 2432, 128, scr, r % I_IN, F.lane); continue; }
        r -= 2 * I_IN;
        if (r < 2 * I_OUT) { const int l = r / I_OUT; p0_transpose_item(A.in[23] + (size_t)l * D * D, D, D, (bf16*)(F.ws + WS_WOUT) + (size_t)l * D * D, 1 << 30, 0, scr, r % I_OUT, F.lane); continue; }
        r -= 2 * I_OUT;
        {
            const int l = r / I_MOD, rem = r % I_MOD, jb = rem / 16, ib = rem % 16, i0 = ib * 64, j = jb * 64 + F.lane;
#pragma unroll
            for (int b = 0; b < 8; ++b) scr[b * 64 + F.lane] = silu_f(A.in[1][b * D + i0 + F.lane]);
            LDS_WAIT(); asm volatile("" ::: "memory");
            float acc[8];
#pragma unroll
            for (int b = 0; b < 8; ++b) acc[b] = 0.f;
            const float* wa = A.in[2] + (size_t)l * D * 3072 + (size_t)i0 * 3072 + j;
#pragma unroll 4
            for (int i = 0; i < 64; ++i) { const float wv = wa[(size_t)i * 3072];
#pragma unroll
                for (int b = 0; b < 8; ++b) acc[b] += scr[b * 64 + i] * wv; }
            const float bb = (ib == 0) ? A.in[3][l * 3072 + j] : 0.f;
#pragma unroll
            for (int b = 0; b < 8; ++b) atomicAdd(&mod[(l * 8 + b) * 3072 + j], acc[b] + bb);
            LDS_WAIT(); asm volatile("" ::: "memory");
        }
    }
    for (int l = 0; l < 2; ++l) {
        v4u* z = (v4u*)((bf16*)(F.ws + WS_WIN) + (size_t)l * NPAD * D + (size_t)2432 * D);
        const int n16 = 128 * D * 2 / 16;
        for (int i = F.vcu * NTHR + F.tid; i < n16; i += F.G * NTHR) z[i] = (v4u){0u, 0u, 0u, 0u};
    }
}

__device__ __forceinline__ void p1a_xn(Frame& F, const Args& A, int layer) {
    const int gw = F.vcu * NWAVES + F.wave, NGW = F.G * NWAVES;
    const float* src = layer ? F.out : A.in[0];
    const float* mod = (const float*)(F.ws + WS_CTL) + CW_MOD + (size_t)layer * 8 * 3072;
    float* rowstat = (float*)(F.ws + WS_ROWSTAT);
    bf16* XN = (bf16*)(F.ws + WS_XN);
    const float* lng = A.in[24]; const float* lnb = A.in[25];
    for (int m = gw; m < M; m += NGW) {
        const int b = m / T;
        const GAS f32x4* xr = (const GAS f32x4*)(src + (size_t)m * D) + F.lane;
        f32x4 v[4];
#pragma unroll
        for (int j = 0; j < 4; ++j) v[j] = xr[64 * j];
        if (layer) {
            float s = 0.f;
#pragma unroll
            for (int j = 0; j < 4; ++j) s += (v[j].x + v[j].y) + (v[j].z + v[j].w);
            const float mean = wave_sum(s) * (1.f / D); float s2 = 0.f;
#pragma unroll
            for (int j = 0; j < 4; ++j) { v[j] = v[j] - mean; s2 += (v[j].x * v[j].x + v[j].y * v[j].y) + (v[j].z * v[j].z + v[j].w * v[j].w); }
            const float rstd = 1.f / sqrtf(wave_sum(s2) * (1.f / D) + LN_EPS);
            if (F.lane == 0) { rowstat[2 * (size_t)m] = mean; rowstat[2 * (size_t)m + 1] = rstd; }
#pragma unroll
            for (int j = 0; j < 4; ++j) { const f32x4 g = *((const f32x4*)lng + F.lane + 64 * j), bb = *((const f32x4*)lnb + F.lane + 64 * j); v[j] = v[j] * rstd * g + bb; }
        }
        const f32x4* sh = (const f32x4*)(mod + (size_t)b * 3072) + F.lane;
        const f32x4* sc = (const f32x4*)(mod + (size_t)b * 3072 + 1024) + F.lane;
        GAS unsigned long long* o8 = (GAS unsigned long long*)(XN + (size_t)m * D) + F.lane;
#pragma unroll
        for (int j = 0; j < 4; ++j) { const f32x4 h = v[j] * (sc[64 * j] + 1.0f) + sh[64 * j];
            o8[64 * j] = (unsigned long long)pk2(h.x, h.y) | ((unsigned long long)pk2(h.z, h.w) << 32); }
    }
}
__device__ __forceinline__ void p4_final(Frame& F, const Args& A) {
    const int gw = F.vcu * NWAVES + F.wave, NGW = F.G * NWAVES;
    const float* lng = A.in[24] + D; const float* lnb = A.in[25] + D;
    for (int m = gw; m < M; m += NGW) {
        GAS f32x4* xr = (GAS f32x4*)(F.out + (size_t)m * D) + F.lane;
        f32x4 v[4]; float s = 0.f;
#pragma unroll
        for (int j = 0; j < 4; ++j) { v[j] = xr[64 * j]; s += (v[j].x + v[j].y) + (v[j].z + v[j].w); }
        const float mean = wave_sum(s) * (1.f / D); float s2 = 0.f;
#pragma unroll
        for (int j = 0; j < 4; ++j) { v[j] = v[j] - mean; s2 += (v[j].x * v[j].x + v[j].y * v[j].y) + (v[j].z * v[j].z + v[j].w * v[j].w); }
        const float rstd = 1.f / sqrtf(wave_sum(s2) * (1.f / D) + LN_EPS);
#pragma unroll
        for (int j = 0; j < 4; ++j) { const f32x4 g = *((const f32x4*)lng + F.lane + 64 * j), bb = *((const f32x4*)lnb + F.lane + 64 * j); xr[64 * j] = v[j] * rstd * g + bb; }
    }
}

__device__ __forceinline__ void sgu_unit_simple(Frame& F, const Args& A, int layer, int nb) {
    LAS float* vln = (LAS float*)(F.lds + RING_OFF);
    const bf16* PA = (const bf16*)(F.ws + WS_PA);
    bf16* Y = (bf16*)(F.ws + WS_XN);
    const float* lng = A.in[5] + layer * 256; const float* lnb = A.in[6] + layer * 256;
    const float* wsp = A.in[7] + (size_t)layer * 4 * 128 * 128; const float* bsp = A.in[8] + layer * 4 * 128;
    const size_t m0 = (size_t)nb * 128;
    __syncthreads();
    {
        const int tt = F.tid >> 2, g = F.tid & 3;
        const v4u* src = (const v4u*)(PA + (m0 + tt) * PA_LD + 256 + g * 64);
        float x[64];
#pragma unroll
        for (int i = 0; i < 8; ++i) { const v4u u = src[i]; x[8 * i + 0] = bflo(u.x); x[8 * i + 1] = bfhi(u.x); x[8 * i + 2] = bflo(u.y); x[8 * i + 3] = bfhi(u.y);
            x[8 * i + 4] = bflo(u.z); x[8 * i + 5] = bfhi(u.z); x[8 * i + 6] = bflo(u.w); x[8 * i + 7] = bfhi(u.w); }
        float s = 0.f;
#pragma unroll
        for (int i = 0; i < 64; ++i) s += x[i];
        const float mean = s * (1.f / 64.f); float q = 0.f;
#pragma unroll
        for (int i = 0; i < 64; ++i) { x[i] -= mean; q += x[i] * x[i]; }
        const float rstd = 1.f / sqrtf(q * (1.f / 64.f) + LN_EPS);
#pragma unroll
        for (int i = 0; i < 64; ++i) vln[tt * 256 + g * 64 + i] = x[i] * rstd * lng[g * 64 + i] + lnb[g * 64 + i];
    }
    __syncthreads();
    {
        const int col = F.tid & 255, ph = F.tid >> 8, g = col >> 6;
        for (int p = 64 * ph; p < 64 * ph + 64; ++p) {
            const float* wr = wsp + ((size_t)g * 128 + p) * 128;
            float acc = 0.f;
            for (int q = 0; q <= p; ++q) acc += wr[q] * vln[q * 256 + col];
            const float s = acc + bsp[g * 128 + p];
            const float u = bf2f(PA[(m0 + p) * PA_LD + col]), gt = bf2f(PA[(m0 + p) * PA_LD + 512 + col]);
            Y[(m0 + p) * D + col] = (bf16)f2bf(silu_f(gt) * u * s);
        }
    }
    __syncthreads();
}

__device__ __forceinline__ void attn_item_simple(Frame& F, const Args& A, int layer, int m, int h) {
    LAS float* wq = (LAS float*)(F.lds + RING_OFF + F.wave * 4096);
    LAS float* wp = wq + 64;
    const bf16* PC = (const bf16*)(F.ws + WS_PC);
    bf16* Y = (bf16*)(F.ws + WS_XN);
    const float* tab = A.in[22] + ((size_t)layer * CH + h) * 513;
    const int t = m % T, n = t >> 6; const size_t mb = (size_t)(m - t);
    const int j0 = (n >= 8 ? n - 8 : 0) * 64, j1 = (n + 1) * 64, cnt = j1 - j0;
    wq[F.lane] = bf2f(PC[(size_t)m * PC_LD + h * 64 + F.lane]);
    LDS_WAIT(); asm volatile("" ::: "memory");
    float sc[9]; float mx = -INFINITY;
#pragma unroll
    for (int rd = 0; rd < 9; ++rd) {
        const int jj = rd * 64 + F.lane; float s = -INFINITY;
        if (jj < cnt) {
            const int kp = j0 + jj;
            const v4u* kr = (const v4u*)(PC + (mb + kp) * PC_LD + 384 + h * 64);
            float dot = 0.f;
#pragma unroll
            for (int i = 0; i < 8; ++i) { const v4u u = kr[i]; const LAS float* q = wq + 8 * i;
                dot += q[0] * bflo(u.x) + q[1] * bfhi(u.x) + q[2] * bflo(u.y) + q[3] * bfhi(u.y) + q[4] * bflo(u.z) + q[5] * bfhi(u.z) + q[6] * bflo(u.w) + q[7] * bfhi(u.w); }
            int dist = t - kp; dist = dist < -256 ? -256 : (dist > 256 ? 256 : dist);
            s = dot + tab[dist + 256] * LOG2E;
        }
        sc[rd] = s; mx = fmaxf(mx, s);
    }
    mx = wave_max(mx);
    float sum = 0.f;
#pragma unroll
    for (int rd = 0; rd < 9; ++rd) { const float p = exp2f(sc[rd] - mx); sum += p; wp[rd * 64 + F.lane] = p; }
    sum = wave_sum(sum);
    LDS_WAIT(); asm volatile("" ::: "memory");
    const bf16* vb = PC + (mb + j0) * PC_LD + 768 + h * 64 + F.lane;
    float o = 0.f;
    for (int jj = 0; jj < cnt; ++jj) o += wp[jj] * bf2f(vb[(size_t)jj * PC_LD]);
    o /= sum;
    const float g = bf2f(PC[(size_t)m * PC_LD + 1152 + h * 64 + F.lane]);
    Y[(size_t)m * D + 640 + h * 64 + F.lane] = (bf16)f2bf(silu_f(g) * o);
    LDS_WAIT(); asm volatile("" ::: "memory");
}


typedef float f32x16 __attribute__((ext_vector_type(16)));
typedef short s16x4 __attribute__((ext_vector_type(4)));
constexpr int AT_K = 0, AT_V = 16384, AT_TAB = 32768, AT_WSF = AT_TAB + 2560;
__device__ __forceinline__ int crow(int r, int hi) { return (r & 3) + 8 * (r >> 2) + 4 * hi; }
__device__ __forceinline__ s16x4 vtr(const LAS unsigned char* p) { return __builtin_bit_cast(s16x4, __builtin_amdgcn_ds_read_tr16_b64_v4i16((LAS s16x4*)p)); }
__device__ __forceinline__ void attn_unit_mfma(Frame& F, const Args& A, int layer, int u) {
    const int qi = u & 31, h = (u >> 5) % CH, b = u / (32 * CH);
    const int tid = F.tid, lane = F.lane, wid = F.wave, r32 = lane & 31, hi = lane >> 5;
    LAS unsigned char* L = F.lds + RING_OFF;
    const bf16* PC = (const bf16*)(F.ws + WS_PC);
    bf16* Y = (bf16*)(F.ws + WS_XN);
    const size_t mb = (size_t)b * T;
    const int ci = wid >> 1, qin = 32 * (wid & 1) + r32;
    const size_t qrow = mb + (size_t)(4 * qi + ci) * 64 + 32 * (wid & 1);
    const int jmin = (qi >= 2) ? 0 : 8 - 4 * qi;
    {   const float* tab = A.in[22] + ((size_t)layer * CH + h) * 513;
        LAS float* lt = (LAS float*)(L + AT_TAB);
        for (int i = tid; i < 640; i += NTHR) lt[i] = tab[i < 512 ? i : 512] * LOG2E; }
    bf16x8 qr[4];
#pragma unroll
    for (int d0 = 0; d0 < 4; ++d0) qr[d0] = *(const bf16x8*)(PC + (qrow + r32) * PC_LD + h * 64 + d0 * 16 + hi * 8);
    const bf16* ksrc = PC + (mb + (size_t)(4 * qi - 8) * 64 + lane) * PC_LD + 384 + h * 64 + wid * 8;
    const bf16* vsrc = PC + (mb + (size_t)(4 * qi - 8) * 64 + 16 * (wid & 3) + (lane >> 2)) * PC_LD + 768 + h * 64 + (wid >> 2) * 32 + (lane & 3) * 8;
    v4u kreg = *(const v4u*)(ksrc + (size_t)jmin * 64 * PC_LD), vreg = *(const v4u*)(vsrc + (size_t)jmin * 64 * PC_LD);
    f32x16 o0 = {}, o1 = {};
    float mref = 0.f, lsum = 0.f; bool first = true;
    const float tabc = A.in[22][((size_t)layer * CH + h) * 513 + 512] * LOG2E;
    for (int j = jmin; j < 12; ++j) {
        const int slot = (j - jmin) & 1;
        *(LAS v4u*)(L + AT_K + slot * 8192 + wid * 1024 + lane * 16) = kreg;
        *(LAS v4u*)(L + AT_V + slot * 8192 + wid * 1024 + lane * 16) = vreg;
        __syncthreads();
        if (j < 11) { kreg = *(const v4u*)(ksrc + (size_t)(j + 1) * 64 * PC_LD); vreg = *(const v4u*)(vsrc + (size_t)(j + 1) * 64 * PC_LD); }
        if (j >= ci && j <= ci + 8) {
            const int cd = ci + 8 - j;
            const LAS unsigned char* kb = L + AT_K + slot * 8192 + hi * 1024 + r32 * 16;
            f32x16 p0 = {}, p1 = {};
#pragma unroll
            for (int d0 = 0; d0 < 4; ++d0) {
                const bf16x8 b0 = *(const LAS bf16x8*)(kb + d0 * 2048), b1 = *(const LAS bf16x8*)(kb + d0 * 2048 + 512);
                p0 = __builtin_amdgcn_mfma_f32_32x32x16_bf16(b0, qr[d0], p0, 0, 0, 0);
                p1 = __builtin_amdgcn_mfma_f32_32x32x16_bf16(b1, qr[d0], p1, 0, 0, 0);
            }
            if (cd >= 5) {
#pragma unroll
                for (int r = 0; r < 16; ++r) { p0[r] += tabc; p1[r] += tabc; }
            } else {
                const LAS unsigned char* tb = L + AT_TAB + 4 * (64 * cd + 256 + qin - 4 * hi - 63);
#pragma unroll
                for (int r = 0; r < 16; ++r) {
                    p0[r] += *(const LAS float*)(tb + 4 * (63 - ((r & 3) + 8 * (r >> 2))));
                    p1[r] += *(const LAS float*)(tb + 4 * (63 - ((r & 3) + 8 * (r >> 2) + 32)));
                }
            }
            if (first) {
                float mx = p0[0];
#pragma unroll
                for (int r = 0; r < 16; ++r) mx = fmaxf(mx, fmaxf(p0[r], p1[r]));
                const unsigned um = __float_as_uint(mx);
                auto rr = __builtin_amdgcn_permlane32_swap(um, um, false, false);
                const unsigned m0 = rr[0], m1 = rr[1];
                mref = fmaxf(__uint_as_float(m0), __uint_as_float(m1));
                first = false;
            }
            float sacc = 0.f;
#pragma unroll
            for (int r = 0; r < 16; ++r) { p0[r] = exp2f(p0[r] - mref); p1[r] = exp2f(p1[r] - mref); sacc += p0[r] + p1[r]; }
            lsum += sacc;
            v4u pw0, pw1, pw2, pw3;
            pw0.x = pg8::cvt_pk_bf16(p0[0], p0[1]); pw0.y = pg8::cvt_pk_bf16(p0[2], p0[3]); pw0.z = pg8::cvt_pk_bf16(p0[4], p0[5]); pw0.w = pg8::cvt_pk_bf16(p0[6], p0[7]);
            pw1.x = pg8::cvt_pk_bf16(p0[8], p0[9]); pw1.y = pg8::cvt_pk_bf16(p0[10], p0[11]); pw1.z = pg8::cvt_pk_bf16(p0[12], p0[13]); pw1.w = pg8::cvt_pk_bf16(p0[14], p0[15]);
            pw2.x = pg8::cvt_pk_bf16(p1[0], p1[1]); pw2.y = pg8::cvt_pk_bf16(p1[2], p1[3]); pw2.z = pg8::cvt_pk_bf16(p1[4], p1[5]); pw2.w = pg8::cvt_pk_bf16(p1[6], p1[7]);
            pw3.x = pg8::cvt_pk_bf16(p1[8], p1[9]); pw3.y = pg8::cvt_pk_bf16(p1[10], p1[11]); pw3.z = pg8::cvt_pk_bf16(p1[12], p1[13]); pw3.w = pg8::cvt_pk_bf16(p1[14], p1[15]);
            const LAS unsigned char* vb = L + AT_V + slot * 8192 + ((lane >> 4) & 1) * 32 + (lane & 3) * 8 + (4 * hi + ((lane & 15) >> 2)) * 64;
#define AT_PV(OACC, D0) do { \
            s16x4 lo0 = vtr(vb + (D0) * 4096), hi0 = vtr(vb + (D0) * 4096 + 512), lo1 = vtr(vb + (D0) * 4096 + 1024), hi1 = vtr(vb + (D0) * 4096 + 1536), \
                  lo2 = vtr(vb + (D0) * 4096 + 2048), hi2 = vtr(vb + (D0) * 4096 + 2560), lo3 = vtr(vb + (D0) * 4096 + 3072), hi3 = vtr(vb + (D0) * 4096 + 3584); \
            OACC = __builtin_amdgcn_mfma_f32_32x32x16_bf16(__builtin_bit_cast(bf16x8, pw0), ((bf16x8){lo0[0], lo0[1], lo0[2], lo0[3], hi0[0], hi0[1], hi0[2], hi0[3]}), OACC, 0, 0, 0); \
            OACC = __builtin_amdgcn_mfma_f32_32x32x16_bf16(__builtin_bit_cast(bf16x8, pw1), ((bf16x8){lo1[0], lo1[1], lo1[2], lo1[3], hi1[0], hi1[1], hi1[2], hi1[3]}), OACC, 0, 0, 0); \
            OACC = __builtin_amdgcn_mfma_f32_32x32x16_bf16(__builtin_bit_cast(bf16x8, pw2), ((bf16x8){lo2[0], lo2[1], lo2[2], lo2[3], hi2[0], hi2[1], hi2[2], hi2[3]}), OACC, 0, 0, 0); \
            OACC = __builtin_amdgcn_mfma_f32_32x32x16_bf16(__builtin_bit_cast(bf16x8, pw3), ((bf16x8){lo3[0], lo3[1], lo3[2], lo3[3], hi3[0], hi3[1], hi3[2], hi3[3]}), OACC, 0, 0, 0); } while (0)
            AT_PV(o0, 0); AT_PV(o1, 1);
#undef AT_PV
        }
    }
    {   const unsigned ul = __float_as_uint(lsum);
        auto rr = __builtin_amdgcn_permlane32_swap(ul, ul, false, false);
        const unsigned l0 = rr[0], l1 = rr[1];
        const float lt = __uint_as_float(l0) + __uint_as_float(l1);
        LAS float* wsf = (LAS float*)(L + AT_WSF) + wid * 32;
        if (hi == 0) wsf[r32] = lt;
        LDS_WAIT(); asm volatile("" ::: "memory");
#pragma unroll
        for (int r = 0; r < 16; ++r) {
            const int q = crow(r, hi);
            const float rl = 1.0f / wsf[q];
            const size_t row = qrow + q;
            const float g0 = bf2f(PC[row * PC_LD + 1152 + h * 64 + r32]), g1 = bf2f(PC[row * PC_LD + 1152 + h * 64 + 32 + r32]);
            Y[row * D + 640 + h * 64 + r32] = (bf16)f2bf(silu_f(g0) * o0[r] * rl);
            Y[row * D + 640 + h * 64 + 32 + r32] = (bf16)f2bf(silu_f(g1) * o1[r] * rl);
        }
    }
    __syncthreads();
}
__device__ __forceinline__ float softplus_f(float x) { return fmaxf(x, 0.f) + log1pf(__expf(-fabsf(x))); }
__device__ __forceinline__ void rwkv_pre_simple(Frame& F, const Args& A, int layer) {
    LAS float* lw = (LAS float*)(F.lds + RING_OFF);
    LAS float* la = lw + 64;
    LAS float* vs = la + 64;
    LAS float* h1 = vs + 384;
    LAS float* k2 = h1 + 32;
    const bf16* PB = (const bf16*)(F.ws + WS_PB);
    bf16* OPS = (bf16*)(F.ws + WS_OPS);
    const float* mu = A.in[9] + layer * BSHIFT;
    const float* w0 = A.in[10] + layer * 384; const float* w2 = A.in[11] + (size_t)layer * 64 * 384;
    const float* a0 = A.in[12] + layer * 384; const float* a2 = A.in[13] + (size_t)layer * 64 * 384;
    const float* kkp = A.in[14] + layer * 384; const float* kap = A.in[15] + layer * 384;
    const float* v0 = A.in[19]; const float* v1 = A.in[20]; const float* v2 = A.in[21];
    const int per = M / F.G;
    const int tid = F.tid;
    for (int m = F.vcu * per; m < (F.vcu + 1) * per; ++m) {
        const int t = m % T, b = m / T;
        const bf16* pc = PB + (size_t)m * PB_LD; const bf16* pp = pc - PB_LD;
        float xr = 0.f, xk = 0.f, xv = 0.f;
        if (tid < 384) {
            const float c0 = bf2f(pc[tid]), c1 = bf2f(pc[384 + tid]), c2 = bf2f(pc[768 + tid]);
            const float p0 = t ? bf2f(pp[tid]) : 0.f, p1 = t ? bf2f(pp[384 + tid]) : 0.f, p2 = t ? bf2f(pp[768 + tid]) : 0.f;
            xr = c0 + (p0 - c0) * mu[tid]; xk = c1 + (p1 - c1) * mu[384 + tid]; xv = c2 + (p2 - c2) * mu[768 + tid];
            vs[tid] = xv;
        } else {
            const int i = tid - 384, col = 1152 + i;
            const float c0 = bf2f(pc[col]), p0 = t ? bf2f(pp[col]) : 0.f;
            const float xl = c0 + (p0 - c0) * mu[col];
            if (i < 64) lw[i] = tanhf(xl); else la[i - 64] = xl;
        }
        __syncthreads();
        float wlin = 0.f, alin = 0.f;
        if (tid < 384) {
#pragma unroll 8
            for (int i = 0; i < 64; ++i) { wlin += lw[i] * w2[i * 384 + tid]; alin += la[i] * a2[i * 384 + tid]; }
        } else if (layer && tid < 384 + 32) {
            const int n = tid - 384; float acc = 0.f;
            for (int j = 0; j < 384; ++j) acc += vs[j] * v1[j * 32 + n];
            h1[n] = acc;
        }
        float kk = 0.f;
        if (tid < 384) { kk = xk * kkp[tid]; k2[tid] = kk * kk; }
        __syncthreads();
        if (tid < 384) {
            const int hh = tid >> 6, cc = tid & 63;
            const size_t oidx = ((size_t)(b * BH + hh) * T + t) * 384 + cc;
            if (layer) {
                float vl = 0.f;
#pragma unroll 8
                for (int n = 0; n < 32; ++n) vl += h1[n] * v2[n * 384 + tid];
                const float vf = bf2f(OPS[oidx + 3 * 64]);
                xv = xv + (vf - xv) * sigmoid_f(v0[tid] + vl);
            }
            const float w = -softplus_f(-(w0[tid] + wlin)) - 0.5f;
            const float dw = -expm1f(-__expf(w));
            const float a = sigmoid_f(a0[tid] + alin);
            float hs = 0.f;
#pragma unroll 8
            for (int i = 0; i < 64; ++i) hs += k2[hh * 64 + i];
            const float kn = kk / fmaxf(sqrtf(hs), 1e-12f);
            const float kq = xk * (1.f + (a - 1.f) * kap[tid]);
            OPS[oidx] = (bf16)f2bf(xr); OPS[oidx + 64] = (bf16)f2bf(dw); OPS[oidx + 128] = (bf16)f2bf(kq);
            OPS[oidx + 192] = (bf16)f2bf(xv); OPS[oidx + 256] = (bf16)f2bf(-kn); OPS[oidx + 320] = (bf16)f2bf(kn * a);
        }
        __syncthreads();
    }
}

__device__ __forceinline__ float allred32(float x) {
    x += __shfl_xor(x, 1); x += __shfl_xor(x, 2); x += __shfl_xor(x, 4); x += __shfl_xor(x, 8); x += __shfl_xor(x, 16);
    return x;
}
__device__ __forceinline__ void rwkv_scan_simple(Frame& F, int unit) {
    const int bh = unit >> 2, qt = unit & 3, b = bh / BH, h = bh % BH;
    const int row = 16 * qt + 2 * F.wave + (F.lane >> 5), kp = F.lane & 31;
    const unsigned* op = (const unsigned*)(F.ws + WS_OPS) + (size_t)bh * T * 192;
    unsigned char* yb = F.ws + WS_PB + (size_t)b * T * (PB_LD * 2) + (size_t)(h * 64 + row) * 4;
    float s0 = 0.f, s1 = 0.f, ykeep = 0.f;
    for (int t0 = 0; t0 < T; t0 += 32) {
#pragma unroll 4
        for (int tt = 0; tt < 32; ++tt) {
            const unsigned* o = op + (size_t)(t0 + tt) * 192;
            const unsigned ur = o[kp], udw = o[32 + kp], uk = o[64 + kp], ua = o[128 + kp], ub = o[160 + kp];
            const float vv = bf2f(((const unsigned short*)(o + 96))[row]);
            const float sa = allred32(s0 * bflo(ua) + s1 * bfhi(ua));
            s0 = s0 * (1.f - bflo(udw)) + (sa * bflo(ub) + vv * bflo(uk));
            s1 = s1 * (1.f - bfhi(udw)) + (sa * bfhi(ub) + vv * bfhi(uk));
            const float y = allred32(s0 * bflo(ur) + s1 * bfhi(ur));
            if (kp == tt) ykeep = y;
        }
        *(float*)(yb + (size_t)(t0 + kp) * (PB_LD * 2)) = ykeep;
    }
}

template <int CTRL> __device__ __forceinline__ float dppx(float x) { return __int_as_float(__builtin_amdgcn_update_dpp(0, __float_as_int(x), CTRL, 0xf, 0xf, true)); }
__device__ __forceinline__ float allred32_dpp(float x) {
    x += dppx<0xB1>(x); x += dppx<0x4E>(x); x += dppx<0x141>(x); x += dppx<0x140>(x);
    const unsigned u = __float_as_uint(x);
    auto r = __builtin_amdgcn_permlane16_swap(u, u, false, false);
    const unsigned r0 = r[0], r1 = r[1];
    return __uint_as_float(r0) + __uint_as_float(r1);
}
constexpr int SC_CH = 32, SC_VEC = (SC_CH / 2) * 512, SC_VOFF = 5 * SC_VEC, SC_BUF = SC_VOFF + (SC_CH / 2) * 128;
typedef float f32x2g __attribute__((ext_vector_type(2)));
__device__ __forceinline__ void scan_write_chunk(LAS unsigned char* Lb, const v4u (&st)[3], int tid, int qt) {
#pragma unroll
    for (int i = 0; i < 3; ++i) {
        const int p = tid + 512 * i, step = p / 48, q = p - step * 48, vec = q >> 3, e0 = (q & 7) * 8;
        float f[8] = {bflo(st[i].x), bfhi(st[i].x), bflo(st[i].y), bfhi(st[i].y), bflo(st[i].z), bfhi(st[i].z), bflo(st[i].w), bfhi(st[i].w)};
        if (vec == 1) {
#pragma unroll
            for (int j = 0; j < 8; ++j) f[j] = 1.0f - f[j];
        }
        const int slot = (0x207314 >> (4 * vec)) & 7;
        if (vec != 3) {
            LAS unsigned char* d = Lb + slot * SC_VEC + (step >> 1) * 512 + (e0 >> 1) * 16 + (step & 1) * 8;
#pragma unroll
            for (int j = 0; j < 4; ++j) *(LAS f32x2g*)(d + j * 16) = (f32x2g){f[2 * j], f[2 * j + 1]};
        } else if ((e0 >> 4) == qt) {
            LAS unsigned char* d = Lb + SC_VOFF + (step >> 1) * 128 + (e0 & 15) * 8 + (step & 1) * 4;
#pragma unroll
            for (int j = 0; j < 8; ++j) *(LAS float*)(d + j * 8) = f[j];
        }
    }
}
__device__ __forceinline__ void rwkv_scan_lds(Frame& F, int unit) {
    const int bh = unit >> 2, qt = unit & 3, b = bh / BH, h = bh % BH;
    const int half = F.lane >> 5, kp = F.lane & 31, rloc = 2 * F.wave + half, row = 16 * qt + rloc;
    LAS unsigned char* L = F.lds + RING_OFF;
    const unsigned char* ops = F.ws + WS_OPS + (size_t)bh * T * 768;
    unsigned char* yb = F.ws + WS_PB + (size_t)b * T * (PB_LD * 2) + (size_t)(h * 64 + row) * 4;
    v4u st[3];
    __syncthreads();
#pragma unroll
    for (int i = 0; i < 3; ++i) st[i] = *(const v4u*)(ops + (size_t)(F.tid + 512 * i) * 16);
    scan_write_chunk(L, st, F.tid, qt);
    __syncthreads();
    float s0 = 0.f, s1 = 0.f;
    constexpr int NCH = T / SC_CH;
    for (int c = 0; c < NCH; ++c) {
        if (c + 1 < NCH) {
#pragma unroll
            for (int i = 0; i < 3; ++i) st[i] = *(const v4u*)(ops + (size_t)(c + 1) * (SC_CH * 768) + (size_t)(F.tid + 512 * i) * 16);
        }
        const LAS unsigned char* Lb = L + (c & 1) * SC_BUF + kp * 16;
        const LAS unsigned char* Lv = L + (c & 1) * SC_BUF + SC_VOFF + rloc * 8;
        float ykeep = 0.f;
#pragma unroll
        for (int tp = 0; tp < SC_CH / 2; ++tp) {
            const f32x4 a4 = *(const LAS f32x4*)(Lb + tp * 512), w4 = *(const LAS f32x4*)(Lb + SC_VEC + tp * 512), b4 = *(const LAS f32x4*)(Lb + 2 * SC_VEC + tp * 512),
                        k4 = *(const LAS f32x4*)(Lb + 3 * SC_VEC + tp * 512), r4 = *(const LAS f32x4*)(Lb + 4 * SC_VEC + tp * 512);
            const f32x2g v2 = *(const LAS f32x2g*)(Lv + tp * 128);
            {   const float sa = allred32_dpp(s0 * a4.x + s1 * a4.y);
                s0 = s0 * w4.x + (sa * b4.x + v2.x * k4.x);
                s1 = s1 * w4.y + (sa * b4.y + v2.x * k4.y);
                const float y = allred32_dpp(s0 * r4.x + s1 * r4.y);
                if (kp == 2 * tp) ykeep = y; }
            {   const float sa = allred32_dpp(s0 * a4.z + s1 * a4.w);
                s0 = s0 * w4.z + (sa * b4.z + v2.y * k4.z);
                s1 = s1 * w4.w + (sa * b4.w + v2.y * k4.w);
                const float y = allred32_dpp(s0 * r4.z + s1 * r4.w);
                if (kp == 2 * tp + 1) ykeep = y; }
        }
        *(float*)(yb + (size_t)(c * SC_CH + kp) * (PB_LD * 2)) = ykeep;
        if (c + 1 < NCH) scan_write_chunk(L + ((c + 1) & 1) * SC_BUF, st, F.tid, qt);
        __syncthreads();
    }
}
__device__ __forceinline__ void rwkv_post_simple(Frame& F, const Args& A, int layer) {
    const unsigned char* PBb = F.ws + WS_PB;
    const bf16* OPS = (const bf16*)(F.ws + WS_OPS);
    bf16* Y = (bf16*)(F.ws + WS_XN);
    const float* rk = A.in[16] + layer * 384; const float* lg = A.in[17] + layer * 384; const float* lb = A.in[18] + layer * 384;
    const int sub = F.lane & 7;
    const long ngrp = (long)M * BH;
    for (long gi = ((long)F.vcu * NTHR + F.tid) >> 3; gi < ngrp; gi += ((long)F.G * NTHR) >> 3) {
        const int m = (int)(gi / BH), h = (int)(gi % BH), t = m % T, b = m / T;
        const unsigned char* prow = PBb + (size_t)m * (PB_LD * 2);
        const f32x4 y0 = *(const f32x4*)(prow + (h * 64 + sub * 8) * 4), y1 = *(const f32x4*)(prow + (h * 64 + sub * 8) * 4 + 16);
        float y[8] = {y0.x, y0.y, y0.z, y0.w, y1.x, y1.y, y1.z, y1.w};
        const size_t oidx = ((size_t)(b * BH + h) * T + t) * 384 + sub * 8;
        const v4u ur = *(const v4u*)(OPS + oidx), uk = *(const v4u*)(OPS + oidx + 128), uv = *(const v4u*)(OPS + oidx + 192);
        const v4u ug = *(const v4u*)(prow + (1280 + h * 64 + sub * 8) * 2);
        float r[8] = {bflo(ur.x), bfhi(ur.x), bflo(ur.y), bfhi(ur.y), bflo(ur.z), bfhi(ur.z), bflo(ur.w), bfhi(ur.w)};
        float k[8] = {bflo(uk.x), bfhi(uk.x), bflo(uk.y), bfhi(uk.y), bflo(uk.z), bfhi(uk.z), bflo(uk.w), bfhi(uk.w)};
        float v[8] = {bflo(uv.x), bfhi(uv.x), bflo(uv.y), bfhi(uv.y), bflo(uv.z), bfhi(uv.z), bflo(uv.w), bfhi(uv.w)};
        float g[8] = {bflo(ug.x), bfhi(ug.x), bflo(ug.y), bfhi(ug.y), bflo(ug.z), bfhi(ug.z), bflo(ug.w), bfhi(ug.w)};
        float s = 0.f, bon = 0.f;
#pragma unroll
        for (int i = 0; i < 8; ++i) { s += y[i]; bon += r[i] * k[i] * rk[h * 64 + sub * 8 + i]; }
        s += __shfl_xor(s, 1); s += __shfl_xor(s, 2); s += __shfl_xor(s, 4);
        bon += __shfl_xor(bon, 1); bon += __shfl_xor(bon, 2); bon += __shfl_xor(bon, 4);
        const float mean = s * (1.f / 64.f); float q = 0.f;
#pragma unroll
        for (int i = 0; i < 8; ++i) { y[i] -= mean; q += y[i] * y[i]; }
        q += __shfl_xor(q, 1); q += __shfl_xor(q, 2); q += __shfl_xor(q, 4);
        const float rstd = 1.f / sqrtf(q * (1.f / 64.f) + GN_EPS);
        float o[8];
#pragma unroll
        for (int i = 0; i < 8; ++i) { const int c = h * 64 + sub * 8 + i; o[i] = silu_f(g[i]) * (y[i] * rstd * lg[c] + lb[c] + bon * v[i]); }
        v4u w; w.x = pk2(o[0], o[1]); w.y = pk2(o[2], o[3]); w.z = pk2(o[4], o[5]); w.w = pk2(o[6], o[7]);
        *(v4u*)(Y + (size_t)m * D + 256 + h * 64 + sub * 8) = w;
    }
}


#define IN(k) (lo <= (k) && (k) < hi)
#define SEAM(k) do { if (IN(k) && IN((k) + 1)) xcd_barrier(bar); } while (0)
template <int layer> __device__ __forceinline__ void layer_phases(Frame& F, const Args& args, const int lo, const int hi, const XcdBarrier& bar) {
    constexpr int pb = 1 + 6 * layer;
    const float* mod = (const float*)(F.ws + WS_CTL) + CW_MOD + (size_t)layer * 8 * 3072;
    if (IN(pb + 0)) { p1a_xn(F, args, layer); } SEAM(pb + 0);
    if (IN(pb + 1)) {
        pg8::Gemm g{(const pg8::bf16_t*)(F.ws + WS_XN), (const pg8::bf16_t*)(F.ws + WS_WIN) + (size_t)layer * NPAD * D, M, NPAD, D};
        pg8::StaticOrder S; S.init(M, NPAD, F.G, (int)blockIdx.x);
        pg8::EpiProj E{(pg8::bf16_t*)(F.ws + WS_PA), (pg8::bf16_t*)(F.ws + WS_PB), (pg8::bf16_t*)(F.ws + WS_PC), QSCALE};
        pg8::gemm_phase<pg8::EpiProj, pg8::StaticOrder, true, true>(F.lds + RING_OFF, g, S, E);
    } SEAM(pb + 1);
    if (IN(pb + 2)) {
        rwkv_pre_simple(F, args, layer);
        for (int nb = F.vcu; nb < M / 128; nb += F.G) sgu_unit_simple(F, args, layer, nb);
        __syncthreads();
        for (int u = F.vcu; u < BATCH * CH * 32; u += F.G) attn_unit_mfma(F, args, layer, u);
    } SEAM(pb + 2);
    if (IN(pb + 3)) { if (F.vcu < 192) rwkv_scan_lds(F, F.vcu); } SEAM(pb + 3);
    if (IN(pb + 4)) { rwkv_post_simple(F, args, layer); } SEAM(pb + 4);
    if (IN(pb + 5)) {
        pg8::Gemm g{(const pg8::bf16_t*)(F.ws + WS_XN), (const pg8::bf16_t*)(F.ws + WS_WOUT) + (size_t)layer * D * D, M, D, D};
        pg8::StaticOrder S; S.init(M, D, F.G, (int)blockIdx.x);
        pg8::EpiRes E{layer ? (const float*)F.out : args.in[0], F.out, mod + 2048, layer, (const float*)(F.ws + WS_ROWSTAT), args.in[24], args.in[25], DN_ALPHA};
        pg8::gemm_phase<pg8::EpiRes, pg8::StaticOrder, true, true>(F.lds + RING_OFF, g, S, E);
    } SEAM(pb + 5);
}
__global__ void __launch_bounds__(NTHR, 2) fwd_kernel(Args args) {
    extern __shared__ __attribute__((aligned(16))) unsigned char lds[];
    Frame F;
    F.lds = (LAS unsigned char*)lds;
    F.MISC = (volatile LAS unsigned*)(F.lds + MISC_OFF);
    F.tid = threadIdx.x; F.lane = F.tid & 63; F.wave = __builtin_amdgcn_readfirstlane(F.tid >> 6);
    F.G = gridDim.x; { const int bx = blockIdx.x; F.vcu = (F.G % 8 == 0) ? (bx % 8) * (F.G / 8) + bx / 8 : bx; }
    F.out = args.out; F.ws = args.ws;
    F.ctl = (gu32*)(args.ws + WS_CTL);
    for (int u = F.tid; u < (LDS_BYTES - LDSCTL_OFF) / 4; u += NTHR) ((LAS unsigned*)(F.lds + LDSCTL_OFF))[u] = 0u;
    __syncthreads();
    const int lo = args.ph_lo, hi = args.ph_hi;
    XcdBarrier bar; bar.bar = (unsigned*)(F.ctl + CW_BAR); bar.x = 0; bar.st = nullptr;
    if (hi - lo > 1) bar = xcd_barrier_post((unsigned*)(F.ctl + CW_BAR), F.MISC + 8);

    if (IN(0)) { p0_prologue(F, args); } SEAM(0);
    layer_phases<0>(F, args, lo, hi, bar);
    layer_phases<1>(F, args, lo, hi, bar);
    if (IN(13)) { p4_final(F, args); }
#undef IN
#undef SEAM
}

extern "C" void kernel_launch(void* const* d_in, const int* in_sizes, int n_in, void* d_out, int out_size, void* d_ws, size_t ws_size, hipStream_t stream) {
    static int grid = 0;
    if (grid == 0) {
        if (n_in != 26 || in_sizes[0] != M * D || out_size != M * D || ws_size < WS_END) { fprintf(stderr, "kernel_launch: unexpected shapes: n_in %d in0 %d out %d ws %zu (need %zu)\n", n_in, n_in > 0 ? in_sizes[0] : -1, out_size, ws_size, (size_t)WS_END); grid = -1; return; }
        int dev = 0, cus = 0;
        if (hipGetDevice(&dev) != hipSuccess || hipDeviceGetAttribute(&cus, hipDeviceAttributeMultiprocessorCount, dev) != hipSuccess) { grid = -1; return; }
        if (hipFuncSetAttribute((const void*)fwd_kernel, hipFuncAttributeMaxDynamicSharedMemorySize, LDS_BYTES) != hipSuccess) { fprintf(stderr, "kernel_launch: hipFuncSetAttribute failed\n"); grid = -1; return; }
        int per_cu = 0;
        if (hipOccupancyMaxActiveBlocksPerMultiprocessor(&per_cu, (const void*)fwd_kernel, NTHR, LDS_BYTES) != hipSuccess || per_cu < 1) fprintf(stderr, "kernel_launch: occupancy query says %d\n", per_cu);
        (void)hipGetLastError();
        grid = cus;
        if (grid != 256) fprintf(stderr, "kernel_launch: grid %d != 256\n", grid);
    }
    if (grid < 0) return;
    if (hipMemsetAsync((char*)d_ws + WS_CTL, 0, CTL_ZERO_BYTES, stream) != hipSuccess) return;
    Args a{};
    for (int i = 0; i < 26; ++i) a.in[i] = (const float*)d_in[i];
    a.out = (float*)d_out; a.ws = (unsigned char*)d_ws;
    if (MK_N_LAUNCHES == 1) {
        a.ph_lo = 0; a.ph_hi = 14; a.li = 0;
        hipLaunchKernelGGL(fwd_kernel, dim3(grid), dim3(NTHR), LDS_BYTES, stream, a);
    } else {
        for (int p = 0; p < 14; ++p) { a.ph_lo = p; a.ph_hi = p + 1; a.li = p;
            hipLaunchKernelGGL(fwd_kernel, dim3(grid), dim3(NTHR), LDS_BYTES, stream, a); }
    }
}
```

```cpp
#include <hip/hip_runtime.h>
#include <cstdio>
#include <cstdint>
#include <cmath>
#ifndef MK_N_LAUNCHES
#define MK_N_LAUNCHES 1
#endif
namespace pg8 {
#define PG8_LAS __attribute__((address_space(3)))
typedef unsigned short bf16_t;
typedef short bf16x8 __attribute__((ext_vector_type(8)));
typedef float f32x4 __attribute__((ext_vector_type(4)));
typedef unsigned u32x4 __attribute__((ext_vector_type(4)));
constexpr int BM = 256, BK = 64, HALF = 128, HTB = HALF * BK * 2  , STAGE_BYTES = 8 * HTB, NXCD = 8, WGM = 8;

__host__ __device__ __forceinline__ int lds_byte(int r, int c) { const int st = (r >> 4) * 2 + (c >> 5), rr = r & 15, cc = c & 31, ob = rr * 64 + cc * 2; return st * 1024 + (ob ^ (((ob >> 9) & 1) << 5)); }
__host__ __device__ __forceinline__ void stage_rc(int b, int& R, int& C) { const int st = b / 1024, sb = b % 1024, swz = sb ^ (((sb >> 9) & 1) << 5); R = (st >> 1) * 16 + swz / 64; C = (st & 1) * 32 + (swz % 64) / 2; }
__host__ __device__ __forceinline__ int perm32(int rho) { const int n = rho >> 4, i = rho & 15; return 8 * (i >> 2) + 4 * n + (i & 3); }

struct Unit { int pm, pn; };
struct Gemm { const bf16_t* A; const bf16_t* Bt; int M, N, K; };

struct StaticOrder {
    int nM, nN, nwg, G, c;
    __host__ __device__ void init(int M, int N, int G_, int c_) { nM = M / BM; nN = N / BM; nwg = nM * nN; G = G_; c = c_; }
    __host__ __device__ bool next(int i, Unit& u) const {
        const long L = (long)i * G + c; if (L >= nwg) return false;
        int wgid = (int)L; { const int q = nwg / NXCD, r = nwg % NXCD, xcd = wgid % NXCD, off = wgid / NXCD; wgid = (xcd < r ? xcd * (q + 1) : r * (q + 1) + (xcd - r) * q) + off; }
        const int nig = WGM * nN, gid = wgid / nig, fm = gid * WGM, gsz = (nM - fm) < WGM ? (nM - fm) : WGM;
        u.pm = fm + ((wgid % nig) % gsz); u.pn = (wgid % nig) / gsz; return true;
    }
    __device__ __forceinline__ void a_ready(const Unit&) const {}
    __device__ __forceinline__ void done(const Unit&) const {}
};

__device__ __forceinline__ unsigned cvt_pk_bf16(float lo, float hi) { unsigned r; asm volatile("v_cvt_pk_bf16_f32 %0, %1, %2" : "=v"(r) : "v"(lo), "v"(hi)); return r; }
typedef float f32x2 __attribute__((ext_vector_type(2)));
typedef float f32x2 __attribute__((ext_vector_type(2)));
struct EpiProj {
    static constexpr bool PERM = true, AFTER_DRAIN = false;
    bf16_t* pa; bf16_t* pb; bf16_t* pc; float qscale;
    __device__ __forceinline__ void operator()(const f32x4 (&acc)[2][2][4][2], const Unit& u, int wr, int wc, int fr, int fq) const {
        const int row0 = u.pm * BM + wr * 64 + fr;
        bf16_t* base; int ldc, colt; float sc0 = 1.f, sc1 = 1.f;
        if (u.pn < 3) { base = pa; ldc = 768; colt = u.pn * 256; }
        else if (u.pn < 10) { base = pb; ldc = 1664; colt = (u.pn - 3) * 256; }
        else { base = pc; ldc = 1536; colt = (u.pn - 10) * 256; if (u.pn == 10) { sc0 = qscale; sc1 = qscale; } else if (u.pn == 11) { sc0 = qscale; } }
        const bool skip1 = (u.pn == 9);
        const int col0 = colt + wc * 32 + 8 * fq;
#pragma unroll
        for (int ai = 0; ai < 2; ++ai)
#pragma unroll
            for (int m = 0; m < 4; ++m) { bf16_t* rowp = base + (size_t)(row0 + ai * HALF + m * 16) * ldc + col0;
#pragma unroll
                for (int bj = 0; bj < 2; ++bj) { if (bj == 1 && skip1) continue;
                    const float sc = bj ? sc1 : sc0;
                    const f32x4 v0 = acc[ai][bj][m][0] * sc, v1 = acc[ai][bj][m][1] * sc;
                    u32x4 w; w.x = cvt_pk_bf16(v0[0], v0[1]); w.y = cvt_pk_bf16(v0[2], v0[3]); w.z = cvt_pk_bf16(v1[0], v1[1]); w.w = cvt_pk_bf16(v1[2], v1[3]);
                    *(u32x4*)(rowp + bj * HALF) = w; } }
    }
};
struct EpiRes {
    static constexpr bool PERM = false, AFTER_DRAIN = false;
    const float* xres; float* out; const float* gate1;   int layer; const float* rowstat; const float* lng; const float* lnb; float alpha;
    __device__ __forceinline__ void operator()(const f32x4 (&acc)[2][2][4][2], const Unit& u, int wr, int wc, int fr, int fq) const {
        const int b = u.pm >> 5;
        const float* g = gate1 + (size_t)b * 3072;
        const int col0 = u.pn * BM + wc * 32 + 4 * fq;
#pragma unroll
        for (int bj = 0; bj < 2; ++bj)
#pragma unroll
            for (int n = 0; n < 2; ++n) {
                const int c = col0 + bj * HALF + n * 16;
                const f32x4 gv = *(const f32x4*)(g + c) + 1.0f;
                f32x4 lg = (f32x4){1.f, 1.f, 1.f, 1.f}, lb = (f32x4){0.f, 0.f, 0.f, 0.f};
                if (layer) { lg = *(const f32x4*)(lng + c); lb = *(const f32x4*)(lnb + c); }
#pragma unroll
                for (int ai = 0; ai < 2; ++ai)
#pragma unroll
                    for (int m = 0; m < 4; ++m) {
                        const int row = u.pm * BM + ai * HALF + wr * 64 + m * 16 + fr;
                        const size_t off = (size_t)row * 1024 + c;
                        f32x4 xr = *(const f32x4*)(xres + off);
                        if (layer) { const f32x2 st = *(const f32x2*)(rowstat + 2 * (size_t)row); xr = (xr - st.x) * st.y * lg + lb; }
                        const f32x4 o = xr * alpha + gv * acc[ai][bj][m][n];
                        *(f32x4*)(out + off) = o;
                    }
            }
    }
};
template <class Epi, class Sched, bool ALIGN_EPI = false, bool SP2 = false>
__device__ __forceinline__ void gemm_phase(PG8_LAS unsigned char* lds, const Gemm g, const Sched& S, const Epi& E) {
    const int tid = threadIdx.x, wid = __builtin_amdgcn_readfirstlane(tid >> 6), lane = tid & 63, wr = wid >> 2, wc = wid & 3, fr = lane & 15, fq = lane >> 4;
    const int K = g.K, nt = K / BK;
    unsigned voffA[2], voffB[2];
#pragma unroll
    for (int i = 0; i < 2; ++i) { int R, C; stage_rc(tid * 16 + i * 8192, R, C); const int Rb = Epi::PERM ? ((R & ~31) + perm32(R & 31)) : R;
        voffA[i] = (unsigned)(R * K + C) * 2u; voffB[i] = (unsigned)(Rb * K + C) * 2u; }
    const size_t kstep = (size_t)(BK * 2);
    const size_t hstep = (size_t)HALF * K * 2;
    const size_t tstep = 2 * hstep;
    const unsigned ldsw = (unsigned)wid * 1024u;
    const int aoff = lds_byte(wr * 64 + fr, fq * 8), boff = lds_byte(wc * 32 + fr, fq * 8);
#define PG8_SA(b, h) (((b) * 2 + (h)) * HTB)
#define PG8_SB(b, h) ((4 + (b) * 2 + (h)) * HTB)
#define PG8_STAGE(bufoff, gbase, voff) do { _Pragma("unroll") for (int _i = 0; _i < 2; ++_i) \
        __builtin_amdgcn_global_load_lds((const unsigned*)((const char*)(gbase) + (voff)[_i]), (PG8_LAS unsigned*)(lds + (bufoff) + ldsw + _i * 8192), 16, 0, 0); } while (0)
#define PG8_LDA(dst, b, h) do { _Pragma("unroll") for (int m = 0; m < 4; ++m) _Pragma("unroll") for (int k = 0; k < 2; ++k) dst[m][k] = *(const PG8_LAS bf16x8*)(lds + PG8_SA(b, h) + aoff + m * 2048 + k * 1024); } while (0)
#define PG8_LDB(dst, b, h) do { _Pragma("unroll") for (int n = 0; n < 2; ++n) _Pragma("unroll") for (int k = 0; k < 2; ++k) dst[n][k] = *(const PG8_LAS bf16x8*)(lds + PG8_SB(b, h) + boff + n * 2048 + k * 1024); } while (0)
#define PG8_MMA(ai, bj, At, Bt) do { __builtin_amdgcn_s_setprio(1); _Pragma("unroll") for (int m = 0; m < 4; ++m) _Pragma("unroll") for (int n = 0; n < 2; ++n) _Pragma("unroll") for (int k = 0; k < 2; ++k) \
        acc[ai][bj][m][n] = __builtin_amdgcn_mfma_f32_16x16x32_bf16(Bt[n][k], At[m][k], acc[ai][bj][m][n], 0, 0, 0); __builtin_amdgcn_s_setprio(0); } while (0)
#define PG8_WAIT_V(n) asm volatile("s_waitcnt vmcnt(" #n ")" ::: "memory")
#define PG8_WAIT_L(n) asm volatile("s_waitcnt lgkmcnt(" #n ")" ::: "memory")
#define PG8_BAR __builtin_amdgcn_s_barrier()
#define PG8_SCHED __builtin_amdgcn_sched_barrier(0)
    Unit cur, nxt; int ui = 0;
    if (!S.next(0, cur)) return;
    f32x4 acc[2][2][4][2];
#pragma unroll
    for (int a = 0; a < 2; ++a)
#pragma unroll
        for (int b = 0; b < 2; ++b)
#pragma unroll
            for (int m = 0; m < 4; ++m)
#pragma unroll
                for (int n = 0; n < 2; ++n) acc[a][b][m][n] = (f32x4){0.f, 0.f, 0.f, 0.f};
    bf16x8 At[4][2], B0[2][2], B1[2][2];
    const char* cA = (const char*)g.A + (size_t)cur.pm * tstep; const char* cB = (const char*)g.Bt + (size_t)cur.pn * tstep;
    S.a_ready(cur);
    if constexpr (SP2) {
        PG8_STAGE(PG8_SB(0, 0), cB, voffB); PG8_STAGE(PG8_SB(0, 1), cB + hstep, voffB); PG8_STAGE(PG8_SA(0, 0), cA, voffA); PG8_STAGE(PG8_SA(0, 1), cA + hstep, voffA);
        if (wr == 1) PG8_BAR;
        PG8_WAIT_V(2); PG8_BAR;
        PG8_STAGE(PG8_SB(1, 0), cB + kstep, voffB); PG8_STAGE(PG8_SA(1, 0), cA + kstep, voffA); PG8_STAGE(PG8_SB(1, 1), cB + hstep + kstep, voffB);
        PG8_WAIT_V(6); PG8_BAR;
    } else {
        PG8_STAGE(PG8_SB(0, 0), cB, voffB); PG8_STAGE(PG8_SA(0, 0), cA, voffA); PG8_STAGE(PG8_SB(0, 1), cB + hstep, voffB); PG8_STAGE(PG8_SA(0, 1), cA + hstep, voffA);
        if (wr == 1) PG8_BAR;
        PG8_WAIT_V(4); PG8_BAR;
        PG8_STAGE(PG8_SB(1, 0), cB + kstep, voffB); PG8_STAGE(PG8_SA(1, 0), cA + kstep, voffA); PG8_STAGE(PG8_SB(1, 1), cB + hstep + kstep, voffB);
        PG8_WAIT_V(6); PG8_BAR;
    }
    for (;;) {
        const bool has_next = S.next(ui + 1, nxt);
        const char* nA = has_next ? (const char*)g.A + (size_t)nxt.pm * tstep : cA; const char* nB = has_next ? (const char*)g.Bt + (size_t)nxt.pn * tstep : cB;
        for (int t = 0; t < nt; t += 2) {
            const bool last = (t == nt - 2);
            const char* a1 = cA + (size_t)(t + 1) * kstep;
            const char* a2 = last ? nA : cA + (size_t)(t + 2) * kstep; const char* b2 = last ? nB : cB + (size_t)(t + 2) * kstep;
            const char* a3 = a2 + kstep; const char* b3 = b2 + kstep;
            if (last && has_next) S.a_ready(nxt);
            if constexpr (SP2) {
            PG8_LDB(B0, 0, 0); PG8_LDB(B1, 0, 1); PG8_SCHED; PG8_LDA(At, 0, 0); PG8_STAGE(PG8_SA(1, 1), a1 + hstep, voffA);
            PG8_WAIT_V(8); PG8_WAIT_L(0); PG8_BAR; PG8_MMA(0, 0, At, B0); PG8_MMA(0, 1, At, B1); PG8_BAR; PG8_SCHED;
            PG8_LDA(At, 0, 1); PG8_STAGE(PG8_SB(0, 0), b2, voffB); PG8_STAGE(PG8_SB(0, 1), b2 + hstep, voffB); PG8_STAGE(PG8_SA(0, 0), a2, voffA);
            PG8_WAIT_V(8); PG8_WAIT_L(0); PG8_BAR; PG8_MMA(1, 0, At, B0); PG8_MMA(1, 1, At, B1); PG8_BAR; PG8_SCHED;
            PG8_LDB(B0, 1, 0); PG8_LDB(B1, 1, 1); PG8_SCHED; PG8_LDA(At, 1, 0); PG8_STAGE(PG8_SA(0, 1), a2 + hstep, voffA);
            PG8_WAIT_V(8); PG8_WAIT_L(0); PG8_BAR; PG8_MMA(0, 0, At, B0); PG8_MMA(0, 1, At, B1); PG8_BAR; PG8_SCHED;
            PG8_LDA(At, 1, 1); PG8_STAGE(PG8_SB(1, 0), b3, voffB); PG8_STAGE(PG8_SB(1, 1), b3 + hstep, voffB); PG8_STAGE(PG8_SA(1, 0), a3, voffA);
            PG8_WAIT_V(8); PG8_WAIT_L(0); PG8_BAR; PG8_MMA(1, 0, At, B0); PG8_MMA(1, 1, At, B1); PG8_BAR; PG8_SCHED;
            } else {
            PG8_LDB(B0, 0, 0); PG8_SCHED; PG8_LDA(At, 0, 0); PG8_STAGE(PG8_SA(1, 1), a1 + hstep, voffA);
            PG8_WAIT_L(8); PG8_BAR; PG8_WAIT_L(0); PG8_MMA(0, 0, At, B0); PG8_BAR; PG8_SCHED;
            PG8_LDB(B1, 0, 1); PG8_STAGE(PG8_SB(0, 0), b2, voffB);
            PG8_BAR; PG8_WAIT_L(0); PG8_MMA(0, 1, At, B1); PG8_BAR;
            PG8_LDA(At, 0, 1); PG8_STAGE(PG8_SA(0, 0), a2, voffA);
            PG8_BAR; PG8_WAIT_L(0); PG8_MMA(1, 0, At, B0); PG8_BAR; PG8_SCHED;
            PG8_STAGE(PG8_SB(0, 1), b2 + hstep, voffB);
            PG8_WAIT_V(6); PG8_BAR; PG8_MMA(1, 1, At, B1); PG8_BAR;
            PG8_LDB(B0, 1, 0); PG8_SCHED; PG8_LDA(At, 1, 0); PG8_STAGE(PG8_SA(0, 1), a2 + hstep, voffA);
            PG8_WAIT_L(8); PG8_BAR; PG8_WAIT_L(0); PG8_MMA(0, 0, At, B0); PG8_BAR; PG8_SCHED;
            PG8_LDB(B1, 1, 1); PG8_STAGE(PG8_SB(1, 0), b3, voffB);
            PG8_BAR; PG8_WAIT_L(0); PG8_MMA(0, 1, At, B1); PG8_BAR;
            PG8_LDA(At, 1, 1); PG8_STAGE(PG8_SA(1, 0), a3, voffA);
            PG8_BAR; PG8_WAIT_L(0); PG8_MMA(1, 0, At, B0); PG8_BAR; PG8_SCHED;
            PG8_STAGE(PG8_SB(1, 1), b3 + hstep, voffB);
            PG8_WAIT_V(6); PG8_BAR; PG8_MMA(1, 1, At, B1); PG8_BAR;
            }
        }
        if constexpr (ALIGN_EPI) { if (wr == 0) PG8_BAR; }
        if constexpr (!Epi::AFTER_DRAIN) { E(acc, cur, wr, wc, fr, fq); S.done(cur); }
        if (!has_next) break;
#pragma unroll
        for (int a = 0; a < 2; ++a)
#pragma unroll
            for (int b = 0; b < 2; ++b)
#pragma unroll
                for (int m = 0; m < 4; ++m)
#pragma unroll
                    for (int n = 0; n < 2; ++n) acc[a][b][m][n] = (f32x4){0.f, 0.f, 0.f, 0.f};
        cur = nxt; cA = nA; cB = nB; ++ui;
        if constexpr (ALIGN_EPI) { if (wr == 1) PG8_BAR; }
    }
    PG8_WAIT_V(0);
    if constexpr (!ALIGN_EPI) { if (wr == 0) PG8_BAR; }
    PG8_BAR;
    if constexpr (Epi::AFTER_DRAIN) { E.fused(acc, cur, wr, wc, fr, fq, lds, wid, lane); S.done(cur); }
#undef PG8_SA
#undef PG8_SB
#undef PG8_STAGE
#undef PG8_LDA
#undef PG8_LDB
#undef PG8_MMA
#undef PG8_WAIT_V
#undef PG8_WAIT_L
#undef PG8_BAR
#undef PG8_SCHED
}
}
#define GAS __attribute__((address_space(1)))
#define LAS __attribute__((address_space(3)))
typedef unsigned short bf16;
typedef unsigned v4u __attribute__((ext_vector_type(4)));
typedef float f32x4 __attribute__((ext_vector_type(4)));
typedef short bf16x8 __attribute__((ext_vector_type(8)));
typedef GAS unsigned gu32;
typedef GAS unsigned long long gu64;
#define RLX_AGENT __ATOMIC_RELAXED, __HIP_MEMORY_SCOPE_AGENT
#define LDS_WAIT() asm volatile("s_waitcnt lgkmcnt(0)" ::: "memory")
#define VM_WAIT() asm volatile("s_waitcnt vmcnt(0)" ::: "memory")
__device__ __forceinline__ unsigned long long rt() { return __builtin_amdgcn_s_memrealtime(); }
__device__ __forceinline__ unsigned f2bf(float f) { unsigned u = __builtin_bit_cast(unsigned, f); return (u + 0x7fffu + ((u >> 16) & 1u)) >> 16; }
__device__ __forceinline__ unsigned pk2(float lo, float hi) { return f2bf(lo) | (f2bf(hi) << 16); }

#define XB_TMO      128
#define XB_XCNT(j)  (256  + 64 * (j))
#define XB_XSUB(j)  (1280 + 64 * (j))
#define XB_XGEN(j)  (2304 + 64 * (j))
#define XB_TOP      3328
#define XB_TOPGEN   3392
#define XCD_BAR_WORDS 3456
#define XB_SPIN_CAP (1u << 18)

__device__ __forceinline__ unsigned xb_ld(unsigned* p)              { return __hip_atomic_load(p, __ATOMIC_RELAXED, __HIP_MEMORY_SCOPE_AGENT); }
__device__ __forceinline__ unsigned xb_add(unsigned* p, unsigned v) { return __hip_atomic_fetch_add(p, v, __ATOMIC_RELAXED, __HIP_MEMORY_SCOPE_AGENT); }
__device__ __forceinline__ unsigned xb_xcc_id() { return (unsigned)__builtin_amdgcn_s_getreg((3 << 11) | 20) & 0xFu; }
#define XB_SPIN(cond, bar) do { unsigned _sp = 0; while (cond) { __builtin_amdgcn_s_sleep(1); \
    if ((++_sp & 255u) == 0u) { if (xb_ld(&(bar)[XB_TMO])) break; if (_sp > XB_SPIN_CAP) { atomicAdd(&(bar)[XB_TMO], 1u); break; } } } } while (0)

struct XcdBarrier {
    unsigned* bar; unsigned x;
    volatile LAS unsigned* st;
};

__device__ __forceinline__ XcdBarrier xcd_barrier_post(unsigned* bar, volatile LAS unsigned* st) {
    XcdBarrier b; b.bar = bar; b.x = xb_xcc_id(); b.st = st;
    if (threadIdx.x == 0) (void)xb_add(&bar[XB_XCNT(b.x)], 1u);
    return b;
}
__device__ __forceinline__ void xcd_barrier_complete(unsigned* bar, unsigned x, unsigned& nloc, unsigned& nx) {
    const unsigned G = gridDim.x * gridDim.y * gridDim.z;
    unsigned sum, cnt, mine, sp = 0u;
    for (;;) {
        sum = 0u; cnt = 0u; mine = 0u;
#pragma unroll
        for (unsigned j = 0; j < 16; ++j) { const unsigned c = xb_ld(&bar[XB_XCNT(j)]); sum += c; cnt += (c > 0u) ? 1u : 0u; mine = (j == x) ? c : mine; }
        if (sum == G) break;
        __builtin_amdgcn_s_sleep(1);
        if ((++sp & 255u) == 0u) { if (xb_ld(&bar[XB_TMO])) break; if (sp > XB_SPIN_CAP) { atomicAdd(&bar[XB_TMO], 1u); break; } }
    }
    nloc = mine > 0u ? mine : 1u; nx = cnt > 0u ? cnt : 1u;
}

__device__ __forceinline__ void xcd_barrier(const XcdBarrier& b) {
    asm volatile("s_waitcnt vmcnt(0)" ::: "memory");
    __syncthreads();
    if (threadIdx.x == 0) {
        unsigned* bar = b.bar;
        __builtin_amdgcn_s_waitcnt(0);
        unsigned nloc = b.st[0], nx = b.st[1];
        if (nloc == 0u) { xcd_barrier_complete(bar, b.x, nloc, nx); b.st[0] = nloc; b.st[1] = nx; }
        const unsigned old = xb_add(&bar[XB_XSUB(b.x)], 1u);
        const unsigned gen = old / nloc;
        if (old + 1u == (gen + 1u) * nloc) {
            __builtin_amdgcn_fence(__ATOMIC_RELEASE, "agent");
            asm volatile("s_waitcnt vmcnt(0)" ::: "memory");
            const unsigned og = xb_add(&bar[XB_TOP], 1u);
            const unsigned tg = og / nx;
            if (og + 1u == (tg + 1u) * nx) xb_add(&bar[XB_TOPGEN], 1u);
            else XB_SPIN(xb_ld(&bar[XB_TOPGEN]) == tg, bar);
            __builtin_amdgcn_fence(__ATOMIC_ACQUIRE, "agent");
            xb_add(&bar[XB_XGEN(b.x)], 1u);
            asm volatile("s_waitcnt vmcnt(0)" ::: "memory");
        } else {
            XB_SPIN(xb_ld(&bar[XB_XGEN(b.x)]) == gen, bar);
            __builtin_amdgcn_fence(__ATOMIC_ACQUIRE, "agent");
            asm volatile("s_waitcnt vmcnt(0)" ::: "memory");
        }
    }
    __syncthreads();
}

constexpr int NWAVES = 8, NTHR = 512;
constexpr int BATCH = 8, T = 8192, D = 1024, M = BATCH * T, DEPTH = 2;
constexpr int NPROJ = 3968, NPAD = 4096;
constexpr int HD = 64, BH = 6, CH = 6;
constexpr int PA_LD = 768, PB_LD = 1664, PC_LD = 1536;
constexpr int BSHIFT = 1280;
constexpr float LN_EPS = 1e-5f, GN_EPS = 64e-5f;
constexpr float DN_ALPHA = 1.4142135623730951f;
constexpr float LOG2E = 1.4426950408889634f;
constexpr float QSCALE = 0.125f * LOG2E;

#ifndef MK_N_LAUNCHES
#define MK_N_LAUNCHES 1
#endif
constexpr int N_PHASES = 16;

#ifndef REP_S0
#define REP_S0 1
#endif
#ifndef REP_S2
#define REP_S2 1
#endif
#ifndef REP_XN
#define REP_XN 1
#endif
#ifndef REP_GEMM1
#define REP_GEMM1 1
#endif
#ifndef REP_PRE
#define REP_PRE 1
#endif
#ifndef REP_SGU
#define REP_SGU 1
#endif
#ifndef REP_ATTN
#define REP_ATTN 1
#endif
#ifndef REP_SCAN
#define REP_SCAN 1
#endif
#ifndef REP_POST
#define REP_POST 1
#endif
#ifndef REP_GEMM2
#define REP_GEMM2 1
#endif
constexpr size_t MiB = 1u << 20;
constexpr size_t WS_CTL = 0, CTL_ZERO_BYTES = 1 * MiB;
constexpr size_t WS_WIN = 2 * MiB;
constexpr size_t WS_WOUT = 18 * MiB;
constexpr size_t WS_LORA = 22 * MiB;
constexpr int LO_W2T = 0, LO_A2T = 2 * 384 * 64, LO_V1T = 4 * 384 * 64, LO_V2T = LO_V1T + 32 * 384;
constexpr size_t WS_WSB = 22 * MiB + 512 * 1024;
constexpr size_t WS_ROWSTAT = 23 * MiB;
constexpr size_t WS_XN = 32 * MiB;
constexpr size_t WS_PA = 160 * MiB;
constexpr size_t WS_PC = 256 * MiB;
constexpr size_t WS_PB = 448 * MiB;
constexpr size_t WS_OPS = 656 * MiB;
constexpr size_t WS_CHK = WS_PC;
constexpr size_t WS_SST = 944 * MiB;
constexpr size_t WS_END = 992 * MiB;
constexpr int CW_BAR = 4096;
constexpr int CW_MOD = 16384;
static_assert((CW_MOD + 49152) * 4 <= (int)CTL_ZERO_BYTES, "ctl region");

constexpr int RING_OFF = 0, RING_BYTES = 155648;
constexpr int LDSCTL_OFF = RING_BYTES, MISC_OFF = LDSCTL_OFF + 320;
constexpr int LDS_BYTES = 159744;

struct Frame {
    LAS unsigned char* lds;
    volatile LAS unsigned* MISC;
    gu32* ctl;
    int tid, lane, wave, vcu, G;
    float* out; unsigned char* ws;
};
struct Args { const float* in[26]; float* out; unsigned char* ws; int ph_lo, ph_hi, li, pad; };
#define INP(k) (A.in[k])
__device__ __forceinline__ float bf2f(unsigned short h) { return __builtin_bit_cast(float, (unsigned)h << 16); }
__device__ __forceinline__ float bflo(unsigned u) { return __builtin_bit_cast(float, u << 16); }
__device__ __forceinline__ float bfhi(unsigned u) { return __builtin_bit_cast(float, u & 0xffff0000u); }
__device__ __forceinline__ float silu_f(float x) { return x / (1.0f + __expf(-x)); }
__device__ __forceinline__ float sigmoid_f(float x) { return 1.0f / (1.0f + __expf(-x)); }
__device__ __forceinline__ float wave_sum(float v) {
#pragma unroll
    for (int o = 1; o < 64; o <<= 1) v += __shfl_xor(v, o);
    return v;
}
__device__ __forceinline__ float wave_max(float v) {
#pragma unroll
    for (int o = 1; o < 64; o <<= 1) v = fmaxf(v, __shfl_xor(v, o));
    return v;
}

__device__ __forceinline__ int opaque_i(int x) { asm volatile("" : "+v"(x)); return x; }
typedef float f32x4m __attribute__((ext_vector_type(4)));
template <int CTRL> __device__ __forceinline__ float dppx(float x) { return __int_as_float(__builtin_amdgcn_update_dpp(0, __float_as_int(x), CTRL, 0xf, 0xf, true)); }
__device__ __forceinline__ void p0_transpose_item(const float* W, int K, int N, bf16* WT, int shift_from, int shift, LAS float* scr, int item, int lane) {
    const int nblk = N / 32, kb = item / nblk, nb = item % nblk, k0 = 64 * kb, n0 = 32 * nb;
#pragma unroll 8
    for (int i = 0; i < 32; ++i) { const int kk = 2 * i + (lane >> 5); scr[kk * 33 + (lane & 31)] = W[(size_t)(k0 + kk) * N + n0 + (lane & 31)]; }
    LDS_WAIT(); asm volatile("" ::: "memory");
    const int c = lane & 7;
    const int r0 = n0 + (n0 >= shift_from ? shift : 0);
#pragma unroll
    for (int j = 0; j < 4; ++j) { const int n = (lane >> 3) + 8 * j; const LAS float* s = scr + (8 * c) * 33 + n;
        v4u o; o.x = pk2(s[0 * 33], s[1 * 33]); o.y = pk2(s[2 * 33], s[3 * 33]); o.z = pk2(s[4 * 33], s[5 * 33]); o.w = pk2(s[6 * 33], s[7 * 33]);
        *(GAS v4u*)(WT + (size_t)(r0 + n) * K + k0 + 8 * c) = o; }
    LDS_WAIT(); asm volatile("" ::: "memory");
}
__device__ __forceinline__ void p0_prologue(Frame& F, const Args& A) {
    LAS float* scr = (LAS float*)(F.lds + RING_OFF + F.wave * 16384);
    const int gw = F.vcu * NWAVES + F.wave, NGW = F.G * NWAVES;
    constexpr int I_IN = (D / 64) * (NPROJ / 32);
    constexpr int I_OUT = (D / 64) * (D / 32);
    constexpr int I_MOD = 48 * 16;
    constexpr int NITEMS = 2 * (I_IN + I_OUT + I_MOD);
    float* mod = (float*)(F.ws + WS_CTL) + CW_MOD;
    for (int it = gw; it < NITEMS; it += NGW) {
        int r = it;
        if (r < 2 * I_IN) { const int l = r / I_IN; p0_transpose_item(A.in[4] + (size_t)l * D * NPROJ, D, NPROJ, (bf16*)(F.ws + WS_WIN) + (size_t)l * NPAD * D, 2432, 128, scr, r % I_IN, F.lane); continue; }
        r -= 2 * I_IN;
        if (r < 2 * I_OUT) { const int l = r / I_OUT; p0_transpose_item(A.in[23] + (size_t)l * D * D, D, D, (bf16*)(F.ws + WS_WOUT) + (size_t)l * D * D, 1 << 30, 0, scr, r % I_OUT, F.lane); continue; }
        r -= 2 * I_OUT;
        {
            const int l = r / I_MOD, rem = r % I_MOD, jb = rem / 16, ib = rem % 16, i0 = ib * 64, j = jb * 64 + F.lane;
#pragma unroll
            for (int b = 0; b < 8; ++b) scr[b * 64 + F.lane] = silu_f(A.in[1][b * D + i0 + F.lane]);
            LDS_WAIT(); asm volatile("" ::: "memory");
            float acc[8];
#pragma unroll
            for (int b = 0; b < 8; ++b) acc[b] = 0.f;
            const float* wa = A.in[2] + (size_t)l * D * 3072 + (size_t)i0 * 3072 + j;
#pragma unroll 4
            for (int i = 0; i < 64; ++i) { const float wv = wa[(size_t)i * 3072];
#pragma unroll
                for (int b = 0; b < 8; ++b) acc[b] += scr[b * 64 + i] * wv; }
            const float bb = (ib == 0) ? A.in[3][l * 3072 + j] : 0.f;
#pragma unroll
            for (int b = 0; b < 8; ++b) atomicAdd(&mod[(l * 8 + b) * 3072 + j], acc[b] + bb);
            LDS_WAIT(); asm volatile("" ::: "memory");
        }
    }
    {
        bf16* LW = (bf16*)(F.ws + WS_LORA);
        const int gt = F.vcu * NTHR + F.tid, GT = F.G * NTHR;
        for (int i = gt; i < 2 * 384 * 64; i += GT) { const int l = i / (384 * 64), r = i % (384 * 64), col = r >> 6, k = r & 63;
            LW[LO_W2T + i] = (bf16)f2bf(A.in[11][((size_t)l * 64 + k) * 384 + col]); LW[LO_A2T + i] = (bf16)f2bf(A.in[13][((size_t)l * 64 + k) * 384 + col]); }
        {   bf16* WSB = (bf16*)(F.ws + WS_WSB);
            for (int i = gt; i < 2 * 4 * 128 * 128; i += GT) { const int p = (i >> 7) & 127, q = i & 127; WSB[i] = (bf16)f2bf(q <= p ? A.in[7][i] : 0.f); } }
        for (int i = gt; i < 32 * 384; i += GT) { const int n = i / 384, j = i % 384; LW[LO_V1T + i] = (bf16)f2bf(A.in[20][j * 32 + n]); }
        for (int i = gt; i < 384 * 32; i += GT) { const int col = i >> 5, n = i & 31; LW[LO_V2T + i] = (bf16)f2bf(A.in[21][n * 384 + col]); }
    }
    for (int l = 0; l < 2; ++l) {
        v4u* z = (v4u*)((bf16*)(F.ws + WS_WIN) + (size_t)l * NPAD * D + (size_t)2432 * D);
        const int n16 = 128 * D * 2 / 16;
        for (int i = F.vcu * NTHR + F.tid; i < n16; i += F.G * NTHR) z[i] = (v4u){0u, 0u, 0u, 0u};
    }
}

__device__ __forceinline__ void p1a_xn(Frame& F, const Args& A, int layer) {
    const int gw = F.vcu * NWAVES + F.wave, NGW = F.G * NWAVES;
    const float* src = layer ? F.out : A.in[0];
    const float* mod = (const float*)(F.ws + WS_CTL) + CW_MOD + (size_t)layer * 8 * 3072;
    float* rowstat = (float*)(F.ws + WS_ROWSTAT);
    bf16* XN = (bf16*)(F.ws + WS_XN);
    const float* lng = A.in[24]; const float* lnb = A.in[25];
    for (int m = gw; m < M; m += NGW) {
        const int b = m / T;
        const GAS f32x4* xr = (const GAS f32x4*)(src + (size_t)m * D) + F.lane;
        f32x4 v[4];
#pragma unroll
        for (int j = 0; j < 4; ++j) v[j] = xr[64 * j];
        if (layer) {
            float s = 0.f;
#pragma unroll
            for (int j = 0; j < 4; ++j) s += (v[j].x + v[j].y) + (v[j].z + v[j].w);
            const float mean = wave_sum(s) * (1.f / D); float s2 = 0.f;
#pragma unroll
            for (int j = 0; j < 4; ++j) { v[j] = v[j] - mean; s2 += (v[j].x * v[j].x + v[j].y * v[j].y) + (v[j].z * v[j].z + v[j].w * v[j].w); }
            const float rstd = 1.f / sqrtf(wave_sum(s2) * (1.f / D) + LN_EPS);
            if (F.lane == 0) { rowstat[2 * (size_t)m] = mean; rowstat[2 * (size_t)m + 1] = rstd; }
#pragma unroll
            for (int j = 0; j < 4; ++j) { const f32x4 g = *((const f32x4*)lng + F.lane + 64 * j), bb = *((const f32x4*)lnb + F.lane + 64 * j); v[j] = v[j] * rstd * g + bb; }
        }
        const f32x4* sh = (const f32x4*)(mod + (size_t)b * 3072) + F.lane;
        const f32x4* sc = (const f32x4*)(mod + (size_t)b * 3072 + 1024) + F.lane;
        GAS unsigned long long* o8 = (GAS unsigned long long*)(XN + (size_t)m * D) + F.lane;
#pragma unroll
        for (int j = 0; j < 4; ++j) { const f32x4 h = v[j] * (sc[64 * j] + 1.0f) + sh[64 * j];
            o8[64 * j] = (unsigned long long)pk2(h.x, h.y) | ((unsigned long long)pk2(h.z, h.w) << 32); }
    }
}
__device__ __forceinline__ void p4_final(Frame& F, const Args& A) {
    const int gw = F.vcu * NWAVES + F.wave, NGW = F.G * NWAVES;
    const float* lng = A.in[24] + D; const float* lnb = A.in[25] + D;
    for (int m = gw; m < M; m += NGW) {
        GAS f32x4* xr = (GAS f32x4*)(F.out + (size_t)m * D) + F.lane;
        f32x4 v[4]; float s = 0.f;
#pragma unroll
        for (int j = 0; j < 4; ++j) { v[j] = xr[64 * j]; s += (v[j].x + v[j].y) + (v[j].z + v[j].w); }
        const float mean = wave_sum(s) * (1.f / D); float s2 = 0.f;
#pragma unroll
        for (int j = 0; j < 4; ++j) { v[j] = v[j] - mean; s2 += (v[j].x * v[j].x + v[j].y * v[j].y) + (v[j].z * v[j].z + v[j].w * v[j].w); }
        const float rstd = 1.f / sqrtf(wave_sum(s2) * (1.f / D) + LN_EPS);
#pragma unroll
        for (int j = 0; j < 4; ++j) { const f32x4 g = *((const f32x4*)lng + F.lane + 64 * j), bb = *((const f32x4*)lnb + F.lane + 64 * j); xr[64 * j] = v[j] * rstd * g + bb; }
    }
}

__device__ __forceinline__ void sgu_unit_simple(Frame& F, const Args& A, int layer, int nb) {
    LAS float* vln = (LAS float*)(F.lds + RING_OFF);
    const bf16* PA = (const bf16*)(F.ws + WS_PA);
    bf16* Y = (bf16*)(F.ws + WS_XN);
    const float* lng = A.in[5] + layer * 256; const float* lnb = A.in[6] + layer * 256;
    const float* wsp = A.in[7] + (size_t)layer * 4 * 128 * 128; const float* bsp = A.in[8] + layer * 4 * 128;
    const size_t m0 = (size_t)nb * 128;
    __syncthreads();
    {
        const int tt = F.tid >> 2, g = F.tid & 3;
        const v4u* src = (const v4u*)(PA + (m0 + tt) * PA_LD + 256 + g * 64);
        float x[64];
#pragma unroll
        for (int i = 0; i < 8; ++i) { const v4u u = src[i]; x[8 * i + 0] = bflo(u.x); x[8 * i + 1] = bfhi(u.x); x[8 * i + 2] = bflo(u.y); x[8 * i + 3] = bfhi(u.y);
            x[8 * i + 4] = bflo(u.z); x[8 * i + 5] = bfhi(u.z); x[8 * i + 6] = bflo(u.w); x[8 * i + 7] = bfhi(u.w); }
        float s = 0.f;
#pragma unroll
        for (int i = 0; i < 64; ++i) s += x[i];
        const float mean = s * (1.f / 64.f); float q = 0.f;
#pragma unroll
        for (int i = 0; i < 64; ++i) { x[i] -= mean; q += x[i] * x[i]; }
        const float rstd = 1.f / sqrtf(q * (1.f / 64.f) + LN_EPS);
#pragma unroll
        for (int i = 0; i < 64; ++i) vln[tt * 256 + g * 64 + i] = x[i] * rstd * lng[g * 64 + i] + lnb[g * 64 + i];
    }
    __syncthreads();
    {
        const int col = F.tid & 255, ph = F.tid >> 8, g = col >> 6;
        for (int p = 64 * ph; p < 64 * ph + 64; ++p) {
            const float* wr = wsp + ((size_t)g * 128 + p) * 128;
            float acc = 0.f;
            for (int q = 0; q <= p; ++q) acc += wr[q] * vln[q * 256 + col];
            const float s = acc + bsp[g * 128 + p];
            const float u = bf2f(PA[(m0 + p) * PA_LD + col]), gt = bf2f(PA[(m0 + p) * PA_LD + 512 + col]);
            Y[(m0 + p) * D + col] = (bf16)f2bf(silu_f(gt) * u * s);
        }
    }
    __syncthreads();
}


constexpr int SG_STRIDE = 272;
__device__ __forceinline__ void sgu_unit_mfma(Frame& F, const Args& A, int layer, int nb) {
    LAS unsigned char* L = F.lds + RING_OFF;
    const bf16* PA = (const bf16*)(F.ws + WS_PA);
    bf16* Y = (bf16*)(F.ws + WS_XN);
    const bf16* WSB = (const bf16*)(F.ws + WS_WSB) + (size_t)layer * 4 * 128 * 128;
    const float* lng = A.in[5] + layer * 256; const float* lnb = A.in[6] + layer * 256; const float* bsp = A.in[8] + layer * 4 * 128;
    const size_t m0 = (size_t)nb * 128;
    const int tid_ = opaque_i(F.tid), lane = tid_ & 63, wid = F.wave, lc = lane & 15, lq = lane >> 4;
    {
        const int tt = tid_ >> 2, g = tid_ & 3;
        const v4u* src = (const v4u*)(PA + (m0 + tt) * PA_LD + 256 + g * 64);
        float x[64];
#pragma unroll
        for (int i = 0; i < 8; ++i) { const v4u u = src[i]; x[8 * i + 0] = bflo(u.x); x[8 * i + 1] = bfhi(u.x); x[8 * i + 2] = bflo(u.y); x[8 * i + 3] = bfhi(u.y);
            x[8 * i + 4] = bflo(u.z); x[8 * i + 5] = bfhi(u.z); x[8 * i + 6] = bflo(u.w); x[8 * i + 7] = bfhi(u.w); }
        float s = 0.f;
#pragma unroll
        for (int i = 0; i < 64; ++i) s += x[i];
        const float mean = s * (1.f / 64.f); float q = 0.f;
#pragma unroll
        for (int i = 0; i < 64; ++i) { x[i] -= mean; q += x[i] * x[i]; }
        const float rstd = 1.f / sqrtf(q * (1.f / 64.f) + LN_EPS);
#pragma unroll
        for (int i = 0; i < 64; ++i) *(LAS bf16*)(L + (g * 64 + i) * SG_STRIDE + tt * 2) = (bf16)f2bf(x[i] * rstd * lng[g * 64 + i] + lnb[g * 64 + i]);
    }
    __syncthreads();
    {
        const int g = wid >> 1, ch = wid & 1;
        const bf16* Wg = WSB + (size_t)g * 128 * 128;
#pragma unroll 1
        for (int i = 0; i < 8; ++i) {
            f32x4m acc0 = {0.f, 0.f, 0.f, 0.f}, acc1 = {0.f, 0.f, 0.f, 0.f};
            const int nks = (i >> 1) + 1;
            for (int ks = 0; ks < nks; ++ks) {
                const bf16x8 a = *(const bf16x8*)(Wg + (size_t)(16 * i + lc) * 128 + 32 * ks + 8 * lq);
                const bf16x8 b0 = *(const LAS bf16x8*)(L + (g * 64 + 32 * ch + lc) * SG_STRIDE + (32 * ks + 8 * lq) * 2);
                const bf16x8 b1 = *(const LAS bf16x8*)(L + (g * 64 + 32 * ch + 16 + lc) * SG_STRIDE + (32 * ks + 8 * lq) * 2);
                acc0 = __builtin_amdgcn_mfma_f32_16x16x32_bf16(a, b0, acc0, 0, 0, 0);
                acc1 = __builtin_amdgcn_mfma_f32_16x16x32_bf16(a, b1, acc1, 0, 0, 0);
            }
#pragma unroll
            for (int r = 0; r < 4; ++r) {
                const int p = 16 * i + 4 * lq + r; const size_t m = m0 + p;
                const float bs = bsp[g * 128 + p];
                const int c0 = g * 64 + 32 * ch + lc, c1 = c0 + 16;
                const float u0 = bf2f(PA[m * PA_LD + c0]), g0 = bf2f(PA[m * PA_LD + 512 + c0]), u1 = bf2f(PA[m * PA_LD + c1]), g1 = bf2f(PA[m * PA_LD + 512 + c1]);
                Y[m * D + c0] = (bf16)f2bf(silu_f(g0) * u0 * (acc0[r] + bs));
                Y[m * D + c1] = (bf16)f2bf(silu_f(g1) * u1 * (acc1[r] + bs));
            }
        }
    }
    __syncthreads();
}
__device__ __forceinline__ void attn_item_simple(Frame& F, const Args& A, int layer, int m, int h) {
    LAS float* wq = (LAS float*)(F.lds + RING_OFF + F.wave * 4096);
    LAS float* wp = wq + 64;
    const bf16* PC = (const bf16*)(F.ws + WS_PC);
    bf16* Y = (bf16*)(F.ws + WS_XN);
    const float* tab = A.in[22] + ((size_t)layer * CH + h) * 513;
    const int t = m % T, n = t >> 6; const size_t mb = (size_t)(m - t);
    const int j0 = (n >= 8 ? n - 8 : 0) * 64, j1 = (n + 1) * 64, cnt = j1 - j0;
    wq[F.lane] = bf2f(PC[(size_t)m * PC_LD + h * 64 + F.lane]);
    LDS_WAIT(); asm volatile("" ::: "memory");
    float sc[9]; float mx = -INFINITY;
#pragma unroll
    for (int rd = 0; rd < 9; ++rd) {
        const int jj = rd * 64 + F.lane; float s = -INFINITY;
        if (jj < cnt) {
            const int kp = j0 + jj;
            const v4u* kr = (const v4u*)(PC + (mb + kp) * PC_LD + 384 + h * 64);
            float dot = 0.f;
#pragma unroll
            for (int i = 0; i < 8; ++i) { const v4u u = kr[i]; const LAS float* q = wq + 8 * i;
                dot += q[0] * bflo(u.x) + q[1] * bfhi(u.x) + q[2] * bflo(u.y) + q[3] * bfhi(u.y) + q[4] * bflo(u.z) + q[5] * bfhi(u.z) + q[6] * bflo(u.w) + q[7] * bfhi(u.w); }
            int dist = t - kp; dist = dist < -256 ? -256 : (dist > 256 ? 256 : dist);
            s = dot + tab[dist + 256] * LOG2E;
        }
        sc[rd] = s; mx = fmaxf(mx, s);
    }
    mx = wave_max(mx);
    float sum = 0.f;
#pragma unroll
    for (int rd = 0; rd < 9; ++rd) { const float p = exp2f(sc[rd] - mx); sum += p; wp[rd * 64 + F.lane] = p; }
    sum = wave_sum(sum);
    LDS_WAIT(); asm volatile("" ::: "memory");
    const bf16* vb = PC + (mb + j0) * PC_LD + 768 + h * 64 + F.lane;
    float o = 0.f;
    for (int jj = 0; jj < cnt; ++jj) o += wp[jj] * bf2f(vb[(size_t)jj * PC_LD]);
    o /= sum;
    const float g = bf2f(PC[(size_t)m * PC_LD + 1152 + h * 64 + F.lane]);
    Y[(size_t)m * D + 640 + h * 64 + F.lane] = (bf16)f2bf(silu_f(g) * o);
    LDS_WAIT(); asm volatile("" ::: "memory");
}


typedef float f32x16 __attribute__((ext_vector_type(16)));
typedef short s16x4 __attribute__((ext_vector_type(4)));
constexpr int AT_K = 0, AT_V = 16384, AT_TAB = 32768, AT_WSF = AT_TAB + 2560;
__device__ __forceinline__ int crow(int r, int hi) { return (r & 3) + 8 * (r >> 2) + 4 * hi; }
__device__ __forceinline__ s16x4 vtr(const LAS unsigned char* p) { return __builtin_bit_cast(s16x4, __builtin_amdgcn_ds_read_tr16_b64_v4i16((LAS s16x4*)p)); }
__device__ __forceinline__ void attn_unit_mfma(Frame& F, const Args& A, int layer, int u) {
    const int qi = u & 31, h = (u >> 5) % CH, b = u / (32 * CH);
    const int tid = opaque_i(F.tid), lane = tid & 63, wid = F.wave, r32 = lane & 31, hi = lane >> 5;
    LAS unsigned char* L = F.lds + RING_OFF;
    const bf16* PC = (const bf16*)(F.ws + WS_PC);
    bf16* Y = (bf16*)(F.ws + WS_XN);
    const size_t mb = (size_t)b * T;
    const int ci = wid >> 1, qin = 32 * (wid & 1) + r32;
    const size_t qrow = mb + (size_t)(4 * qi + ci) * 64 + 32 * (wid & 1);
    const int jmin = (qi >= 2) ? 0 : 8 - 4 * qi;
    {   const float* tab = A.in[22] + ((size_t)layer * CH + h) * 513;
        LAS float* lt = (LAS float*)(L + AT_TAB);
        for (int i = tid; i < 640; i += NTHR) lt[i] = tab[i < 512 ? i : 512] * LOG2E; }
    bf16x8 qr[4];
#pragma unroll
    for (int d0 = 0; d0 < 4; ++d0) qr[d0] = *(const bf16x8*)(PC + (qrow + r32) * PC_LD + h * 64 + d0 * 16 + hi * 8);
    const bf16* ksrc = PC + (mb + (size_t)(4 * qi - 8) * 64 + lane) * PC_LD + 384 + h * 64 + wid * 8;
    const bf16* vsrc = PC + (mb + (size_t)(4 * qi - 8) * 64 + 16 * (wid & 3) + (lane >> 2)) * PC_LD + 768 + h * 64 + (wid >> 2) * 32 + (lane & 3) * 8;
    v4u kreg = *(const v4u*)(ksrc + (size_t)jmin * 64 * PC_LD), vreg = *(const v4u*)(vsrc + (size_t)jmin * 64 * PC_LD);
    f32x16 o0 = {}, o1 = {};
    float mref = 0.f, lsum = 0.f; bool first = true;
    const float tabc = A.in[22][((size_t)layer * CH + h) * 513 + 512] * LOG2E;
    for (int j = jmin; j < 12; ++j) {
        const int slot = (j - jmin) & 1;
        *(LAS v4u*)(L + AT_K + slot * 8192 + wid * 1024 + lane * 16) = kreg;
        *(LAS v4u*)(L + AT_V + slot * 8192 + wid * 1024 + lane * 16) = vreg;
        __syncthreads();
        if (j < 11) { kreg = *(const v4u*)(ksrc + (size_t)(j + 1) * 64 * PC_LD); vreg = *(const v4u*)(vsrc + (size_t)(j + 1) * 64 * PC_LD); }
        if (j >= ci && j <= ci + 8) {
            const int cd = ci + 8 - j;
            const LAS unsigned char* kb = L + AT_K + slot * 8192 + hi * 1024 + r32 * 16;
            f32x16 p0 = {}, p1 = {};
#pragma unroll
            for (int d0 = 0; d0 < 4; ++d0) {
                const bf16x8 b0 = *(const LAS bf16x8*)(kb + d0 * 2048), b1 = *(const LAS bf16x8*)(kb + d0 * 2048 + 512);
                p0 = __builtin_amdgcn_mfma_f32_32x32x16_bf16(b0, qr[d0], p0, 0, 0, 0);
                p1 = __builtin_amdgcn_mfma_f32_32x32x16_bf16(b1, qr[d0], p1, 0, 0, 0);
            }
            if (cd >= 5) {
#pragma unroll
                for (int r = 0; r < 16; ++r) { p0[r] += tabc; p1[r] += tabc; }
            } else {
                const LAS unsigned char* tb = L + AT_TAB + 4 * (64 * cd + 256 + qin - 4 * hi - 63);
#pragma unroll
                for (int r = 0; r < 16; ++r) {
                    p0[r] += *(const LAS float*)(tb + 4 * (63 - ((r & 3) + 8 * (r >> 2))));
                    p1[r] += *(const LAS float*)(tb + 4 * (63 - ((r & 3) + 8 * (r >> 2) + 32)));
                }
            }
            if (first) {
                float mx = p0[0];
#pragma unroll
                for (int r = 0; r < 16; ++r) mx = fmaxf(mx, fmaxf(p0[r], p1[r]));
                const unsigned um = __float_as_uint(mx);
                auto rr = __builtin_amdgcn_permlane32_swap(um, um, false, false);
                const unsigned m0 = rr[0], m1 = rr[1];
                mref = fmaxf(__uint_as_float(m0), __uint_as_float(m1));
                first = false;
            }
            float sacc = 0.f;
#pragma unroll
            for (int r = 0; r < 16; ++r) { p0[r] = exp2f(p0[r] - mref); p1[r] = exp2f(p1[r] - mref); sacc += p0[r] + p1[r]; }
            lsum += sacc;
            v4u pw0, pw1, pw2, pw3;
            pw0.x = pg8::cvt_pk_bf16(p0[0], p0[1]); pw0.y = pg8::cvt_pk_bf16(p0[2], p0[3]); pw0.z = pg8::cvt_pk_bf16(p0[4], p0[5]); pw0.w = pg8::cvt_pk_bf16(p0[6], p0[7]);
            pw1.x = pg8::cvt_pk_bf16(p0[8], p0[9]); pw1.y = pg8::cvt_pk_bf16(p0[10], p0[11]); pw1.z = pg8::cvt_pk_bf16(p0[12], p0[13]); pw1.w = pg8::cvt_pk_bf16(p0[14], p0[15]);
            pw2.x = pg8::cvt_pk_bf16(p1[0], p1[1]); pw2.y = pg8::cvt_pk_bf16(p1[2], p1[3]); pw2.z = pg8::cvt_pk_bf16(p1[4], p1[5]); pw2.w = pg8::cvt_pk_bf16(p1[6], p1[7]);
            pw3.x = pg8::cvt_pk_bf16(p1[8], p1[9]); pw3.y = pg8::cvt_pk_bf16(p1[10], p1[11]); pw3.z = pg8::cvt_pk_bf16(p1[12], p1[13]); pw3.w = pg8::cvt_pk_bf16(p1[14], p1[15]);
            const LAS unsigned char* vb = L + AT_V + slot * 8192 + ((lane >> 4) & 1) * 32 + (lane & 3) * 8 + (4 * hi + ((lane & 15) >> 2)) * 64;
#define AT_PV(OACC, D0) do { \
            s16x4 lo0 = vtr(vb + (D0) * 4096), hi0 = vtr(vb + (D0) * 4096 + 512), lo1 = vtr(vb + (D0) * 4096 + 1024), hi1 = vtr(vb + (D0) * 4096 + 1536), \
                  lo2 = vtr(vb + (D0) * 4096 + 2048), hi2 = vtr(vb + (D0) * 4096 + 2560), lo3 = vtr(vb + (D0) * 4096 + 3072), hi3 = vtr(vb + (D0) * 4096 + 3584); \
            OACC = __builtin_amdgcn_mfma_f32_32x32x16_bf16(__builtin_bit_cast(bf16x8, pw0), ((bf16x8){lo0[0], lo0[1], lo0[2], lo0[3], hi0[0], hi0[1], hi0[2], hi0[3]}), OACC, 0, 0, 0); \
            OACC = __builtin_amdgcn_mfma_f32_32x32x16_bf16(__builtin_bit_cast(bf16x8, pw1), ((bf16x8){lo1[0], lo1[1], lo1[2], lo1[3], hi1[0], hi1[1], hi1[2], hi1[3]}), OACC, 0, 0, 0); \
            OACC = __builtin_amdgcn_mfma_f32_32x32x16_bf16(__builtin_bit_cast(bf16x8, pw2), ((bf16x8){lo2[0], lo2[1], lo2[2], lo2[3], hi2[0], hi2[1], hi2[2], hi2[3]}), OACC, 0, 0, 0); \
            OACC = __builtin_amdgcn_mfma_f32_32x32x16_bf16(__builtin_bit_cast(bf16x8, pw3), ((bf16x8){lo3[0], lo3[1], lo3[2], lo3[3], hi3[0], hi3[1], hi3[2], hi3[3]}), OACC, 0, 0, 0); } while (0)
            AT_PV(o0, 0); AT_PV(o1, 1);
#undef AT_PV
        }
    }
    {   const unsigned ul = __float_as_uint(lsum);
        auto rr = __builtin_amdgcn_permlane32_swap(ul, ul, false, false);
        const unsigned l0 = rr[0], l1 = rr[1];
        const float lt = __uint_as_float(l0) + __uint_as_float(l1);
        LAS float* wsf = (LAS float*)(L + AT_WSF) + wid * 32;
        if (hi == 0) wsf[r32] = lt;
        LDS_WAIT(); asm volatile("" ::: "memory");
#pragma unroll
        for (int r = 0; r < 16; ++r) {
            const int q = crow(r, hi);
            const float rl = 1.0f / wsf[q];
            const size_t row = qrow + q;
            const float g0 = bf2f(PC[row * PC_LD + 1152 + h * 64 + r32]), g1 = bf2f(PC[row * PC_LD + 1152 + h * 64 + 32 + r32]);
            Y[row * D + 640 + h * 64 + r32] = (bf16)f2bf(silu_f(g0) * o0[r] * rl);
            Y[row * D + 640 + h * 64 + 32 + r32] = (bf16)f2bf(silu_f(g1) * o1[r] * rl);
        }
    }
    __syncthreads();
}
__device__ __forceinline__ float softplus_f(float x) { return fmaxf(x, 0.f) + log1pf(__expf(-fabsf(x))); }
__device__ __forceinline__ void rwkv_pre_simple(Frame& F, const Args& A, int layer) {
    LAS float* lw = (LAS float*)(F.lds + RING_OFF);
    LAS float* la = lw + 64;
    LAS float* vs = la + 64;
    LAS float* h1 = vs + 384;
    LAS float* k2 = h1 + 32;
    const bf16* PB = (const bf16*)(F.ws + WS_PB);
    bf16* OPS = (bf16*)(F.ws + WS_OPS);
    const float* mu = A.in[9] + layer * BSHIFT;
    const float* w0 = A.in[10] + layer * 384; const float* w2 = A.in[11] + (size_t)layer * 64 * 384;
    const float* a0 = A.in[12] + layer * 384; const float* a2 = A.in[13] + (size_t)layer * 64 * 384;
    const float* kkp = A.in[14] + layer * 384; const float* kap = A.in[15] + layer * 384;
    const float* v0 = A.in[19]; const float* v1 = A.in[20]; const float* v2 = A.in[21];
    const int per = M / F.G;
    const int tid = F.tid;
    for (int m = F.vcu * per; m < (F.vcu + 1) * per; ++m) {
        const int t = m % T, b = m / T;
        const bf16* pc = PB + (size_t)m * PB_LD; const bf16* pp = pc - PB_LD;
        float xr = 0.f, xk = 0.f, xv = 0.f;
        if (tid < 384) {
            const float c0 = bf2f(pc[tid]), c1 = bf2f(pc[384 + tid]), c2 = bf2f(pc[768 + tid]);
            const float p0 = t ? bf2f(pp[tid]) : 0.f, p1 = t ? bf2f(pp[384 + tid]) : 0.f, p2 = t ? bf2f(pp[768 + tid]) : 0.f;
            xr = c0 + (p0 - c0) * mu[tid]; xk = c1 + (p1 - c1) * mu[384 + tid]; xv = c2 + (p2 - c2) * mu[768 + tid];
            vs[tid] = xv;
        } else {
            const int i = tid - 384, col = 1152 + i;
            const float c0 = bf2f(pc[col]), p0 = t ? bf2f(pp[col]) : 0.f;
            const float xl = c0 + (p0 - c0) * mu[col];
            if (i < 64) lw[i] = tanhf(xl); else la[i - 64] = xl;
        }
        __syncthreads();
        float wlin = 0.f, alin = 0.f;
        if (tid < 384) {
#pragma unroll 8
            for (int i = 0; i < 64; ++i) { wlin += lw[i] * w2[i * 384 + tid]; alin += la[i] * a2[i * 384 + tid]; }
        } else if (layer && tid < 384 + 32) {
            const int n = tid - 384; float acc = 0.f;
            for (int j = 0; j < 384; ++j) acc += vs[j] * v1[j * 32 + n];
            h1[n] = acc;
        }
        float kk = 0.f;
        if (tid < 384) { kk = xk * kkp[tid]; k2[tid] = kk * kk; }
        __syncthreads();
        if (tid < 384) {
            const int hh = tid >> 6, cc = tid & 63;
            const size_t oidx = ((size_t)(b * BH + hh) * T + t) * 384 + cc;
            if (layer) {
                float vl = 0.f;
#pragma unroll 8
                for (int n = 0; n < 32; ++n) vl += h1[n] * v2[n * 384 + tid];
                const float vf = bf2f(OPS[oidx + 3 * 64]);
                xv = xv + (vf - xv) * sigmoid_f(v0[tid] + vl);
            }
            const float w = -softplus_f(-(w0[tid] + wlin)) - 0.5f;
            const float dw = -expm1f(-__expf(w));
            const float a = sigmoid_f(a0[tid] + alin);
            float hs = 0.f;
#pragma unroll 8
            for (int i = 0; i < 64; ++i) hs += k2[hh * 64 + i];
            const float kn = kk / fmaxf(sqrtf(hs), 1e-12f);
            const float kq = xk * (1.f + (a - 1.f) * kap[tid]);
            OPS[oidx] = (bf16)f2bf(xr); OPS[oidx + 64] = (bf16)f2bf(dw); OPS[oidx + 128] = (bf16)f2bf(kq);
            OPS[oidx + 192] = (bf16)f2bf(xv); OPS[oidx + 256] = (bf16)f2bf(-kn); OPS[oidx + 320] = (bf16)f2bf(kn * a);
        }
        __syncthreads();
    }
}


constexpr int PR_A1 = 0, PR_A2 = 9216, PR_A4 = 18432, PR_A3 = 24576;
__device__ __forceinline__ float rowred16(float x) { x += dppx<0xB1>(x); x += dppx<0x4E>(x); x += dppx<0x141>(x); x += dppx<0x140>(x); return x; }
template <int layer> __device__ __forceinline__ void rwkv_pre_tile(Frame& F, const Args& A, int tile) {
    LAS unsigned char* L = F.lds + RING_OFF;
    const bf16* PB = (const bf16*)(F.ws + WS_PB);
    bf16* OPS = (bf16*)(F.ws + WS_OPS);
    const bf16* LW = (const bf16*)(F.ws + WS_LORA);
    const float* mu = A.in[9] + layer * BSHIFT;
    const int tid = opaque_i(F.tid), lane = tid & 63, wid = F.wave, lc = lane & 15, lq = lane >> 4;
    const size_t m0 = (size_t)tile * 64;
    const int b = (int)(m0 / T), t0 = (int)(m0 % T);
    {
        const int tt = tid >> 3, cg = tid & 7;
        const bool hasp = (t0 + tt) != 0;
        const bf16* pc = PB + (m0 + tt) * PB_LD; const bf16* pp = pc - PB_LD;
        {   const int c0 = 1152 + 16 * cg;
            unsigned outw[8];
#pragma unroll
            for (int i = 0; i < 2; ++i) {
                const v4u c = *(const v4u*)(pc + c0 + 8 * i); v4u p = (v4u){0u, 0u, 0u, 0u}; if (hasp) p = *(const v4u*)(pp + c0 + 8 * i);
                const unsigned cw[4] = {c.x, c.y, c.z, c.w}, pw[4] = {p.x, p.y, p.z, p.w};
#pragma unroll
                for (int e = 0; e < 4; ++e) {
                    const int col = c0 + 8 * i + 2 * e;
                    float x0 = bflo(cw[e]), x1 = bfhi(cw[e]);
                    x0 = x0 + (bflo(pw[e]) - x0) * mu[col]; x1 = x1 + (bfhi(pw[e]) - x1) * mu[col + 1];
                    if (cg < 4) { x0 = tanhf(x0); x1 = tanhf(x1); }
                    outw[4 * i + e] = pk2(x0, x1);
                }
            }
            LAS v4u* d = (LAS v4u*)(L + (cg < 4 ? PR_A1 : PR_A2) + tt * 144 + (cg & 3) * 32);
            d[0] = (v4u){outw[0], outw[1], outw[2], outw[3]}; d[1] = (v4u){outw[4], outw[5], outw[6], outw[7]};
        }
        if (layer) {
#pragma unroll
            for (int i = 0; i < 6; ++i) {
                const int c0 = 768 + 48 * cg + 8 * i;
                const v4u c = *(const v4u*)(pc + c0); v4u p = (v4u){0u, 0u, 0u, 0u}; if (hasp) p = *(const v4u*)(pp + c0);
                const unsigned cw[4] = {c.x, c.y, c.z, c.w}, pw[4] = {p.x, p.y, p.z, p.w}; unsigned ow[4];
#pragma unroll
                for (int e = 0; e < 4; ++e) { float x0 = bflo(cw[e]), x1 = bfhi(cw[e]);
                    x0 = x0 + (bflo(pw[e]) - x0) * mu[c0 + 2 * e]; x1 = x1 + (bfhi(pw[e]) - x1) * mu[c0 + 2 * e + 1]; ow[e] = pk2(x0, x1); }
                *(LAS v4u*)(L + PR_A3 + tt * 784 + (48 * cg + 8 * i) * 2) = (v4u){ow[0], ow[1], ow[2], ow[3]};
            }
        }
    }
    __syncthreads();
    if (layer) {
        const int tq = wid >> 1, nt = wid & 1;
        f32x4m acc = {0.f, 0.f, 0.f, 0.f};
#pragma unroll
        for (int ks = 0; ks < 12; ++ks) {
            const bf16x8 a3 = *(const LAS bf16x8*)(L + PR_A3 + (16 * tq + lc) * 784 + (32 * ks + 8 * lq) * 2);
            const bf16x8 bv = *(const bf16x8*)(LW + LO_V1T + (16 * nt + lc) * 384 + 32 * ks + 8 * lq);
            acc = __builtin_amdgcn_mfma_f32_16x16x32_bf16(a3, bv, acc, 0, 0, 0);
        }
#pragma unroll
        for (int r = 0; r < 4; ++r) *(LAS bf16*)(L + PR_A4 + (16 * tq + 4 * lq + r) * 80 + (16 * nt + lc) * 2) = (bf16)f2bf(acc[r]);
        __syncthreads();
    }
    const float* w0 = A.in[10] + layer * 384; const float* a0 = A.in[12] + layer * 384;
    const float* kkp = A.in[14] + layer * 384; const float* kap = A.in[15] + layer * 384; const float* v0 = A.in[19];
#pragma unroll 1
    for (int ui = 0; ui < 3; ++ui) {
        const int id = 3 * wid + ui, hh = id >> 2, tq = id & 3;
        f32x4m wl[4], al[4], vl[4];
#pragma unroll
        for (int ct = 0; ct < 4; ++ct) { wl[ct] = (f32x4m){0.f, 0.f, 0.f, 0.f}; al[ct] = wl[ct]; vl[ct] = wl[ct]; }
#pragma unroll
        for (int ks = 0; ks < 2; ++ks) {
            const bf16x8 a1 = *(const LAS bf16x8*)(L + PR_A1 + (16 * tq + lc) * 144 + (32 * ks + 8 * lq) * 2);
            const bf16x8 a2f = *(const LAS bf16x8*)(L + PR_A2 + (16 * tq + lc) * 144 + (32 * ks + 8 * lq) * 2);
#pragma unroll
            for (int ct = 0; ct < 4; ++ct) {
                const int col = hh * 64 + ct * 16 + lc;
                const bf16x8 bw = *(const bf16x8*)(LW + LO_W2T + ((size_t)layer * 384 + col) * 64 + 32 * ks + 8 * lq);
                const bf16x8 ba = *(const bf16x8*)(LW + LO_A2T + ((size_t)layer * 384 + col) * 64 + 32 * ks + 8 * lq);
                wl[ct] = __builtin_amdgcn_mfma_f32_16x16x32_bf16(a1, bw, wl[ct], 0, 0, 0);
                al[ct] = __builtin_amdgcn_mfma_f32_16x16x32_bf16(a2f, ba, al[ct], 0, 0, 0);
            }
        }
        if (layer) {
            const bf16x8 a4 = *(const LAS bf16x8*)(L + PR_A4 + (16 * tq + lc) * 80 + 8 * lq * 2);
#pragma unroll
            for (int ct = 0; ct < 4; ++ct) {
                const int col = hh * 64 + ct * 16 + lc;
                const bf16x8 bv = *(const bf16x8*)(LW + LO_V2T + col * 32 + 8 * lq);
                vl[ct] = __builtin_amdgcn_mfma_f32_16x16x32_bf16(a4, bv, vl[ct], 0, 0, 0);
            }
        }
        float kkv[4][4], av[4][4], ss[4] = {0.f, 0.f, 0.f, 0.f};
        const size_t obase = ((size_t)(b * BH + hh) * T + t0 + 16 * tq + 4 * lq) * 384;
#pragma unroll
        for (int ct = 0; ct < 4; ++ct) {
            const int col = hh * 64 + ct * 16 + lc, cc = ct * 16 + lc;
            const float mur = mu[col], muk = mu[384 + col], muv = mu[768 + col], w0c = w0[col], a0c = a0[col], kkc = kkp[col], kac = kap[col];
            const float v0c = layer ? v0[col] : 0.f;
#pragma unroll
            for (int r = 0; r < 4; ++r) {
                const int tok = 16 * tq + 4 * lq + r;
                const bf16* pc = PB + (m0 + tok) * PB_LD + col; const bf16* pp = pc - PB_LD;
                const bool hasp = (t0 + tok) != 0;
                const float c0 = bf2f(pc[0]), c1 = bf2f(pc[384]), c2 = bf2f(pc[768]);
                const float p0 = hasp ? bf2f(pp[0]) : 0.f, p1 = hasp ? bf2f(pp[384]) : 0.f, p2 = hasp ? bf2f(pp[768]) : 0.f;
                const float xr = c0 + (p0 - c0) * mur, xk = c1 + (p1 - c1) * muk; float xv = c2 + (p2 - c2) * muv;
                const size_t oidx = obase + (size_t)r * 384 + cc;
                if (layer) { const float vf = bf2f(OPS[oidx + 192]); xv = xv + (vf - xv) * sigmoid_f(v0c + vl[ct][r]); }
                const float w = -softplus_f(-(w0c + wl[ct][r])) - 0.5f;
                const float dw = -expm1f(-__expf(w));
                const float a = sigmoid_f(a0c + al[ct][r]);
                const float kk = xk * kkc;
                kkv[ct][r] = kk; av[ct][r] = a; ss[r] += kk * kk;
                OPS[oidx] = (bf16)f2bf(xr); OPS[oidx + 64] = (bf16)f2bf(dw); OPS[oidx + 128] = (bf16)f2bf(xk * (1.f + (a - 1.f) * kac)); OPS[oidx + 192] = (bf16)f2bf(xv);
            }
        }
#pragma unroll
        for (int r = 0; r < 4; ++r) ss[r] = 1.0f / fmaxf(sqrtf(rowred16(ss[r])), 1e-12f);
#pragma unroll
        for (int ct = 0; ct < 4; ++ct)
#pragma unroll
            for (int r = 0; r < 4; ++r) { const size_t oidx = obase + (size_t)r * 384 + ct * 16 + lc; const float kn = kkv[ct][r] * ss[r];
                OPS[oidx + 256] = (bf16)f2bf(-kn); OPS[oidx + 320] = (bf16)f2bf(kn * av[ct][r]); }
    }
    __syncthreads();
}

constexpr int P2_A1 = 0, P2_A2 = 9216, P2_A4 = 18432, P2_RN = 23552, P2_XS = 24576, P2_XST = 272, P2_OT = 77824, P2_A3 = 24576;
template <int layer> __device__ __forceinline__ void rwkv_pre_tile2(Frame& F, const Args& A, int tile) {
    LAS unsigned char* L = F.lds + RING_OFF;
    const bf16* PB = (const bf16*)(F.ws + WS_PB);
    bf16* OPS = (bf16*)(F.ws + WS_OPS);
    const bf16* LW = (const bf16*)(F.ws + WS_LORA);
    const float* mu = A.in[9] + layer * BSHIFT;
    const int tid = opaque_i(F.tid), lane = tid & 63, wid = F.wave, lc = lane & 15, lq = lane >> 4;
    const int tr = wid >> 1, tc0 = 2 * (wid & 1);
    const size_t m0 = (size_t)tile * 64;
    const int b = (int)(m0 / T), t0 = (int)(m0 % T);
    const int tt = tid >> 3, cg = tid & 7;
    const bool hasp = (t0 + tt) != 0;
    const bf16* pc = PB + (m0 + tt) * PB_LD; const bf16* pp = pc - PB_LD;
    {
        {   const int c0 = 1152 + 16 * cg;
            unsigned outw[8];
#pragma unroll
            for (int i = 0; i < 2; ++i) {
                const v4u c = *(const v4u*)(pc + c0 + 8 * i); v4u p = (v4u){0u, 0u, 0u, 0u}; if (hasp) p = *(const v4u*)(pp + c0 + 8 * i);
                const unsigned cw[4] = {c.x, c.y, c.z, c.w}, pw[4] = {p.x, p.y, p.z, p.w};
#pragma unroll
                for (int e = 0; e < 4; ++e) {
                    const int col = c0 + 8 * i + 2 * e;
                    float x0 = bflo(cw[e]), x1 = bfhi(cw[e]);
                    x0 = x0 + (bflo(pw[e]) - x0) * mu[col]; x1 = x1 + (bfhi(pw[e]) - x1) * mu[col + 1];
                    if (cg < 4) { x0 = tanhf(x0); x1 = tanhf(x1); }
                    outw[4 * i + e] = pk2(x0, x1);
                }
            }
            LAS v4u* d = (LAS v4u*)(L + (cg < 4 ? P2_A1 : P2_A2) + tt * 144 + (cg & 3) * 32);
            d[0] = (v4u){outw[0], outw[1], outw[2], outw[3]}; d[1] = (v4u){outw[4], outw[5], outw[6], outw[7]};
        }
        if (layer) {
#pragma unroll
            for (int i = 0; i < 6; ++i) {
                const int c0 = 768 + 48 * cg + 8 * i;
                const v4u c = *(const v4u*)(pc + c0); v4u p = (v4u){0u, 0u, 0u, 0u}; if (hasp) p = *(const v4u*)(pp + c0);
                const unsigned cw[4] = {c.x, c.y, c.z, c.w}, pw[4] = {p.x, p.y, p.z, p.w}; unsigned ow[4];
#pragma unroll
                for (int e = 0; e < 4; ++e) { float x0 = bflo(cw[e]), x1 = bfhi(cw[e]);
                    x0 = x0 + (bflo(pw[e]) - x0) * mu[c0 + 2 * e]; x1 = x1 + (bfhi(pw[e]) - x1) * mu[c0 + 2 * e + 1]; ow[e] = pk2(x0, x1); }
                *(LAS v4u*)(L + P2_A3 + tt * 784 + (48 * cg + 8 * i) * 2) = (v4u){ow[0], ow[1], ow[2], ow[3]};
            }
        }
    }
    __syncthreads();
    if (layer) {
        const int tq = wid >> 1, nt = wid & 1;
        f32x4m acc = {0.f, 0.f, 0.f, 0.f};
#pragma unroll
        for (int ks = 0; ks < 12; ++ks) {
            const bf16x8 a3 = *(const LAS bf16x8*)(L + P2_A3 + (16 * tq + lc) * 784 + (32 * ks + 8 * lq) * 2);
            const bf16x8 bv = *(const bf16x8*)(LW + LO_V1T + (16 * nt + lc) * 384 + 32 * ks + 8 * lq);
            acc = __builtin_amdgcn_mfma_f32_16x16x32_bf16(a3, bv, acc, 0, 0, 0);
        }
#pragma unroll
        for (int r = 0; r < 4; ++r) *(LAS bf16*)(L + P2_A4 + (16 * tq + 4 * lq + r) * 80 + (16 * nt + lc) * 2) = (bf16)f2bf(acc[r]);
        __syncthreads();
    }
    const float* w0 = A.in[10] + layer * 384; const float* a0 = A.in[12] + layer * 384;
    const float* kkp = A.in[14] + layer * 384; const float* kap = A.in[15] + layer * 384; const float* v0 = A.in[19];
#pragma unroll 1
    for (int hh = 0; hh < BH; ++hh) {
        {
            float ss = 0.f;
#pragma unroll
            for (int i = 0; i < 3; ++i) {
                const int c0 = i * 384 + hh * 64 + cg * 8;
                const v4u c = *(const v4u*)(pc + c0); v4u p = (v4u){0u, 0u, 0u, 0u}; if (hasp) p = *(const v4u*)(pp + c0);
                const f32x4m m0v = *(const f32x4m*)(mu + c0), m1v = *(const f32x4m*)(mu + c0 + 4);
                f32x4m x0 = {bflo(c.x), bfhi(c.x), bflo(c.y), bfhi(c.y)}, x1 = {bflo(c.z), bfhi(c.z), bflo(c.w), bfhi(c.w)};
                const f32x4m q0 = {bflo(p.x), bfhi(p.x), bflo(p.y), bfhi(p.y)}, q1 = {bflo(p.z), bfhi(p.z), bflo(p.w), bfhi(p.w)};
                x0 = x0 + (q0 - x0) * m0v; x1 = x1 + (q1 - x1) * m1v;
                LAS f32x4m* d = (LAS f32x4m*)(L + P2_XS + (i * 64 + tt) * P2_XST + cg * 32);
                d[0] = x0; d[1] = x1;
                if (i == 1) { const f32x4m k0 = *(const f32x4m*)(kkp + hh * 64 + cg * 8), k1 = *(const f32x4m*)(kkp + hh * 64 + cg * 8 + 4);
                    const f32x4m y0 = x0 * k0, y1 = x1 * k1; ss = (y0.x * y0.x + y0.y * y0.y) + (y0.z * y0.z + y0.w * y0.w) + (y1.x * y1.x + y1.y * y1.y) + (y1.z * y1.z + y1.w * y1.w); }
            }
            ss += dppx<0xB1>(ss); ss += dppx<0x4E>(ss); ss += dppx<0x141>(ss);
            if (cg == 0) *(LAS float*)(L + P2_RN + tt * 4) = 1.0f / fmaxf(sqrtf(ss), 1e-12f);
        }
        __syncthreads();
        f32x4m wl[2], al[2], vl[2];
        {
            bf16x8 a1[2], a2f[2];
#pragma unroll
            for (int ks = 0; ks < 2; ++ks) { a1[ks] = *(const LAS bf16x8*)(L + P2_A1 + (16 * tr + lc) * 144 + (32 * ks + 8 * lq) * 2); a2f[ks] = *(const LAS bf16x8*)(L + P2_A2 + (16 * tr + lc) * 144 + (32 * ks + 8 * lq) * 2); }
#pragma unroll
            for (int j = 0; j < 2; ++j) {
                const int col = hh * 64 + 16 * (tc0 + j) + lc;
                wl[j] = (f32x4m){0.f, 0.f, 0.f, 0.f}; al[j] = wl[j]; vl[j] = wl[j];
#pragma unroll
                for (int ks = 0; ks < 2; ++ks) {
                    const bf16x8 bw = *(const bf16x8*)(LW + LO_W2T + ((size_t)layer * 384 + col) * 64 + 32 * ks + 8 * lq);
                    const bf16x8 ba = *(const bf16x8*)(LW + LO_A2T + ((size_t)layer * 384 + col) * 64 + 32 * ks + 8 * lq);
                    wl[j] = __builtin_amdgcn_mfma_f32_16x16x32_bf16(a1[ks], bw, wl[j], 0, 0, 0);
                    al[j] = __builtin_amdgcn_mfma_f32_16x16x32_bf16(a2f[ks], ba, al[j], 0, 0, 0);
                }
                if (layer) {
                    const bf16x8 a4 = *(const LAS bf16x8*)(L + P2_A4 + (16 * tr + lc) * 80 + 8 * lq * 2);
                    const bf16x8 bv = *(const bf16x8*)(LW + LO_V2T + col * 32 + 8 * lq);
                    vl[j] = __builtin_amdgcn_mfma_f32_16x16x32_bf16(a4, bv, vl[j], 0, 0, 0);
                }
            }
        }
        {
            const size_t gbase = ((size_t)(b * BH + hh) * T + t0) * 384;
            float vfv[2][4];
            if (layer) {
#pragma unroll
                for (int j = 0; j < 2; ++j)
#pragma unroll
                    for (int r = 0; r < 4; ++r) vfv[j][r] = bf2f(OPS[gbase + (size_t)(16 * tr + 4 * lq + r) * 384 + 192 + 16 * (tc0 + j) + lc]);
            }
#pragma unroll
            for (int j = 0; j < 2; ++j) {
                const int cc = 16 * (tc0 + j) + lc, col = hh * 64 + cc;
                const float w0c = w0[col], a0c = a0[col], kkc = kkp[col], kac = kap[col];
                const float v0c = layer ? v0[col] : 0.f;
#pragma unroll
                for (int r = 0; r < 4; ++r) {
                    const int tok = 16 * tr + 4 * lq + r;
                    const float xr = *(const LAS float*)(L + P2_XS + tok * P2_XST + cc * 4);
                    const float xk = *(const LAS float*)(L + P2_XS + (64 + tok) * P2_XST + cc * 4);
                    float xv = *(const LAS float*)(L + P2_XS + (128 + tok) * P2_XST + cc * 4);
                    const float rn = *(const LAS float*)(L + P2_RN + tok * 4);
                    if (layer) xv = xv + (vfv[j][r] - xv) * sigmoid_f(v0c + vl[j][r]);
                    const float w = -softplus_f(-(w0c + wl[j][r])) - 0.5f;
                    const float dw = -expm1f(-__expf(w));
                    const float a = sigmoid_f(a0c + al[j][r]);
                    const float kn = xk * kkc * rn;
                    LAS bf16* o = (LAS bf16*)(L + P2_OT + (tok * 384 + cc) * 2);
                    o[0] = (bf16)f2bf(xr); o[64] = (bf16)f2bf(dw); o[128] = (bf16)f2bf(xk * (1.f + (a - 1.f) * kac)); o[192] = (bf16)f2bf(xv);
                    o[256] = (bf16)f2bf(-kn); o[320] = (bf16)f2bf(kn * a);
                }
            }
        }
        __syncthreads();
        {
            unsigned char* gd = (unsigned char*)(OPS + ((size_t)(b * BH + hh) * T + t0) * 384);
#pragma unroll
            for (int i = 0; i < 6; ++i) *(v4u*)(gd + (size_t)(tid + 512 * i) * 16) = *(const LAS v4u*)(L + P2_OT + (tid + 512 * i) * 16);
        }
    }
    __syncthreads();
}
__device__ __forceinline__ float allred32(float x) {
    x += __shfl_xor(x, 1); x += __shfl_xor(x, 2); x += __shfl_xor(x, 4); x += __shfl_xor(x, 8); x += __shfl_xor(x, 16);
    return x;
}
__device__ __forceinline__ void rwkv_scan_simple(Frame& F, int unit) {
    const int bh = unit >> 2, qt = unit & 3, b = bh / BH, h = bh % BH;
    const int row = 16 * qt + 2 * F.wave + (F.lane >> 5), kp = F.lane & 31;
    const unsigned* op = (const unsigned*)(F.ws + WS_OPS) + (size_t)bh * T * 192;
    unsigned char* yb = F.ws + WS_PB + (size_t)b * T * (PB_LD * 2) + (size_t)(h * 64 + row) * 4;
    float s0 = 0.f, s1 = 0.f, ykeep = 0.f;
    for (int t0 = 0; t0 < T; t0 += 32) {
#pragma unroll 4
        for (int tt = 0; tt < 32; ++tt) {
            const unsigned* o = op + (size_t)(t0 + tt) * 192;
            const unsigned ur = o[kp], udw = o[32 + kp], uk = o[64 + kp], ua = o[128 + kp], ub = o[160 + kp];
            const float vv = bf2f(((const unsigned short*)(o + 96))[row]);
            const float sa = allred32(s0 * bflo(ua) + s1 * bfhi(ua));
            s0 = s0 * (1.f - bflo(udw)) + (sa * bflo(ub) + vv * bflo(uk));
            s1 = s1 * (1.f - bfhi(udw)) + (sa * bfhi(ub) + vv * bfhi(uk));
            const float y = allred32(s0 * bflo(ur) + s1 * bfhi(ur));
            if (kp == tt) ykeep = y;
        }
        *(float*)(yb + (size_t)(t0 + kp) * (PB_LD * 2)) = ykeep;
    }
}

__device__ __forceinline__ float allred32_dpp(float x) {
    x += dppx<0xB1>(x); x += dppx<0x4E>(x); x += dppx<0x141>(x); x += dppx<0x140>(x);
    const unsigned u = __float_as_uint(x);
    auto r = __builtin_amdgcn_permlane16_swap(u, u, false, false);
    const unsigned r0 = r[0], r1 = r[1];
    return __uint_as_float(r0) + __uint_as_float(r1);
}
constexpr int SC_CH = 32, SC_VEC = (SC_CH / 2) * 512, SC_VOFF = 5 * SC_VEC, SC_BUF = SC_VOFF + (SC_CH / 2) * 128;
typedef float f32x2g __attribute__((ext_vector_type(2)));
__device__ __forceinline__ void scan_write_chunk(LAS unsigned char* Lb, const v4u (&st)[3], int tid, int qt) {
#pragma unroll
    for (int i = 0; i < 3; ++i) {
        const int p = tid + 512 * i, step = p / 48, q = p - step * 48, vec = q >> 3, e0 = (q & 7) * 8;
        float f[8] = {bflo(st[i].x), bfhi(st[i].x), bflo(st[i].y), bfhi(st[i].y), bflo(st[i].z), bfhi(st[i].z), bflo(st[i].w), bfhi(st[i].w)};
        if (vec == 1) {
#pragma unroll
            for (int j = 0; j < 8; ++j) f[j] = 1.0f - f[j];
        }
        const int slot = (0x207314 >> (4 * vec)) & 7;
        if (vec != 3) {
            LAS unsigned char* d = Lb + slot * SC_VEC + (step >> 1) * 512 + (e0 >> 1) * 16 + (step & 1) * 8;
#pragma unroll
            for (int j = 0; j < 4; ++j) *(LAS f32x2g*)(d + j * 16) = (f32x2g){f[2 * j], f[2 * j + 1]};
        } else if ((e0 >> 4) == qt) {
            LAS unsigned char* d = Lb + SC_VOFF + (step >> 1) * 128 + (e0 & 15) * 8 + (step & 1) * 4;
#pragma unroll
            for (int j = 0; j < 8; ++j) *(LAS float*)(d + j * 8) = f[j];
        }
    }
}
__device__ __forceinline__ void rwkv_scan_lds(Frame& F, int unit) {
    const int bh = unit >> 2, qt = unit & 3, b = bh / BH, h = bh % BH;
    const int half = F.lane >> 5, kp = F.lane & 31, rloc = 2 * F.wave + half, row = 16 * qt + rloc;
    LAS unsigned char* L = F.lds + RING_OFF;
    const unsigned char* ops = F.ws + WS_OPS + (size_t)bh * T * 768;
    unsigned char* yb = F.ws + WS_PB + (size_t)b * T * (PB_LD * 2) + (size_t)(h * 64 + row) * 4;
    v4u st[3];
    __syncthreads();
#pragma unroll
    for (int i = 0; i < 3; ++i) st[i] = *(const v4u*)(ops + (size_t)(F.tid + 512 * i) * 16);
    scan_write_chunk(L, st, F.tid, qt);
    __syncthreads();
    float s0 = 0.f, s1 = 0.f;
    constexpr int NCH = T / SC_CH;
    for (int c = 0; c < NCH; ++c) {
        if (c + 1 < NCH) {
#pragma unroll
            for (int i = 0; i < 3; ++i) st[i] = *(const v4u*)(ops + (size_t)(c + 1) * (SC_CH * 768) + (size_t)(F.tid + 512 * i) * 16);
        }
        const LAS unsigned char* Lb = L + (c & 1) * SC_BUF + kp * 16;
        const LAS unsigned char* Lv = L + (c & 1) * SC_BUF + SC_VOFF + rloc * 8;
        float ykeep = 0.f;
#pragma unroll
        for (int tp = 0; tp < SC_CH / 2; ++tp) {
            const f32x4 a4 = *(const LAS f32x4*)(Lb + tp * 512), w4 = *(const LAS f32x4*)(Lb + SC_VEC + tp * 512), b4 = *(const LAS f32x4*)(Lb + 2 * SC_VEC + tp * 512),
                        k4 = *(const LAS f32x4*)(Lb + 3 * SC_VEC + tp * 512), r4 = *(const LAS f32x4*)(Lb + 4 * SC_VEC + tp * 512);
            const f32x2g v2 = *(const LAS f32x2g*)(Lv + tp * 128);
            {   const float sa = allred32_dpp(s0 * a4.x + s1 * a4.y);
                s0 = s0 * w4.x + (sa * b4.x + v2.x * k4.x);
                s1 = s1 * w4.y + (sa * b4.y + v2.x * k4.y);
                const float y = allred32_dpp(s0 * r4.x + s1 * r4.y);
                if (kp == 2 * tp) ykeep = y; }
            {   const float sa = allred32_dpp(s0 * a4.z + s1 * a4.w);
                s0 = s0 * w4.z + (sa * b4.z + v2.y * k4.z);
                s1 = s1 * w4.w + (sa * b4.w + v2.y * k4.w);
                const float y = allred32_dpp(s0 * r4.z + s1 * r4.w);
                if (kp == 2 * tp + 1) ykeep = y; }
        }
        *(float*)(yb + (size_t)(c * SC_CH + kp) * (PB_LD * 2)) = ykeep;
        if (c + 1 < NCH) scan_write_chunk(L + ((c + 1) & 1) * SC_BUF, st, F.tid, qt);
        __syncthreads();
    }
}

constexpr int CK_ST = 144;
constexpr int CK_SLOT = 64 * CK_ST;
#define CK_SL(i) ((i) * CK_SLOT)
constexpr int CK_NF = 15 * CK_SLOT;
constexpr int CK_G63 = CK_NF + 4096;
constexpr int CK_GT = CK_G63 + 256;
static_assert(CK_GT + 2048 <= RING_BYTES, "chunk_prep LDS");
__device__ __forceinline__ void mm64(f32x4m (&acc)[2], const LAS unsigned char* X, const LAS unsigned char* YT, int tr, int tc0, int lc, int lq) {
#pragma unroll
    for (int ks = 0; ks < 2; ++ks) {
        const bf16x8 a = *(const LAS bf16x8*)(X + (16 * tr + lc) * CK_ST + (32 * ks + 8 * lq) * 2);
#pragma unroll
        for (int j = 0; j < 2; ++j) {
            const bf16x8 b = *(const LAS bf16x8*)(YT + (16 * (tc0 + j) + lc) * CK_ST + (32 * ks + 8 * lq) * 2);
            acc[j] = __builtin_amdgcn_mfma_f32_16x16x32_bf16(a, b, acc[j], 0, 0, 0);
        }
    }
}
__device__ __forceinline__ void ldA(bf16x8 (&a)[2], const LAS unsigned char* X, int tr, int lc, int lq) {
#pragma unroll
    for (int ks = 0; ks < 2; ++ks) a[ks] = *(const LAS bf16x8*)(X + (16 * tr + lc) * CK_ST + (32 * ks + 8 * lq) * 2);
}
__device__ __forceinline__ void ldB(bf16x8 (&b)[2][2], const LAS unsigned char* YT, int tc0, int lc, int lq) {
#pragma unroll
    for (int j = 0; j < 2; ++j)
#pragma unroll
        for (int ks = 0; ks < 2; ++ks) b[j][ks] = *(const LAS bf16x8*)(YT + (16 * (tc0 + j) + lc) * CK_ST + (32 * ks + 8 * lq) * 2);
}
__device__ __forceinline__ void mmr(f32x4m (&acc)[2], const bf16x8 (&a)[2], const bf16x8 (&b)[2][2]) {
#pragma unroll
    for (int ks = 0; ks < 2; ++ks)
#pragma unroll
        for (int j = 0; j < 2; ++j) acc[j] = __builtin_amdgcn_mfma_f32_16x16x32_bf16(a[ks], b[j][ks], acc[j], 0, 0, 0);
}
__device__ __forceinline__ void st_rm(LAS unsigned char* B, const f32x4m (&acc)[2], int tr, int tc0, int lc, int lq) {
#pragma unroll
    for (int j = 0; j < 2; ++j)
#pragma unroll
        for (int r = 0; r < 4; ++r) *(LAS bf16*)(B + (16 * tr + 4 * lq + r) * CK_ST + (16 * (tc0 + j) + lc) * 2) = (bf16)f2bf(acc[j][r]);
}
__device__ __forceinline__ void st_tr(LAS unsigned char* B, const f32x4m (&acc)[2], int tr, int tc0, int lc, int lq) {
#pragma unroll
    for (int j = 0; j < 2; ++j) *(LAS unsigned long long*)(B + (16 * (tc0 + j) + lc) * CK_ST + (16 * tr + 4 * lq) * 2) =
        (unsigned long long)pk2(acc[j][0], acc[j][1]) | ((unsigned long long)pk2(acc[j][2], acc[j][3]) << 32);
}
__device__ __forceinline__ void st_gtr(bf16* Gm, const f32x4m (&acc)[2], int tr, int tc0, int lc, int lq) {
#pragma unroll
    for (int j = 0; j < 2; ++j) *(unsigned long long*)(Gm + (16 * (tc0 + j) + lc) * 64 + 16 * tr + 4 * lq) =
        (unsigned long long)pk2(acc[j][0], acc[j][1]) | ((unsigned long long)pk2(acc[j][2], acc[j][3]) << 32);
}
#define CK_ZERO(acc) do { acc[0] = (f32x4m){0.f, 0.f, 0.f, 0.f}; acc[1] = acc[0]; } while (0)
__device__ __forceinline__ void chunk_prep_unit(Frame& F, int bh, int n, const unsigned (&inr)[24]) {
    LAS unsigned char* L = F.lds + RING_OFF;
    const int tid = opaque_i(F.tid), lane = tid & 63, wid = F.wave, lc = lane & 15, lq = lane >> 4;
    const int tr = wid >> 1, tc0 = 2 * (wid & 1);
    bf16* CH = (bf16*)(F.ws + WS_CHK) + ((size_t)bh * 128 + n) * (4 * 4096);
    for (int rp0 = 0; rp0 < REP_S0; ++rp0) {
        if (rp0) __syncthreads();
        const int k = lane, t8 = 8 * wid;
        float av[8], bv[8], kv[8], rv[8], vv[8], lp[8];
        float run = 0.f;
#pragma unroll
        for (int s8 = 0; s8 < 8; ++s8) {
            rv[s8] = bflo(inr[3 * s8 + 0]); const float dw = bfhi(inr[3 * s8 + 0]); kv[s8] = bflo(inr[3 * s8 + 1]); vv[s8] = bfhi(inr[3 * s8 + 1]); av[s8] = bflo(inr[3 * s8 + 2]); bv[s8] = bfhi(inr[3 * s8 + 2]);
            run += log1pf(-dw); lp[s8] = run;
        }
        LAS float* gt = (LAS float*)(L + CK_GT);
        gt[wid * 64 + k] = run;
        for (int i = tid; i < 2 * CK_SLOT / 16; i += NTHR) *(LAS v4u*)(L + CK_SL(12) + i * 16) = (v4u){0u, 0u, 0u, 0u};
        __syncthreads();
        float off = 0.f, tot = 0.f;
#pragma unroll
        for (int w = 0; w < 8; ++w) { const float g = gt[w * 64 + k]; tot += g; if (w < wid) off += g; }
        if (wid == 0) *(LAS float*)(L + CK_G63 + k * 4) = __expf(tot);
        unsigned pa[4], pbc[4], pkc[4], pv[4];
        float a2[8], bc[8], kc[8];
#pragma unroll
        for (int s8 = 0; s8 < 8; ++s8) {
            const int t = t8 + s8;
            const float Lt = off + lp[s8], Lm = (s8 == 0) ? off : off + lp[s8 - 1];
            const float eP = __expf(Lm), eN = __expf(-Lt), eR = __expf(Lt), eC = __expf(tot - Lt);
            a2[s8] = av[s8] * eP; bc[s8] = bv[s8] * eC; kc[s8] = kv[s8] * eC;
            *(LAS bf16*)(L + CK_SL(0) + t * CK_ST + k * 2) = (bf16)f2bf(a2[s8]);
            *(LAS bf16*)(L + CK_SL(1) + t * CK_ST + k * 2) = (bf16)f2bf(bv[s8] * eN);
            *(LAS bf16*)(L + CK_SL(2) + t * CK_ST + k * 2) = (bf16)f2bf(kv[s8] * eN);
            *(LAS bf16*)(L + CK_SL(4) + t * CK_ST + k * 2) = (bf16)f2bf(rv[s8] * eR);
        }
#pragma unroll
        for (int i = 0; i < 4; ++i) { pa[i] = pk2(a2[2 * i], a2[2 * i + 1]); pbc[i] = pk2(bc[2 * i], bc[2 * i + 1]); pkc[i] = pk2(kc[2 * i], kc[2 * i + 1]); pv[i] = pk2(vv[2 * i], vv[2 * i + 1]); }
        *(LAS v4u*)(L + CK_SL(3) + k * CK_ST + t8 * 2) = (v4u){pa[0], pa[1], pa[2], pa[3]};
        *(LAS v4u*)(L + CK_SL(5) + k * CK_ST + t8 * 2) = (v4u){pbc[0], pbc[1], pbc[2], pbc[3]};
        *(LAS v4u*)(L + CK_SL(6) + k * CK_ST + t8 * 2) = (v4u){pkc[0], pkc[1], pkc[2], pkc[3]};
        *(LAS v4u*)(L + CK_SL(7) + k * CK_ST + t8 * 2) = (v4u){pv[0], pv[1], pv[2], pv[3]};
    }
    __syncthreads();
    {
        bf16x8 xb[2], xk[2], ya[2][2], yr[2][2];
        ldA(xb, L + CK_SL(1), tr, lc, lq); ldA(xk, L + CK_SL(2), tr, lc, lq); ldB(ya, L + CK_SL(0), tc0, lc, lq); ldB(yr, L + CK_SL(4), tc0, lc, lq);
        f32x4m mab[2], mak[2], nbr[2], nkr[2];
        CK_ZERO(mab); CK_ZERO(mak); CK_ZERO(nbr); CK_ZERO(nkr);
        mmr(mab, xb, ya); mmr(mak, xk, ya); mmr(nbr, xb, yr); mmr(nkr, xk, yr);
#pragma unroll
        for (int j = 0; j < 2; ++j)
#pragma unroll
            for (int r = 0; r < 4; ++r) {
                const int i = 16 * tr + 4 * lq + r, t = 16 * (tc0 + j) + lc;
                if (!(i < t)) { mab[j][r] = 0.f; mak[j][r] = 0.f; }
                if (!(i <= t)) { nbr[j][r] = 0.f; nkr[j][r] = 0.f; }
            }
#pragma unroll
        for (int j = 0; j < 2; ++j) if (tr == tc0 + j) {
#pragma unroll
            for (int r = 0; r < 4; ++r) { *(LAS float*)(L + CK_NF + tr * 1024 + (4 * lq + r) * 64 + lc * 4) = mab[j][r]; mab[j][r] = 0.f; }
        }
        st_tr(L + CK_SL(8), mab, tr, tc0, lc, lq);
        st_rm(L + CK_SL(9), mak, tr, tc0, lc, lq);
        st_tr(L + CK_SL(10), nbr, tr, tc0, lc, lq);
        st_tr(L + CK_SL(11), nkr, tr, tc0, lc, lq);
    }
    __syncthreads();
    if (wid == 0) {
        const int bl = lane >> 4, i = lane & 15;
        const LAS float* Nb = (const LAS float*)(L + CK_NF + bl * 1024);
        float Tr[16];
#pragma unroll
        for (int t = 0; t < 16; ++t) {
            float s0 = (i == t) ? 1.f : 0.f, s1 = 0.f;
#pragma unroll
            for (int j = 0; j < t; ++j) { if (j & 1) s1 += Tr[j] * Nb[j * 16 + t]; else s0 += Tr[j] * Nb[j * 16 + t]; }
            Tr[t] = s0 + s1;
        }
        unsigned w[8];
#pragma unroll
        for (int q = 0; q < 8; ++q) w[q] = pk2(Tr[2 * q], Tr[2 * q + 1]);
        LAS unsigned char* d = L + CK_SL(12) + (16 * bl + i) * CK_ST + 16 * bl * 2;
        *(LAS v4u*)d = (v4u){w[0], w[1], w[2], w[3]}; *(LAS v4u*)(d + 16) = (v4u){w[4], w[5], w[6], w[7]};
#pragma unroll
        for (int t = 0; t < 16; ++t) *(LAS bf16*)(L + CK_SL(13) + (16 * bl + t) * CK_ST + (16 * bl + i) * 2) = (bf16)f2bf(Tr[t]);
    }
    __syncthreads();
    f32x4m e1[2];
    {
        bf16x8 xa[2], yb[2][2]; ldA(xa, L + CK_SL(12), tr, lc, lq); ldB(yb, L + CK_SL(8), tc0, lc, lq);
        CK_ZERO(e1); mmr(e1, xa, yb);
        st_rm(L + CK_SL(0), e1, tr, tc0, lc, lq);
        st_tr(L + CK_SL(1), e1, tr, tc0, lc, lq);
    }
    __syncthreads();
    f32x4m e2[2];
    {
        bf16x8 xa[2], yb[2][2]; ldA(xa, L + CK_SL(0), tr, lc, lq); ldB(yb, L + CK_SL(1), tc0, lc, lq);
        CK_ZERO(e2); mmr(e2, xa, yb);
        st_tr(L + CK_SL(2), e2, tr, tc0, lc, lq);
    }
    __syncthreads();
    {
        bf16x8 xa[2], yb[2][2]; ldA(xa, L + CK_SL(0), tr, lc, lq); ldB(yb, L + CK_SL(2), tc0, lc, lq);
        f32x4m f[2]; CK_ZERO(f); mmr(f, xa, yb);
#pragma unroll
        for (int j = 0; j < 2; ++j)
#pragma unroll
            for (int r = 0; r < 4; ++r) { const int i = 16 * tr + 4 * lq + r, t = 16 * (tc0 + j) + lc; f[j][r] += e1[j][r] + e2[j][r] + ((i == t) ? 1.f : 0.f); }
        st_rm(L + CK_SL(8), f, tr, tc0, lc, lq);
    }
    __syncthreads();
    {
        bf16x8 xa[2], yb[2][2]; ldA(xa, L + CK_SL(8), tr, lc, lq); ldB(yb, L + CK_SL(13), tc0, lc, lq);
        f32x4m tt[2]; CK_ZERO(tt); mmr(tt, xa, yb);
        st_tr(L + CK_SL(12), tt, tr, tc0, lc, lq);
    }
    __syncthreads();
    {
        bf16x8 xa[2], xm[2], yb[2][2]; ldA(xa, L + CK_SL(3), tr, lc, lq); ldA(xm, L + CK_SL(9), tr, lc, lq); ldB(yb, L + CK_SL(12), tc0, lc, lq);
        f32x4m p1[2], w2[2]; CK_ZERO(p1); CK_ZERO(w2);
        mmr(p1, xa, yb); mmr(w2, xm, yb);
        st_rm(L + CK_SL(13), p1, tr, tc0, lc, lq);
        st_tr(L + CK_SL(14), w2, tr, tc0, lc, lq);
    }
    __syncthreads();
    {
        bf16x8 xv[2], xp[2], yw[2][2], yc[2][2], yn[2][2];
        ldA(xv, L + CK_SL(7), tr, lc, lq); ldA(xp, L + CK_SL(13), tr, lc, lq); ldB(yw, L + CK_SL(14), tc0, lc, lq); ldB(yc, L + CK_SL(5), tc0, lc, lq); ldB(yn, L + CK_SL(10), tc0, lc, lq);
        f32x4m ub[2], g[2], rh[2]; CK_ZERO(ub); CK_ZERO(g); CK_ZERO(rh);
        mmr(ub, xv, yw); mmr(g, xp, yc); mmr(rh, xp, yn);
#pragma unroll
        for (int j = 0; j < 2; ++j)
#pragma unroll
            for (int r = 0; r < 4; ++r) { const int row = 16 * tr + 4 * lq + r, col = 16 * (tc0 + j) + lc;
                if (row == col) g[j][r] += *(const LAS float*)(L + CK_G63 + row * 4);
                rh[j][r] += bf2f(*(const LAS bf16*)(L + CK_SL(4) + col * CK_ST + row * 2)); }
        st_gtr(CH + 0 * 4096, g, tr, tc0, lc, lq);
        st_gtr(CH + 2 * 4096, rh, tr, tc0, lc, lq);
        st_rm(L + CK_SL(3), ub, tr, tc0, lc, lq);
    }
    __syncthreads();
    {
        bf16x8 xu[2], xv[2], yc[2][2], yk[2][2], yn[2][2], ym[2][2];
        ldA(xu, L + CK_SL(3), tr, lc, lq); ldA(xv, L + CK_SL(7), tr, lc, lq);
        ldB(yc, L + CK_SL(5), tc0, lc, lq); ldB(yk, L + CK_SL(6), tc0, lc, lq); ldB(yn, L + CK_SL(10), tc0, lc, lq); ldB(ym, L + CK_SL(11), tc0, lc, lq);
        f32x4m h[2], y0[2]; CK_ZERO(h); CK_ZERO(y0);
        mmr(h, xu, yc); mmr(h, xv, yk); mmr(y0, xu, yn); mmr(y0, xv, ym);
        st_gtr(CH + 1 * 4096, h, tr, tc0, lc, lq);
        st_gtr(CH + 3 * 4096, y0, tr, tc0, lc, lq);
    }
    __syncthreads();
}
__device__ __forceinline__ void chunk_prep_load(Frame& F, int u, unsigned (&inr)[24]) {
    const bf16* o = (const bf16*)(F.ws + WS_OPS) + ((size_t)(u >> 7) * T + (size_t)(u & 127) * 64 + 8 * F.wave) * 384 + opaque_i(F.lane);
#pragma unroll
    for (int s8 = 0; s8 < 8; ++s8)
#pragma unroll
        for (int v = 0; v < 3; ++v) inr[3 * s8 + v] = (unsigned)o[(size_t)s8 * 384 + (2 * v) * 64] | ((unsigned)o[(size_t)s8 * 384 + (2 * v + 1) * 64] << 16);
}
__device__ __forceinline__ void chunk_prep_all(Frame& F) {
    unsigned cur[24], nxt[24];
    int u = F.vcu;
    if (u < 48 * 128) chunk_prep_load(F, u, cur);
    for (; u < 48 * 128; u += F.G) {
        const int un = (u + F.G < 48 * 128) ? u + F.G : u;
        chunk_prep_load(F, un, nxt);
        chunk_prep_unit(F, u >> 7, u & 127, cur);
#pragma unroll
        for (int i = 0; i < 24; ++i) cur[i] = nxt[i];
    }
}
__device__ __forceinline__ void chunk_chain(Frame& F, int unit) {
    LAS unsigned char* L = F.lds + RING_OFF;
    const int bh = unit >> 2, rq = unit & 3;
    const int tid = opaque_i(F.tid), lane = tid & 63, wid = F.wave, lc = lane & 15, lq = lane >> 4;
    const int tc = wid & 3; const bool act = wid < 4;
    const bf16* CHb = (const bf16*)(F.ws + WS_CHK) + (size_t)bh * 128 * (4 * 4096);
    bf16* SS = (bf16*)(F.ws + WS_SST) + (size_t)bh * 128 * 4096 + (size_t)(16 * rq) * 64;
    if (tid < 144) *(LAS v4u*)(L + tid * 16) = (v4u){0u, 0u, 0u, 0u};
    __syncthreads();
#define CC_LOAD(GF, HF, nn) do { const bf16* CH_ = CHb + (size_t)((nn) < 128 ? (nn) : 127) * (4 * 4096); \
        _Pragma("unroll") for (int ks = 0; ks < 2; ++ks) GF[ks] = *(const bf16x8*)(CH_ + 0 * 4096 + (16 * tc + lc) * 64 + 32 * ks + 8 * lq); \
        HF = *(const unsigned long long*)(CH_ + 1 * 4096 + (16 * tc + lc) * 64 + 16 * rq + 4 * lq); } while (0)
#define CC_STEP(GF, HF, nn) do { \
        if (tid < 128) { const v4u sv = *(const LAS v4u*)(L + (tid >> 3) * CK_ST + (tid & 7) * 16); *(v4u*)(SS + (size_t)(nn) * 4096 + (tid >> 3) * 64 + (tid & 7) * 8) = sv; } \
        f32x4m sn; { const unsigned h0 = (unsigned)HF, h1 = (unsigned)(HF >> 32); sn = (f32x4m){bflo(h0), bfhi(h0), bflo(h1), bfhi(h1)}; } \
        _Pragma("unroll") for (int ks = 0; ks < 2; ++ks) { \
            const bf16x8 a = *(const LAS bf16x8*)(L + lc * CK_ST + (32 * ks + 8 * lq) * 2); \
            sn = __builtin_amdgcn_mfma_f32_16x16x32_bf16(a, GF[ks], sn, 0, 0, 0); } \
        CC_LOAD(GF, HF, (nn) + 8); \
        __syncthreads(); \
        if (act) { _Pragma("unroll") for (int r = 0; r < 4; ++r) *(LAS bf16*)(L + (4 * lq + r) * CK_ST + (16 * tc + lc) * 2) = (bf16)f2bf(sn[r]); } \
        __syncthreads(); } while (0)
    bf16x8 g0[2], g1[2], g2[2], g3[2], g4[2], g5[2], g6[2], g7[2]; unsigned long long h0_, h1_, h2_, h3_, h4_, h5_, h6_, h7_;
    CC_LOAD(g0, h0_, 0); CC_LOAD(g1, h1_, 1); CC_LOAD(g2, h2_, 2); CC_LOAD(g3, h3_, 3); CC_LOAD(g4, h4_, 4); CC_LOAD(g5, h5_, 5); CC_LOAD(g6, h6_, 6); CC_LOAD(g7, h7_, 7);
    for (int n = 0; n < 128; n += 8) {
        CC_STEP(g0, h0_, n); CC_STEP(g1, h1_, n + 1); CC_STEP(g2, h2_, n + 2); CC_STEP(g3, h3_, n + 3);
        CC_STEP(g4, h4_, n + 4); CC_STEP(g5, h5_, n + 5); CC_STEP(g6, h6_, n + 6); CC_STEP(g7, h7_, n + 7);
    }
#undef CC_LOAD
#undef CC_STEP
}
__device__ __forceinline__ void chunk_ypost(Frame& F, const Args& A, int layer) {
    const int lane = opaque_i(F.lane), lc = lane & 15, lq = lane >> 4;
    bf16* Y = (bf16*)(F.ws + WS_XN);
    const float* rk = A.in[16] + layer * 384; const float* lg = A.in[17] + layer * 384; const float* lb = A.in[18] + layer * 384;
    const int gw = F.vcu * NWAVES + F.wave, NGW = F.G * NWAVES;
    for (int it = gw; it < 48 * 128 * 4; it += NGW) {
        const int tc = it & 3, n = (it >> 2) & 127, bh = it >> 9, b = bh / BH, h = bh % BH;
        const bf16* CH = (const bf16*)(F.ws + WS_CHK) + ((size_t)bh * 128 + n) * (4 * 4096);
        const bf16* SS = (const bf16*)(F.ws + WS_SST) + ((size_t)bh * 128 + n) * 4096;
        const int tok = n * 64 + 16 * tc + lc; const size_t m = (size_t)b * T + tok;
        bf16x8 rf[2];
#pragma unroll
        for (int ks = 0; ks < 2; ++ks) rf[ks] = *(const bf16x8*)(CH + 2 * 4096 + (16 * tc + lc) * 64 + 32 * ks + 8 * lq);
        f32x4m acc[4];
#pragma unroll
        for (int tr = 0; tr < 4; ++tr) {
            const unsigned long long yf = *(const unsigned long long*)(CH + 3 * 4096 + (16 * tc + lc) * 64 + 16 * tr + 4 * lq);
            const unsigned y0 = (unsigned)yf, y1 = (unsigned)(yf >> 32);
            acc[tr] = (f32x4m){bflo(y0), bfhi(y0), bflo(y1), bfhi(y1)};
#pragma unroll
            for (int ks = 0; ks < 2; ++ks) {
                const bf16x8 a = *(const bf16x8*)(SS + (16 * tr + lc) * 64 + 32 * ks + 8 * lq);
                acc[tr] = __builtin_amdgcn_mfma_f32_16x16x32_bf16(a, rf[ks], acc[tr], 0, 0, 0);
            }
        }
        const bf16* op = (const bf16*)(F.ws + WS_OPS) + ((size_t)bh * T + tok) * 384;
        float bon = 0.f;
#pragma unroll
        for (int i = 0; i < 2; ++i) {
            const v4u ur = *(const v4u*)(op + 16 * lq + 8 * i), uk = *(const v4u*)(op + 128 + 16 * lq + 8 * i);
            const float* rkp = rk + h * 64 + 16 * lq + 8 * i;
            bon += bflo(ur.x) * bflo(uk.x) * rkp[0] + bfhi(ur.x) * bfhi(uk.x) * rkp[1] + bflo(ur.y) * bflo(uk.y) * rkp[2] + bfhi(ur.y) * bfhi(uk.y) * rkp[3]
                 + bflo(ur.z) * bflo(uk.z) * rkp[4] + bfhi(ur.z) * bfhi(uk.z) * rkp[5] + bflo(ur.w) * bflo(uk.w) * rkp[6] + bfhi(ur.w) * bfhi(uk.w) * rkp[7];
        }
        float s1 = 0.f;
#pragma unroll
        for (int tr = 0; tr < 4; ++tr) s1 += (acc[tr][0] + acc[tr][1]) + (acc[tr][2] + acc[tr][3]);
#define RED4(x) do { { const unsigned u_ = __float_as_uint(x); auto r_ = __builtin_amdgcn_permlane16_swap(u_, u_, false, false); const unsigned a_ = r_[0], b_ = r_[1]; x = __uint_as_float(a_) + __uint_as_float(b_); } \
                     { const unsigned u_ = __float_as_uint(x); auto r_ = __builtin_amdgcn_permlane32_swap(u_, u_, false, false); const unsigned a_ = r_[0], b_ = r_[1]; x = __uint_as_float(a_) + __uint_as_float(b_); } } while (0)
        RED4(s1); RED4(bon);
        const float mean = s1 * (1.f / 64.f); float q = 0.f;
#pragma unroll
        for (int tr = 0; tr < 4; ++tr)
#pragma unroll
            for (int r = 0; r < 4; ++r) { acc[tr][r] -= mean; q += acc[tr][r] * acc[tr][r]; }
        RED4(q);
#undef RED4
        const float rstd = 1.f / sqrtf(q * (1.f / 64.f) + GN_EPS);
        const unsigned char* prow = F.ws + WS_PB + m * (PB_LD * 2);
#pragma unroll
        for (int tr = 0; tr < 4; ++tr) {
            const int v0 = 16 * tr + 4 * lq;
            const unsigned long long uv = *(const unsigned long long*)(op + 192 + v0), ug = *(const unsigned long long*)(prow + (1280 + h * 64 + v0) * 2);
            const float vv[4] = {bflo((unsigned)uv), bfhi((unsigned)uv), bflo((unsigned)(uv >> 32)), bfhi((unsigned)(uv >> 32))};
            const float gg[4] = {bflo((unsigned)ug), bfhi((unsigned)ug), bflo((unsigned)(ug >> 32)), bfhi((unsigned)(ug >> 32))};
            const f32x4m lgv = *(const f32x4m*)(lg + h * 64 + v0), lbv = *(const f32x4m*)(lb + h * 64 + v0);
            float o[4];
#pragma unroll
            for (int r = 0; r < 4; ++r) o[r] = silu_f(gg[r]) * (acc[tr][r] * rstd * lgv[r] + lbv[r] + bon * vv[r]);
            *(unsigned long long*)(Y + m * D + 256 + h * 64 + v0) = (unsigned long long)pk2(o[0], o[1]) | ((unsigned long long)pk2(o[2], o[3]) << 32);
        }
    }
}
__device__ __forceinline__ void rwkv_post_simple(Frame& F, const Args& A, int layer) {
    const unsigned char* PBb = F.ws + WS_PB;
    const bf16* OPS = (const bf16*)(F.ws + WS_OPS);
    bf16* Y = (bf16*)(F.ws + WS_XN);
    const float* rk = A.in[16] + layer * 384; const float* lg = A.in[17] + layer * 384; const float* lb = A.in[18] + layer * 384;
    const int sub = F.lane & 7;
    const long ngrp = (long)M * BH;
    for (long gi = ((long)F.vcu * NTHR + F.tid) >> 3; gi < ngrp; gi += ((long)F.G * NTHR) >> 3) {
        const int m = (int)(gi / BH), h = (int)(gi % BH), t = m % T, b = m / T;
        const unsigned char* prow = PBb + (size_t)m * (PB_LD * 2);
        const f32x4 y0 = *(const f32x4*)(prow + (h * 64 + sub * 8) * 4), y1 = *(const f32x4*)(prow + (h * 64 + sub * 8) * 4 + 16);
        float y[8] = {y0.x, y0.y, y0.z, y0.w, y1.x, y1.y, y1.z, y1.w};
        const size_t oidx = ((size_t)(b * BH + h) * T + t) * 384 + sub * 8;
        const v4u ur = *(const v4u*)(OPS + oidx), uk = *(const v4u*)(OPS + oidx + 128), uv = *(const v4u*)(OPS + oidx + 192);
        const v4u ug = *(const v4u*)(prow + (1280 + h * 64 + sub * 8) * 2);
        float r[8] = {bflo(ur.x), bfhi(ur.x), bflo(ur.y), bfhi(ur.y), bflo(ur.z), bfhi(ur.z), bflo(ur.w), bfhi(ur.w)};
        float k[8] = {bflo(uk.x), bfhi(uk.x), bflo(uk.y), bfhi(uk.y), bflo(uk.z), bfhi(uk.z), bflo(uk.w), bfhi(uk.w)};
        float v[8] = {bflo(uv.x), bfhi(uv.x), bflo(uv.y), bfhi(uv.y), bflo(uv.z), bfhi(uv.z), bflo(uv.w), bfhi(uv.w)};
        float g[8] = {bflo(ug.x), bfhi(ug.x), bflo(ug.y), bfhi(ug.y), bflo(ug.z), bfhi(ug.z), bflo(ug.w), bfhi(ug.w)};
        float s = 0.f, bon = 0.f;
#pragma unroll
        for (int i = 0; i < 8; ++i) { s += y[i]; bon += r[i] * k[i] * rk[h * 64 + sub * 8 + i]; }
        s += __shfl_xor(s, 1); s += __shfl_xor(s, 2); s += __shfl_xor(s, 4);
        bon += __shfl_xor(bon, 1); bon += __shfl_xor(bon, 2); bon += __shfl_xor(bon, 4);
        const float mean = s * (1.f / 64.f); float q = 0.f;
#pragma unroll
        for (int i = 0; i < 8; ++i) { y[i] -= mean; q += y[i] * y[i]; }
        q += __shfl_xor(q, 1); q += __shfl_xor(q, 2); q += __shfl_xor(q, 4);
        const float rstd = 1.f / sqrtf(q * (1.f / 64.f) + GN_EPS);
        float o[8];
#pragma unroll
        for (int i = 0; i < 8; ++i) { const int c = h * 64 + sub * 8 + i; o[i] = silu_f(g[i]) * (y[i] * rstd * lg[c] + lb[c] + bon * v[i]); }
        v4u w; w.x = pk2(o[0], o[1]); w.y = pk2(o[2], o[3]); w.z = pk2(o[4], o[5]); w.w = pk2(o[6], o[7]);
        *(v4u*)(Y + (size_t)m * D + 256 + h * 64 + sub * 8) = w;
    }
}


#ifndef USE_CHUNKED
#define USE_CHUNKED 1
#endif
#ifndef REP_PREP
#define REP_PREP 1
#endif
#ifndef REP_CHAIN
#define REP_CHAIN 1
#endif
#define IN(k) (lo <= (k) && (k) < hi)
#define SEAM(k) do { if (IN(k) && IN((k) + 1)) xcd_barrier(bar); } while (0)
template <int layer> __device__ __forceinline__ void layer_phases(Frame& F, const Args& args, const int lo, const int hi, const XcdBarrier& bar) {
    constexpr int pb = 1 + 6 * layer;
    const float* mod = (const float*)(F.ws + WS_CTL) + CW_MOD + (size_t)layer * 8 * 3072;
    if (IN(pb + 0)) { for (int rep = 0; rep < REP_XN; ++rep) p1a_xn(F, args, layer); } SEAM(pb + 0);
    if (IN(pb + 1)) {
        pg8::Gemm g{(const pg8::bf16_t*)(F.ws + WS_XN), (const pg8::bf16_t*)(F.ws + WS_WIN) + (size_t)layer * NPAD * D, M, NPAD, D};
        pg8::StaticOrder S; S.init(M, NPAD, F.G, (int)blockIdx.x);
        pg8::EpiProj E{(pg8::bf16_t*)(F.ws + WS_PA), (pg8::bf16_t*)(F.ws + WS_PB), (pg8::bf16_t*)(F.ws + WS_PC), QSCALE};
        for (int rep = 0; rep < REP_GEMM1; ++rep) pg8::gemm_phase<pg8::EpiProj, pg8::StaticOrder, true, true>(F.lds + RING_OFF, g, S, E);
    } SEAM(pb + 1);
    if (IN(pb + 2)) {
        for (int rep = 0; rep < (layer ? 1 : REP_PRE); ++rep) for (int tile = F.vcu; tile < M / 64; tile += F.G) rwkv_pre_tile2<layer>(F, args, tile);
        for (int rep = 0; rep < REP_SGU; ++rep) for (int nb = F.vcu; nb < M / 128; nb += F.G) sgu_unit_mfma(F, args, layer, nb);
        __syncthreads();
        for (int rep = 0; rep < REP_ATTN; ++rep) for (int u = F.vcu; u < BATCH * CH * 32; u += F.G) attn_unit_mfma(F, args, layer, u);
    } SEAM(pb + 2);
    if (IN(pb + 3)) { for (int rep = 0; rep < REP_SCAN; ++rep) {
#if USE_CHUNKED
            for (int rp = 0; rp < REP_PREP; ++rp) chunk_prep_all(F);
            xcd_barrier(bar);
            for (int rp = 0; rp < REP_CHAIN; ++rp) if (F.vcu < 192) chunk_chain(F, F.vcu);
#else
            if (F.vcu < 192) rwkv_scan_lds(F, F.vcu);
#endif
        } } SEAM(pb + 3);
    if (IN(pb + 4)) { for (int rep = 0; rep < REP_POST; ++rep) {
#if USE_CHUNKED
        chunk_ypost(F, args, layer);
#else
        rwkv_post_simple(F, args, layer);
#endif
    } } SEAM(pb + 4);
    if (IN(pb + 5)) {
        pg8::Gemm g{(const pg8::bf16_t*)(F.ws + WS_XN), (const pg8::bf16_t*)(F.ws + WS_WOUT) + (size_t)layer * D * D, M, D, D};
        pg8::StaticOrder S; S.init(M, D, F.G, (int)blockIdx.x);
        pg8::EpiRes E{layer ? (const float*)F.out : args.in[0], F.out, mod + 2048, layer, (const float*)(F.ws + WS_ROWSTAT), args.in[24], args.in[25], DN_ALPHA};
        for (int rep = 0; rep < (layer ? 1 : REP_GEMM2); ++rep) pg8::gemm_phase<pg8::EpiRes, pg8::StaticOrder, true, true>(F.lds + RING_OFF, g, S, E);
    } SEAM(pb + 5);
}
__global__ void __launch_bounds__(NTHR, 2) fwd_kernel(Args args) {
    extern __shared__ __attribute__((aligned(16))) unsigned char lds[];
    Frame F;
    F.lds = (LAS unsigned char*)lds;
    F.MISC = (volatile LAS unsigned*)(F.lds + MISC_OFF);
    F.tid = threadIdx.x; F.lane = F.tid & 63; F.wave = __builtin_amdgcn_readfirstlane(F.tid >> 6);
    F.G = gridDim.x; { const int bx = blockIdx.x; F.vcu = (F.G % 8 == 0) ? (bx % 8) * (F.G / 8) + bx / 8 : bx; }
    F.out = args.out; F.ws = args.ws;
    F.ctl = (gu32*)(args.ws + WS_CTL);
    for (int u = F.tid; u < (LDS_BYTES - LDSCTL_OFF) / 4; u += NTHR) ((LAS unsigned*)(F.lds + LDSCTL_OFF))[u] = 0u;
    __syncthreads();
    const int lo = args.ph_lo, hi = args.ph_hi;
    XcdBarrier bar; bar.bar = (unsigned*)(F.ctl + CW_BAR); bar.x = 0; bar.st = nullptr;
    if (hi - lo > 1) bar = xcd_barrier_post((unsigned*)(F.ctl + CW_BAR), F.MISC + 8);

    if (IN(0)) { p0_prologue(F, args); } SEAM(0);
    layer_phases<0>(F, args, lo, hi, bar);
    layer_phases<1>(F, args, lo, hi, bar);
    if (IN(13)) { p4_final(F, args); }
#undef IN
#undef SEAM
}

extern "C" void kernel_launch(void* const* d_in, const int* in_sizes, int n_in, void* d_out, int out_size, void* d_ws, size_t ws_size, hipStream_t stream) {
    static int grid = 0;
    if (grid == 0) {
        if (n_in != 26 || in_sizes[0] != M * D || out_size != M * D || ws_size < WS_END) { fprintf(stderr, "kernel_launch: unexpected shapes: n_in %d in0 %d out %d ws %zu (need %zu)\n", n_in, n_in > 0 ? in_sizes[0] : -1, out_size, ws_size, (size_t)WS_END); grid = -1; return; }
        int dev = 0, cus = 0;
        if (hipGetDevice(&dev) != hipSuccess || hipDeviceGetAttribute(&cus, hipDeviceAttributeMultiprocessorCount, dev) != hipSuccess) { grid = -1; return; }
        if (hipFuncSetAttribute((const void*)fwd_kernel, hipFuncAttributeMaxDynamicSharedMemorySize, LDS_BYTES) != hipSuccess) { fprintf(stderr, "kernel_launch: hipFuncSetAttribute failed\n"); grid = -1; return; }
        int per_cu = 0;
        if (hipOccupancyMaxActiveBlocksPerMultiprocessor(&per_cu, (const void*)fwd_kernel, NTHR, LDS_BYTES) != hipSuccess || per_cu < 1) fprintf(stderr, "kernel_launch: occupancy query says %d\n", per_cu);
        (void)hipGetLastError();
        grid = cus;
        if (grid != 256) fprintf(stderr, "kernel_launch: grid %d != 256\n", grid);
    }
    if (grid < 0) return;
    if (hipMemsetAsync((char*)d_ws + WS_CTL, 0, CTL_ZERO_BYTES, stream) != hipSuccess) return;
    Args a{};
    for (int i = 0; i < 26; ++i) a.in[i] = (const float*)d_in[i];
    a.out = (float*)d_out; a.ws = (unsigned char*)d_ws;
    if (MK_N_LAUNCHES == 1) {
        a.ph_lo = 0; a.ph_hi = 14; a.li = 0;
        hipLaunchKernelGGL(fwd_kernel, dim3(grid), dim3(NTHR), LDS_BYTES, stream, a);
    } else {
        for (int p = 0; p < 14; ++p) { a.ph_lo = p; a.ph_hi = p + 1; a.li = p;
            hipLaunchKernelGGL(fwd_kernel, dim3(grid), dim3(NTHR), LDS_BYTES, stream, a); }
    }
}
```

```cpp
#include <hip/hip_runtime.h>
#include <cstdio>
#include <cstdint>
#include <cmath>
#ifndef MK_N_LAUNCHES
#define MK_N_LAUNCHES 1
#endif
namespace pg8 {
#define PG8_LAS __attribute__((address_space(3)))
typedef unsigned short bf16_t;
typedef short bf16x8 __attribute__((ext_vector_type(8)));
typedef float f32x4 __attribute__((ext_vector_type(4)));
typedef unsigned u32x4 __attribute__((ext_vector_type(4)));
constexpr int BM = 256, BK = 64, HALF = 128, HTB = HALF * BK * 2  , STAGE_BYTES = 8 * HTB, NXCD = 8, WGM = 8;

__host__ __device__ __forceinline__ int lds_byte(int r, int c) { const int st = (r >> 4) * 2 + (c >> 5), rr = r & 15, cc = c & 31, ob = rr * 64 + cc * 2; return st * 1024 + (ob ^ (((ob >> 9) & 1) << 5)); }
__host__ __device__ __forceinline__ void stage_rc(int b, int& R, int& C) { const int st = b / 1024, sb = b % 1024, swz = sb ^ (((sb >> 9) & 1) << 5); R = (st >> 1) * 16 + swz / 64; C = (st & 1) * 32 + (swz % 64) / 2; }
__host__ __device__ __forceinline__ int perm32(int rho) { const int n = rho >> 4, i = rho & 15; return 8 * (i >> 2) + 4 * n + (i & 3); }

struct Unit { int pm, pn; };
struct Gemm { const bf16_t* A; const bf16_t* Bt; int M, N, K; };

struct StaticOrder {
    int nM, nN, nwg, G, c;
    __host__ __device__ void init(int M, int N, int G_, int c_) { nM = M / BM; nN = N / BM; nwg = nM * nN; G = G_; c = c_; }
    __host__ __device__ bool next(int i, Unit& u) const {
        const long L = (long)i * G + c; if (L >= nwg) return false;
        int wgid = (int)L; { const int q = nwg / NXCD, r = nwg % NXCD, xcd = wgid % NXCD, off = wgid / NXCD; wgid = (xcd < r ? xcd * (q + 1) : r * (q + 1) + (xcd - r) * q) + off; }
        const int nig = WGM * nN, gid = wgid / nig, fm = gid * WGM, gsz = (nM - fm) < WGM ? (nM - fm) : WGM;
        u.pm = fm + ((wgid % nig) % gsz); u.pn = (wgid % nig) / gsz; return true;
    }
    __device__ __forceinline__ void a_ready(const Unit&) const {}
    __device__ __forceinline__ void done(const Unit&) const {}
};

__device__ __forceinline__ unsigned cvt_pk_bf16(float lo, float hi) { unsigned r; asm volatile("v_cvt_pk_bf16_f32 %0, %1, %2" : "=v"(r) : "v"(lo), "v"(hi)); return r; }
typedef float f32x2 __attribute__((ext_vector_type(2)));
typedef float f32x2 __attribute__((ext_vector_type(2)));
struct EpiProj {
    static constexpr bool PERM = true, AFTER_DRAIN = false;
    bf16_t* pa; bf16_t* pb; bf16_t* pc; float qscale;
    __device__ __forceinline__ void operator()(const f32x4 (&acc)[2][2][4][2], const Unit& u, int wr, int wc, int fr, int fq) const {
        const int row0 = u.pm * BM + wr * 64 + fr;
        bf16_t* base; int ldc, colt; float sc0 = 1.f, sc1 = 1.f;
        if (u.pn < 3) { base = pa; ldc = 768; colt = u.pn * 256; }
        else if (u.pn < 10) { base = pb; ldc = 1664; colt = (u.pn - 3) * 256; }
        else { base = pc; ldc = 1536; colt = (u.pn - 10) * 256; if (u.pn == 10) { sc0 = qscale; sc1 = qscale; } else if (u.pn == 11) { sc0 = qscale; } }
        const bool skip1 = (u.pn == 9);
        const int col0 = colt + wc * 32 + 8 * fq;
#pragma unroll
        for (int ai = 0; ai < 2; ++ai)
#pragma unroll
            for (int m = 0; m < 4; ++m) { bf16_t* rowp = base + (size_t)(row0 + ai * HALF + m * 16) * ldc + col0;
#pragma unroll
                for (int bj = 0; bj < 2; ++bj) { if (bj == 1 && skip1) continue;
                    const float sc = bj ? sc1 : sc0;
                    const f32x4 v0 = acc[ai][bj][m][0] * sc, v1 = acc[ai][bj][m][1] * sc;
                    u32x4 w; w.x = cvt_pk_bf16(v0[0], v0[1]); w.y = cvt_pk_bf16(v0[2], v0[3]); w.z = cvt_pk_bf16(v1[0], v1[1]); w.w = cvt_pk_bf16(v1[2], v1[3]);
                    *(u32x4*)(rowp + bj * HALF) = w; } }
    }
};
struct EpiRes {
    static constexpr bool PERM = false, AFTER_DRAIN = false;
    const float* xres; float* out; const float* gate1;   int layer; const float* rowstat; const float* lng; const float* lnb; float alpha;
    __device__ __forceinline__ void operator()(const f32x4 (&acc)[2][2][4][2], const Unit& u, int wr, int wc, int fr, int fq) const {
        const int b = u.pm >> 5;
        const float* g = gate1 + (size_t)b * 3072;
        const int col0 = u.pn * BM + wc * 32 + 4 * fq;
#pragma unroll
        for (int bj = 0; bj < 2; ++bj)
#pragma unroll
            for (int n = 0; n < 2; ++n) {
                const int c = col0 + bj * HALF + n * 16;
                const f32x4 gv = *(const f32x4*)(g + c) + 1.0f;
                f32x4 lg = (f32x4){1.f, 1.f, 1.f, 1.f}, lb = (f32x4){0.f, 0.f, 0.f, 0.f};
                if (layer) { lg = *(const f32x4*)(lng + c); lb = *(const f32x4*)(lnb + c); }
#pragma unroll
                for (int ai = 0; ai < 2; ++ai)
#pragma unroll
                    for (int m = 0; m < 4; ++m) {
                        const int row = u.pm * BM + ai * HALF + wr * 64 + m * 16 + fr;
                        const size_t off = (size_t)row * 1024 + c;
                        f32x4 xr = *(const f32x4*)(xres + off);
                        if (layer) { const f32x2 st = *(const f32x2*)(rowstat + 2 * (size_t)row); xr = (xr - st.x) * st.y * lg + lb; }
                        const f32x4 o = xr * alpha + gv * acc[ai][bj][m][n];
                        *(f32x4*)(out + off) = o;
                    }
            }
    }
};
template <class Epi, class Sched, bool ALIGN_EPI = false, bool SP2 = false>
__device__ __forceinline__ void gemm_phase(PG8_LAS unsigned char* lds, const Gemm g, const Sched& S, const Epi& E) {
    const int tid = threadIdx.x, wid = __builtin_amdgcn_readfirstlane(tid >> 6), lane = tid & 63, wr = wid >> 2, wc = wid & 3, fr = lane & 15, fq = lane >> 4;
    const int K = g.K, nt = K / BK;
    unsigned voffA[2], voffB[2];
#pragma unroll
    for (int i = 0; i < 2; ++i) { int R, C; stage_rc(tid * 16 + i * 8192, R, C); const int Rb = Epi::PERM ? ((R & ~31) + perm32(R & 31)) : R;
        voffA[i] = (unsigned)(R * K + C) * 2u; voffB[i] = (unsigned)(Rb * K + C) * 2u; }
    const size_t kstep = (size_t)(BK * 2);
    const size_t hstep = (size_t)HALF * K * 2;
    const size_t tstep = 2 * hstep;
    const unsigned ldsw = (unsigned)wid * 1024u;
    const int aoff = lds_byte(wr * 64 + fr, fq * 8), boff = lds_byte(wc * 32 + fr, fq * 8);
#define PG8_SA(b, h) (((b) * 2 + (h)) * HTB)
#define PG8_SB(b, h) ((4 + (b) * 2 + (h)) * HTB)
#define PG8_STAGE(bufoff, gbase, voff) do { _Pragma("unroll") for (int _i = 0; _i < 2; ++_i) \
        __builtin_amdgcn_global_load_lds((const unsigned*)((const char*)(gbase) + (voff)[_i]), (PG8_LAS unsigned*)(lds + (bufoff) + ldsw + _i * 8192), 16, 0, 0); } while (0)
#define PG8_LDA(dst, b, h) do { _Pragma("unroll") for (int m = 0; m < 4; ++m) _Pragma("unroll") for (int k = 0; k < 2; ++k) dst[m][k] = *(const PG8_LAS bf16x8*)(lds + PG8_SA(b, h) + aoff + m * 2048 + k * 1024); } while (0)
#define PG8_LDB(dst, b, h) do { _Pragma("unroll") for (int n = 0; n < 2; ++n) _Pragma("unroll") for (int k = 0; k < 2; ++k) dst[n][k] = *(const PG8_LAS bf16x8*)(lds + PG8_SB(b, h) + boff + n * 2048 + k * 1024); } while (0)
#define PG8_MMA(ai, bj, At, Bt) do { __builtin_amdgcn_s_setprio(1); _Pragma("unroll") for (int m = 0; m < 4; ++m) _Pragma("unroll") for (int n = 0; n < 2; ++n) _Pragma("unroll") for (int k = 0; k < 2; ++k) \
        acc[ai][bj][m][n] = __builtin_amdgcn_mfma_f32_16x16x32_bf16(Bt[n][k], At[m][k], acc[ai][bj][m][n], 0, 0, 0); __builtin_amdgcn_s_setprio(0); } while (0)
#define PG8_WAIT_V(n) asm volatile("s_waitcnt vmcnt(" #n ")" ::: "memory")
#define PG8_WAIT_L(n) asm volatile("s_waitcnt lgkmcnt(" #n ")" ::: "memory")
#define PG8_BAR __builtin_amdgcn_s_barrier()
#define PG8_SCHED __builtin_amdgcn_sched_barrier(0)
    Unit cur, nxt; int ui = 0;
    if (!S.next(0, cur)) return;
    f32x4 acc[2][2][4][2];
#pragma unroll
    for (int a = 0; a < 2; ++a)
#pragma unroll
        for (int b = 0; b < 2; ++b)
#pragma unroll
            for (int m = 0; m < 4; ++m)
#pragma unroll
                for (int n = 0; n < 2; ++n) acc[a][b][m][n] = (f32x4){0.f, 0.f, 0.f, 0.f};
    bf16x8 At[4][2], B0[2][2], B1[2][2];
    const char* cA = (const char*)g.A + (size_t)cur.pm * tstep; const char* cB = (const char*)g.Bt + (size_t)cur.pn * tstep;
    S.a_ready(cur);
    if constexpr (SP2) {
        PG8_STAGE(PG8_SB(0, 0), cB, voffB); PG8_STAGE(PG8_SB(0, 1), cB + hstep, voffB); PG8_STAGE(PG8_SA(0, 0), cA, voffA); PG8_STAGE(PG8_SA(0, 1), cA + hstep, voffA);
        if (wr == 1) PG8_BAR;
        PG8_WAIT_V(2); PG8_BAR;
        PG8_STAGE(PG8_SB(1, 0), cB + kstep, voffB); PG8_STAGE(PG8_SA(1, 0), cA + kstep, voffA); PG8_STAGE(PG8_SB(1, 1), cB + hstep + kstep, voffB);
        PG8_WAIT_V(6); PG8_BAR;
    } else {
        PG8_STAGE(PG8_SB(0, 0), cB, voffB); PG8_STAGE(PG8_SA(0, 0), cA, voffA); PG8_STAGE(PG8_SB(0, 1), cB + hstep, voffB); PG8_STAGE(PG8_SA(0, 1), cA + hstep, voffA);
        if (wr == 1) PG8_BAR;
        PG8_WAIT_V(4); PG8_BAR;
        PG8_STAGE(PG8_SB(1, 0), cB + kstep, voffB); PG8_STAGE(PG8_SA(1, 0), cA + kstep, voffA); PG8_STAGE(PG8_SB(1, 1), cB + hstep + kstep, voffB);
        PG8_WAIT_V(6); PG8_BAR;
    }
    for (;;) {
        const bool has_next = S.next(ui + 1, nxt);
        const char* nA = has_next ? (const char*)g.A + (size_t)nxt.pm * tstep : cA; const char* nB = has_next ? (const char*)g.Bt + (size_t)nxt.pn * tstep : cB;
        for (int t = 0; t < nt; t += 2) {
            const bool last = (t == nt - 2);
            const char* a1 = cA + (size_t)(t + 1) * kstep;
            const char* a2 = last ? nA : cA + (size_t)(t + 2) * kstep; const char* b2 = last ? nB : cB + (size_t)(t + 2) * kstep;
            const char* a3 = a2 + kstep; const char* b3 = b2 + kstep;
            if (last && has_next) S.a_ready(nxt);
            if constexpr (SP2) {
            PG8_LDB(B0, 0, 0); PG8_LDB(B1, 0, 1); PG8_SCHED; PG8_LDA(At, 0, 0); PG8_STAGE(PG8_SA(1, 1), a1 + hstep, voffA);
            PG8_WAIT_V(8); PG8_WAIT_L(0); PG8_BAR; PG8_MMA(0, 0, At, B0); PG8_MMA(0, 1, At, B1); PG8_BAR; PG8_SCHED;
            PG8_LDA(At, 0, 1); PG8_STAGE(PG8_SB(0, 0), b2, voffB); PG8_STAGE(PG8_SB(0, 1), b2 + hstep, voffB); PG8_STAGE(PG8_SA(0, 0), a2, voffA);
            PG8_WAIT_V(8); PG8_WAIT_L(0); PG8_BAR; PG8_MMA(1, 0, At, B0); PG8_MMA(1, 1, At, B1); PG8_BAR; PG8_SCHED;
            PG8_LDB(B0, 1, 0); PG8_LDB(B1, 1, 1); PG8_SCHED; PG8_LDA(At, 1, 0); PG8_STAGE(PG8_SA(0, 1), a2 + hstep, voffA);
            PG8_WAIT_V(8); PG8_WAIT_L(0); PG8_BAR; PG8_MMA(0, 0, At, B0); PG8_MMA(0, 1, At, B1); PG8_BAR; PG8_SCHED;
            PG8_LDA(At, 1, 1); PG8_STAGE(PG8_SB(1, 0), b3, voffB); PG8_STAGE(PG8_SB(1, 1), b3 + hstep, voffB); PG8_STAGE(PG8_SA(1, 0), a3, voffA);
            PG8_WAIT_V(8); PG8_WAIT_L(0); PG8_BAR; PG8_MMA(1, 0, At, B0); PG8_MMA(1, 1, At, B1); PG8_BAR; PG8_SCHED;
            } else {
            PG8_LDB(B0, 0, 0); PG8_SCHED; PG8_LDA(At, 0, 0); PG8_STAGE(PG8_SA(1, 1), a1 + hstep, voffA);
            PG8_WAIT_L(8); PG8_BAR; PG8_WAIT_L(0); PG8_MMA(0, 0, At, B0); PG8_BAR; PG8_SCHED;
            PG8_LDB(B1, 0, 1); PG8_STAGE(PG8_SB(0, 0), b2, voffB);
            PG8_BAR; PG8_WAIT_L(0); PG8_MMA(0, 1, At, B1); PG8_BAR;
            PG8_LDA(At, 0, 1); PG8_STAGE(PG8_SA(0, 0), a2, voffA);
            PG8_BAR; PG8_WAIT_L(0); PG8_MMA(1, 0, At, B0); PG8_BAR; PG8_SCHED;
            PG8_STAGE(PG8_SB(0, 1), b2 + hstep, voffB);
            PG8_WAIT_V(6); PG8_BAR; PG8_MMA(1, 1, At, B1); PG8_BAR;
            PG8_LDB(B0, 1, 0); PG8_SCHED; PG8_LDA(At, 1, 0); PG8_STAGE(PG8_SA(0, 1), a2 + hstep, voffA);
            PG8_WAIT_L(8); PG8_BAR; PG8_WAIT_L(0); PG8_MMA(0, 0, At, B0); PG8_BAR; PG8_SCHED;
            PG8_LDB(B1, 1, 1); PG8_STAGE(PG8_SB(1, 0), b3, voffB);
            PG8_BAR; PG8_WAIT_L(0); PG8_MMA(0, 1, At, B1); PG8_BAR;
            PG8_LDA(At, 1, 1); PG8_STAGE(PG8_SA(1, 0), a3, voffA);
            PG8_BAR; PG8_WAIT_L(0); PG8_MMA(1, 0, At, B0); PG8_BAR; PG8_SCHED;
            PG8_STAGE(PG8_SB(1, 1), b3 + hstep, voffB);
            PG8_WAIT_V(6); PG8_BAR; PG8_MMA(1, 1, At, B1); PG8_BAR;
            }
        }
        if constexpr (ALIGN_EPI) { if (wr == 0) PG8_BAR; }
        if constexpr (!Epi::AFTER_DRAIN) { E(acc, cur, wr, wc, fr, fq); S.done(cur); }
        if (!has_next) break;
#pragma unroll
        for (int a = 0; a < 2; ++a)
#pragma unroll
            for (int b = 0; b < 2; ++b)
#pragma unroll
                for (int m = 0; m < 4; ++m)
#pragma unroll
                    for (int n = 0; n < 2; ++n) acc[a][b][m][n] = (f32x4){0.f, 0.f, 0.f, 0.f};
        cur = nxt; cA = nA; cB = nB; ++ui;
        if constexpr (ALIGN_EPI) { if (wr == 1) PG8_BAR; }
    }
    PG8_WAIT_V(0);
    if constexpr (!ALIGN_EPI) { if (wr == 0) PG8_BAR; }
    PG8_BAR;
    if constexpr (Epi::AFTER_DRAIN) { E.fused(acc, cur, wr, wc, fr, fq, lds, wid, lane); S.done(cur); }
#undef PG8_SA
#undef PG8_SB
#undef PG8_STAGE
#undef PG8_LDA
#undef PG8_LDB
#undef PG8_MMA
#undef PG8_WAIT_V
#undef PG8_WAIT_L
#undef PG8_BAR
#undef PG8_SCHED
}
}
#define GAS __attribute__((address_space(1)))
#define LAS __attribute__((address_space(3)))
typedef unsigned short bf16;
typedef unsigned v4u __attribute__((ext_vector_type(4)));
typedef float f32x4 __attribute__((ext_vector_type(4)));
typedef short bf16x8 __attribute__((ext_vector_type(8)));
typedef GAS unsigned gu32;
typedef GAS unsigned long long gu64;
#define RLX_AGENT __ATOMIC_RELAXED, __HIP_MEMORY_SCOPE_AGENT
#define LDS_WAIT() asm volatile("s_waitcnt lgkmcnt(0)" ::: "memory")
#define VM_WAIT() asm volatile("s_waitcnt vmcnt(0)" ::: "memory")
__device__ __forceinline__ unsigned long long rt() { return __builtin_amdgcn_s_memrealtime(); }
typedef float f32x2c __attribute__((ext_vector_type(2))); typedef __bf16 bf16x2c __attribute__((ext_vector_type(2)));
__device__ __forceinline__ unsigned pk2(float lo, float hi) { f32x2c v = {lo, hi}; bf16x2c b = __builtin_convertvector(v, bf16x2c); return __builtin_bit_cast(unsigned, b); }
__device__ __forceinline__ unsigned f2bf(float f) { return pk2(f, 0.f) & 0xffffu; }

#define XB_TMO      128
#define XB_XCNT(j)  (256  + 64 * (j))
#define XB_XSUB(j)  (1280 + 64 * (j))
#define XB_XGEN(j)  (2304 + 64 * (j))
#define XB_TOP      3328
#define XB_TOPGEN   3392
#define XCD_BAR_WORDS 3456
#define XB_SPIN_CAP (1u << 18)

__device__ __forceinline__ unsigned xb_ld(unsigned* p)              { return __hip_atomic_load(p, __ATOMIC_RELAXED, __HIP_MEMORY_SCOPE_AGENT); }
__device__ __forceinline__ unsigned xb_add(unsigned* p, unsigned v) { return __hip_atomic_fetch_add(p, v, __ATOMIC_RELAXED, __HIP_MEMORY_SCOPE_AGENT); }
__device__ __forceinline__ unsigned xb_xcc_id() { return (unsigned)__builtin_amdgcn_s_getreg((3 << 11) | 20) & 0xFu; }
#define XB_SPIN(cond, bar) do { unsigned _sp = 0; while (cond) { __builtin_amdgcn_s_sleep(1); \
    if ((++_sp & 255u) == 0u) { if (xb_ld(&(bar)[XB_TMO])) break; if (_sp > XB_SPIN_CAP) { atomicAdd(&(bar)[XB_TMO], 1u); break; } } } } while (0)

struct XcdBarrier {
    unsigned* bar; unsigned x;
    volatile LAS unsigned* st;
};

__device__ __forceinline__ XcdBarrier xcd_barrier_post(unsigned* bar, volatile LAS unsigned* st) {
    XcdBarrier b; b.bar = bar; b.x = xb_xcc_id(); b.st = st;
    if (threadIdx.x == 0) (void)xb_add(&bar[XB_XCNT(b.x)], 1u);
    return b;
}
__device__ __forceinline__ void xcd_barrier_complete(unsigned* bar, unsigned x, unsigned& nloc, unsigned& nx) {
    const unsigned G = gridDim.x * gridDim.y * gridDim.z;
    unsigned sum, cnt, mine, sp = 0u;
    for (;;) {
        sum = 0u; cnt = 0u; mine = 0u;
#pragma unroll
        for (unsigned j = 0; j < 16; ++j) { const unsigned c = xb_ld(&bar[XB_XCNT(j)]); sum += c; cnt += (c > 0u) ? 1u : 0u; mine = (j == x) ? c : mine; }
        if (sum == G) break;
        __builtin_amdgcn_s_sleep(1);
        if ((++sp & 255u) == 0u) { if (xb_ld(&bar[XB_TMO])) break; if (sp > XB_SPIN_CAP) { atomicAdd(&bar[XB_TMO], 1u); break; } }
    }
    nloc = mine > 0u ? mine : 1u; nx = cnt > 0u ? cnt : 1u;
}

__device__ __forceinline__ void xcd_barrier(const XcdBarrier& b) {
    asm volatile("s_waitcnt vmcnt(0)" ::: "memory");
    __syncthreads();
    if (threadIdx.x == 0) {
        unsigned* bar = b.bar;
        __builtin_amdgcn_s_waitcnt(0);
        unsigned nloc = b.st[0], nx = b.st[1];
        if (nloc == 0u) { xcd_barrier_complete(bar, b.x, nloc, nx); b.st[0] = nloc; b.st[1] = nx; }
        const unsigned old = xb_add(&bar[XB_XSUB(b.x)], 1u);
        const unsigned gen = old / nloc;
        if (old + 1u == (gen + 1u) * nloc) {
            __builtin_amdgcn_fence(__ATOMIC_RELEASE, "agent");
            asm volatile("s_waitcnt vmcnt(0)" ::: "memory");
            const unsigned og = xb_add(&bar[XB_TOP], 1u);
            const unsigned tg = og / nx;
            if (og + 1u == (tg + 1u) * nx) xb_add(&bar[XB_TOPGEN], 1u);
            else XB_SPIN(xb_ld(&bar[XB_TOPGEN]) == tg, bar);
            __builtin_amdgcn_fence(__ATOMIC_ACQUIRE, "agent");
            xb_add(&bar[XB_XGEN(b.x)], 1u);
            asm volatile("s_waitcnt vmcnt(0)" ::: "memory");
        } else {
            XB_SPIN(xb_ld(&bar[XB_XGEN(b.x)]) == gen, bar);
            __builtin_amdgcn_fence(__ATOMIC_ACQUIRE, "agent");
            asm volatile("s_waitcnt vmcnt(0)" ::: "memory");
        }
    }
    __syncthreads();
}

constexpr int NWAVES = 8, NTHR = 512;
constexpr int BATCH = 8, T = 8192, D = 1024, M = BATCH * T, DEPTH = 2;
constexpr int NPROJ = 3968, NPAD = 4096;
constexpr int HD = 64, BH = 6, CH = 6;
constexpr int PA_LD = 768, PB_LD = 1664, PC_LD = 1536;
constexpr int BSHIFT = 1280;
constexpr float LN_EPS = 1e-5f, GN_EPS = 64e-5f;
constexpr float DN_ALPHA = 1.4142135623730951f;
constexpr float LOG2E = 1.4426950408889634f;
constexpr float QSCALE = 0.125f * LOG2E;

#ifndef MK_N_LAUNCHES
#define MK_N_LAUNCHES 1
#endif
constexpr int N_PHASES = 16;

#ifndef REP_S0
#define REP_S0 1
#endif
#ifndef REP_S2
#define REP_S2 1
#endif
#ifndef REP_XN
#define REP_XN 1
#endif
#ifndef REP_GEMM1
#define REP_GEMM1 1
#endif
#ifndef REP_PRE
#define REP_PRE 1
#endif
#ifndef REP_SGU
#define REP_SGU 1
#endif
#ifndef REP_ATTN
#define REP_ATTN 1
#endif
#ifndef REP_SCAN
#define REP_SCAN 1
#endif
#ifndef REP_POST
#define REP_POST 1
#endif
#ifndef REP_GEMM2
#define REP_GEMM2 1
#endif
constexpr size_t MiB = 1u << 20;
constexpr size_t WS_CTL = 0, CTL_ZERO_BYTES = 1 * MiB;
constexpr size_t WS_WIN = 2 * MiB;
constexpr size_t WS_WOUT = 18 * MiB;
constexpr size_t WS_LORA = 22 * MiB;
constexpr int LO_W2T = 0, LO_A2T = 2 * 384 * 64, LO_V1T = 4 * 384 * 64, LO_V2T = LO_V1T + 32 * 384;
constexpr size_t WS_WSB = 22 * MiB + 512 * 1024;
constexpr size_t WS_ROWSTAT = 23 * MiB;
constexpr size_t WS_XN = 32 * MiB;
constexpr size_t WS_PA = 160 * MiB;
constexpr size_t WS_PC = 256 * MiB;
constexpr size_t WS_PB = 448 * MiB;
constexpr size_t WS_OPS = 656 * MiB;
constexpr size_t WS_CHK = 656 * MiB;
constexpr size_t WS_BV = 848 * MiB;
constexpr size_t WS_VF = 896 * MiB;
constexpr size_t WS_SST = 944 * MiB;
constexpr size_t WS_END = 992 * MiB;
constexpr int CW_BAR = 4096;
constexpr int CW_MOD = 16384;
static_assert((CW_MOD + 49152) * 4 <= (int)CTL_ZERO_BYTES, "ctl region");

constexpr int RING_OFF = 0, RING_BYTES = 159232;
constexpr int LDSCTL_OFF = RING_BYTES, MISC_OFF = LDSCTL_OFF + 320;
constexpr int LDS_BYTES = 159744;

struct Frame {
    LAS unsigned char* lds;
    volatile LAS unsigned* MISC;
    gu32* ctl;
    int tid, lane, wave, vcu, G;
    float* out; unsigned char* ws;
};
struct Args { const float* in[26]; float* out; unsigned char* ws; int ph_lo, ph_hi, li, pad; };
#define INP(k) (A.in[k])
__device__ __forceinline__ float bf2f(unsigned short h) { return __builtin_bit_cast(float, (unsigned)h << 16); }
__device__ __forceinline__ float bflo(unsigned u) { return __builtin_bit_cast(float, u << 16); }
__device__ __forceinline__ float bfhi(unsigned u) { return __builtin_bit_cast(float, u & 0xffff0000u); }
__device__ __forceinline__ float silu_f(float x) { return x * __builtin_amdgcn_rcpf(1.0f + __expf(-x)); }
__device__ __forceinline__ float sigmoid_f(float x) { return __builtin_amdgcn_rcpf(1.0f + __expf(-x)); }
__device__ __forceinline__ float tanh_fast(float x) { return 1.0f - 2.0f * __builtin_amdgcn_rcpf(1.0f + __expf(2.0f * x)); }
__device__ __forceinline__ float wave_sum(float v) {
#pragma unroll
    for (int o = 1; o < 64; o <<= 1) v += __shfl_xor(v, o);
    return v;
}
__device__ __forceinline__ float wave_max(float v) {
#pragma unroll
    for (int o = 1; o < 64; o <<= 1) v = fmaxf(v, __shfl_xor(v, o));
    return v;
}

__device__ __forceinline__ int opaque_i(int x) { asm volatile("" : "+v"(x)); return x; }
typedef float f32x4m __attribute__((ext_vector_type(4)));
template <int CTRL> __device__ __forceinline__ float dppx(float x) { return __int_as_float(__builtin_amdgcn_update_dpp(0, __float_as_int(x), CTRL, 0xf, 0xf, true)); }
__device__ __forceinline__ void p0_transpose_item(const float* W, int K, int N, bf16* WT, int shift_from, int shift, LAS float* scr, int item, int lane) {
    const int nblk = N / 32, kb = item / nblk, nb = item % nblk, k0 = 64 * kb, n0 = 32 * nb;
#pragma unroll 8
    for (int i = 0; i < 32; ++i) { const int kk = 2 * i + (lane >> 5); scr[kk * 33 + (lane & 31)] = W[(size_t)(k0 + kk) * N + n0 + (lane & 31)]; }
    LDS_WAIT(); asm volatile("" ::: "memory");
    const int c = lane & 7;
    const int r0 = n0 + (n0 >= shift_from ? shift : 0);
#pragma unroll
    for (int j = 0; j < 4; ++j) { const int n = (lane >> 3) + 8 * j; const LAS float* s = scr + (8 * c) * 33 + n;
        v4u o; o.x = pk2(s[0 * 33], s[1 * 33]); o.y = pk2(s[2 * 33], s[3 * 33]); o.z = pk2(s[4 * 33], s[5 * 33]); o.w = pk2(s[6 * 33], s[7 * 33]);
        *(GAS v4u*)(WT + (size_t)(r0 + n) * K + k0 + 8 * c) = o; }
    LDS_WAIT(); asm volatile("" ::: "memory");
}
__device__ __forceinline__ void p0_prologue(Frame& F, const Args& A) {
    LAS float* scr = (LAS float*)(F.lds + RING_OFF + F.wave * 16384);
    const int gw = F.vcu * NWAVES + F.wave, NGW = F.G * NWAVES;
    constexpr int I_IN = (D / 64) * (NPROJ / 32);
    constexpr int I_OUT = (D / 64) * (D / 32);
    constexpr int I_MOD = 48 * 16;
    constexpr int NITEMS = 2 * (I_IN + I_OUT + I_MOD);
    float* mod = (float*)(F.ws + WS_CTL) + CW_MOD;
    for (int it = gw; it < NITEMS; it += NGW) {
        int r = it;
        if (r < 2 * I_IN) { const int l = r / I_IN; p0_transpose_item(A.in[4] + (size_t)l * D * NPROJ, D, NPROJ, (bf16*)(F.ws + WS_WIN) + (size_t)l * NPAD * D, 2432, 128, scr, r % I_IN, F.lane); continue; }
        r -= 2 * I_IN;
        if (r < 2 * I_OUT) { const int l = r / I_OUT; p0_transpose_item(A.in[23] + (size_t)l * D * D, D, D, (bf16*)(F.ws + WS_WOUT) + (size_t)l * D * D, 1 << 30, 0, scr, r % I_OUT, F.lane); continue; }
        r -= 2 * I_OUT;
        {
            const int l = r / I_MOD, rem = r % I_MOD, jb = rem / 16, ib = rem % 16, i0 = ib * 64, j = jb * 64 + F.lane;
#pragma unroll
            for (int b = 0; b < 8; ++b) scr[b * 64 + F.lane] = silu_f(A.in[1][b * D + i0 + F.lane]);
            LDS_WAIT(); asm volatile("" ::: "memory");
            float acc[8];
#pragma unroll
            for (int b = 0; b < 8; ++b) acc[b] = 0.f;
            const float* wa = A.in[2] + (size_t)l * D * 3072 + (size_t)i0 * 3072 + j;
#pragma unroll 4
            for (int i = 0; i < 64; ++i) { const float wv = wa[(size_t)i * 3072];
#pragma unroll
                for (int b = 0; b < 8; ++b) acc[b] += scr[b * 64 + i] * wv; }
            const float bb = (ib == 0) ? A.in[3][l * 3072 + j] : 0.f;
#pragma unroll
            for (int b = 0; b < 8; ++b) atomicAdd(&mod[(l * 8 + b) * 3072 + j], acc[b] + bb);
            LDS_WAIT(); asm volatile("" ::: "memory");
        }
    }
    {
        bf16* LW = (bf16*)(F.ws + WS_LORA);
        const int gt = F.vcu * NTHR + F.tid, GT = F.G * NTHR;
        for (int i = gt; i < 2 * 384 * 64; i += GT) { const int l = i / (384 * 64), r = i % (384 * 64), col = r >> 6, k = r & 63;
            LW[LO_W2T + i] = (bf16)f2bf(A.in[11][((size_t)l * 64 + k) * 384 + col]); LW[LO_A2T + i] = (bf16)f2bf(A.in[13][((size_t)l * 64 + k) * 384 + col]); }
        {   bf16* WSB = (bf16*)(F.ws + WS_WSB);
            for (int i = gt; i < 2 * 4 * 128 * 128; i += GT) { const int p = (i >> 7) & 127, q = i & 127; WSB[i] = (bf16)f2bf(q <= p ? A.in[7][i] : 0.f); } }
        for (int i = gt; i < 32 * 384; i += GT) { const int n = i / 384, j = i % 384; LW[LO_V1T + i] = (bf16)f2bf(A.in[20][j * 32 + n]); }
        for (int i = gt; i < 384 * 32; i += GT) { const int col = i >> 5, n = i & 31; LW[LO_V2T + i] = (bf16)f2bf(A.in[21][n * 384 + col]); }
    }
    for (int l = 0; l < 2; ++l) {
        v4u* z = (v4u*)((bf16*)(F.ws + WS_WIN) + (size_t)l * NPAD * D + (size_t)2432 * D);
        const int n16 = 128 * D * 2 / 16;
        for (int i = F.vcu * NTHR + F.tid; i < n16; i += F.G * NTHR) z[i] = (v4u){0u, 0u, 0u, 0u};
    }
}

__device__ __forceinline__ void p1a_xn(Frame& F, const Args& A, int layer) {
    const int gw = F.vcu * NWAVES + F.wave, NGW = F.G * NWAVES;
    const float* src = layer ? F.out : A.in[0];
    const float* mod = (const float*)(F.ws + WS_CTL) + CW_MOD + (size_t)layer * 8 * 3072;
    float* rowstat = (float*)(F.ws + WS_ROWSTAT);
    bf16* XN = (bf16*)(F.ws + WS_XN);
    const float* lng = A.in[24]; const float* lnb = A.in[25];
    for (int m = gw; m < M; m += NGW) {
        const int b = m / T;
        const GAS f32x4* xr = (const GAS f32x4*)(src + (size_t)m * D) + F.lane;
        f32x4 v[4];
#pragma unroll
        for (int j = 0; j < 4; ++j) v[j] = xr[64 * j];
        if (layer) {
            float s = 0.f;
#pragma unroll
            for (int j = 0; j < 4; ++j) s += (v[j].x + v[j].y) + (v[j].z + v[j].w);
            const float mean = wave_sum(s) * (1.f / D); float s2 = 0.f;
#pragma unroll
            for (int j = 0; j < 4; ++j) { v[j] = v[j] - mean; s2 += (v[j].x * v[j].x + v[j].y * v[j].y) + (v[j].z * v[j].z + v[j].w * v[j].w); }
            const float rstd = 1.f / sqrtf(wave_sum(s2) * (1.f / D) + LN_EPS);
            if (F.lane == 0) { rowstat[2 * (size_t)m] = mean; rowstat[2 * (size_t)m + 1] = rstd; }
#pragma unroll
            for (int j = 0; j < 4; ++j) { const f32x4 g = *((const f32x4*)lng + F.lane + 64 * j), bb = *((const f32x4*)lnb + F.lane + 64 * j); v[j] = v[j] * rstd * g + bb; }
        }
        const f32x4* sh = (const f32x4*)(mod + (size_t)b * 3072) + F.lane;
        const f32x4* sc = (const f32x4*)(mod + (size_t)b * 3072 + 1024) + F.lane;
        GAS unsigned long long* o8 = (GAS unsigned long long*)(XN + (size_t)m * D) + F.lane;
#pragma unroll
        for (int j = 0; j < 4; ++j) { const f32x4 h = v[j] * (sc[64 * j] + 1.0f) + sh[64 * j];
            o8[64 * j] = (unsigned long long)pk2(h.x, h.y) | ((unsigned long long)pk2(h.z, h.w) << 32); }
    }
}
__device__ __forceinline__ void p4_final(Frame& F, const Args& A) {
    const int gw = F.vcu * NWAVES + F.wave, NGW = F.G * NWAVES;
    const float* lng = A.in[24] + D; const float* lnb = A.in[25] + D;
    for (int m = gw; m < M; m += NGW) {
        GAS f32x4* xr = (GAS f32x4*)(F.out + (size_t)m * D) + F.lane;
        f32x4 v[4]; float s = 0.f;
#pragma unroll
        for (int j = 0; j < 4; ++j) { v[j] = xr[64 * j]; s += (v[j].x + v[j].y) + (v[j].z + v[j].w); }
        const float mean = wave_sum(s) * (1.f / D); float s2 = 0.f;
#pragma unroll
        for (int j = 0; j < 4; ++j) { v[j] = v[j] - mean; s2 += (v[j].x * v[j].x + v[j].y * v[j].y) + (v[j].z * v[j].z + v[j].w * v[j].w); }
        const float rstd = 1.f / sqrtf(wave_sum(s2) * (1.f / D) + LN_EPS);
#pragma unroll
        for (int j = 0; j < 4; ++j) { const f32x4 g = *((const f32x4*)lng + F.lane + 64 * j), bb = *((const f32x4*)lnb + F.lane + 64 * j); xr[64 * j] = v[j] * rstd * g + bb; }
    }
}

__device__ __forceinline__ void sgu_unit_simple(Frame& F, const Args& A, int layer, int nb) {
    LAS float* vln = (LAS float*)(F.lds + RING_OFF);
    const bf16* PA = (const bf16*)(F.ws + WS_PA);
    bf16* Y = (bf16*)(F.ws + WS_XN);
    const float* lng = A.in[5] + layer * 256; const float* lnb = A.in[6] + layer * 256;
    const float* wsp = A.in[7] + (size_t)layer * 4 * 128 * 128; const float* bsp = A.in[8] + layer * 4 * 128;
    const size_t m0 = (size_t)nb * 128;
    __syncthreads();
    {
        const int tt = F.tid >> 2, g = F.tid & 3;
        const v4u* src = (const v4u*)(PA + (m0 + tt) * PA_LD + 256 + g * 64);
        float x[64];
#pragma unroll
        for (int i = 0; i < 8; ++i) { const v4u u = src[i]; x[8 * i + 0] = bflo(u.x); x[8 * i + 1] = bfhi(u.x); x[8 * i + 2] = bflo(u.y); x[8 * i + 3] = bfhi(u.y);
            x[8 * i + 4] = bflo(u.z); x[8 * i + 5] = bfhi(u.z); x[8 * i + 6] = bflo(u.w); x[8 * i + 7] = bfhi(u.w); }
        float s = 0.f;
#pragma unroll
        for (int i = 0; i < 64; ++i) s += x[i];
        const float mean = s * (1.f / 64.f); float q = 0.f;
#pragma unroll
        for (int i = 0; i < 64; ++i) { x[i] -= mean; q += x[i] * x[i]; }
        const float rstd = 1.f / sqrtf(q * (1.f / 64.f) + LN_EPS);
#pragma unroll
        for (int i = 0; i < 64; ++i) vln[tt * 256 + g * 64 + i] = x[i] * rstd * lng[g * 64 + i] + lnb[g * 64 + i];
    }
    __syncthreads();
    {
        const int col = F.tid & 255, ph = F.tid >> 8, g = col >> 6;
        for (int p = 64 * ph; p < 64 * ph + 64; ++p) {
            const float* wr = wsp + ((size_t)g * 128 + p) * 128;
            float acc = 0.f;
            for (int q = 0; q <= p; ++q) acc += wr[q] * vln[q * 256 + col];
            const float s = acc + bsp[g * 128 + p];
            const float u = bf2f(PA[(m0 + p) * PA_LD + col]), gt = bf2f(PA[(m0 + p) * PA_LD + 512 + col]);
            Y[(m0 + p) * D + col] = (bf16)f2bf(silu_f(gt) * u * s);
        }
    }
    __syncthreads();
}


constexpr int SG_STRIDE = 272;
__device__ __forceinline__ void sgu_unit_mfma(Frame& F, const Args& A, int layer, int nb) {
    LAS unsigned char* L = F.lds + RING_OFF;
    const bf16* PA = (const bf16*)(F.ws + WS_PA);
    bf16* Y = (bf16*)(F.ws + WS_XN);
    const bf16* WSB = (const bf16*)(F.ws + WS_WSB) + (size_t)layer * 4 * 128 * 128;
    const float* lng = A.in[5] + layer * 256; const float* lnb = A.in[6] + layer * 256; const float* bsp = A.in[8] + layer * 4 * 128;
    const size_t m0 = (size_t)nb * 128;
    const int tid_ = opaque_i(F.tid), lane = tid_ & 63, wid = F.wave, lc = lane & 15, lq = lane >> 4;
    {
        const int tt = tid_ >> 2, g = tid_ & 3;
        const v4u* src = (const v4u*)(PA + (m0 + tt) * PA_LD + 256 + g * 64);
        float x[64];
#pragma unroll
        for (int i = 0; i < 8; ++i) { const v4u u = src[i]; x[8 * i + 0] = bflo(u.x); x[8 * i + 1] = bfhi(u.x); x[8 * i + 2] = bflo(u.y); x[8 * i + 3] = bfhi(u.y);
            x[8 * i + 4] = bflo(u.z); x[8 * i + 5] = bfhi(u.z); x[8 * i + 6] = bflo(u.w); x[8 * i + 7] = bfhi(u.w); }
        float s = 0.f;
#pragma unroll
        for (int i = 0; i < 64; ++i) s += x[i];
        const float mean = s * (1.f / 64.f); float q = 0.f;
#pragma unroll
        for (int i = 0; i < 64; ++i) { x[i] -= mean; q += x[i] * x[i]; }
        const float rstd = 1.f / sqrtf(q * (1.f / 64.f) + LN_EPS);
#pragma unroll
        for (int i = 0; i < 64; ++i) *(LAS bf16*)(L + (g * 64 + i) * SG_STRIDE + tt * 2) = (bf16)f2bf(x[i] * rstd * lng[g * 64 + i] + lnb[g * 64 + i]);
    }
    __syncthreads();
    {
        const int g = wid >> 1, ch = wid & 1;
        const bf16* Wg = WSB + (size_t)g * 128 * 128;
#pragma unroll 1
        for (int i = 0; i < 8; ++i) {
            f32x4m acc0 = {0.f, 0.f, 0.f, 0.f}, acc1 = {0.f, 0.f, 0.f, 0.f};
            const int nks = (i >> 1) + 1;
            for (int ks = 0; ks < nks; ++ks) {
                const bf16x8 a = *(const bf16x8*)(Wg + (size_t)(16 * i + lc) * 128 + 32 * ks + 8 * lq);
                const bf16x8 b0 = *(const LAS bf16x8*)(L + (g * 64 + 32 * ch + lc) * SG_STRIDE + (32 * ks + 8 * lq) * 2);
                const bf16x8 b1 = *(const LAS bf16x8*)(L + (g * 64 + 32 * ch + 16 + lc) * SG_STRIDE + (32 * ks + 8 * lq) * 2);
                acc0 = __builtin_amdgcn_mfma_f32_16x16x32_bf16(a, b0, acc0, 0, 0, 0);
                acc1 = __builtin_amdgcn_mfma_f32_16x16x32_bf16(a, b1, acc1, 0, 0, 0);
            }
#pragma unroll
            for (int r = 0; r < 4; ++r) {
                const int p = 16 * i + 4 * lq + r; const size_t m = m0 + p;
                const float bs = bsp[g * 128 + p];
                const int c0 = g * 64 + 32 * ch + lc, c1 = c0 + 16;
                const float u0 = bf2f(PA[m * PA_LD + c0]), g0 = bf2f(PA[m * PA_LD + 512 + c0]), u1 = bf2f(PA[m * PA_LD + c1]), g1 = bf2f(PA[m * PA_LD + 512 + c1]);
                Y[m * D + c0] = (bf16)f2bf(silu_f(g0) * u0 * (acc0[r] + bs));
                Y[m * D + c1] = (bf16)f2bf(silu_f(g1) * u1 * (acc1[r] + bs));
            }
        }
    }
    __syncthreads();
}
__device__ __forceinline__ void attn_item_simple(Frame& F, const Args& A, int layer, int m, int h) {
    LAS float* wq = (LAS float*)(F.lds + RING_OFF + F.wave * 4096);
    LAS float* wp = wq + 64;
    const bf16* PC = (const bf16*)(F.ws + WS_PC);
    bf16* Y = (bf16*)(F.ws + WS_XN);
    const float* tab = A.in[22] + ((size_t)layer * CH + h) * 513;
    const int t = m % T, n = t >> 6; const size_t mb = (size_t)(m - t);
    const int j0 = (n >= 8 ? n - 8 : 0) * 64, j1 = (n + 1) * 64, cnt = j1 - j0;
    wq[F.lane] = bf2f(PC[(size_t)m * PC_LD + h * 64 + F.lane]);
    LDS_WAIT(); asm volatile("" ::: "memory");
    float sc[9]; float mx = -INFINITY;
#pragma unroll
    for (int rd = 0; rd < 9; ++rd) {
        const int jj = rd * 64 + F.lane; float s = -INFINITY;
        if (jj < cnt) {
            const int kp = j0 + jj;
            const v4u* kr = (const v4u*)(PC + (mb + kp) * PC_LD + 384 + h * 64);
            float dot = 0.f;
#pragma unroll
            for (int i = 0; i < 8; ++i) { const v4u u = kr[i]; const LAS float* q = wq + 8 * i;
                dot += q[0] * bflo(u.x) + q[1] * bfhi(u.x) + q[2] * bflo(u.y) + q[3] * bfhi(u.y) + q[4] * bflo(u.z) + q[5] * bfhi(u.z) + q[6] * bflo(u.w) + q[7] * bfhi(u.w); }
            int dist = t - kp; dist = dist < -256 ? -256 : (dist > 256 ? 256 : dist);
            s = dot + tab[dist + 256] * LOG2E;
        }
        sc[rd] = s; mx = fmaxf(mx, s);
    }
    mx = wave_max(mx);
    float sum = 0.f;
#pragma unroll
    for (int rd = 0; rd < 9; ++rd) { const float p = exp2f(sc[rd] - mx); sum += p; wp[rd * 64 + F.lane] = p; }
    sum = wave_sum(sum);
    LDS_WAIT(); asm volatile("" ::: "memory");
    const bf16* vb = PC + (mb + j0) * PC_LD + 768 + h * 64 + F.lane;
    float o = 0.f;
    for (int jj = 0; jj < cnt; ++jj) o += wp[jj] * bf2f(vb[(size_t)jj * PC_LD]);
    o /= sum;
    const float g = bf2f(PC[(size_t)m * PC_LD + 1152 + h * 64 + F.lane]);
    Y[(size_t)m * D + 640 + h * 64 + F.lane] = (bf16)f2bf(silu_f(g) * o);
    LDS_WAIT(); asm volatile("" ::: "memory");
}


typedef float f32x16 __attribute__((ext_vector_type(16)));
typedef short s16x4 __attribute__((ext_vector_type(4)));
constexpr int AT_K = 0, AT_V = 16384, AT_TAB = 32768, AT_WSF = AT_TAB + 2560;
__device__ __forceinline__ int crow(int r, int hi) { return (r & 3) + 8 * (r >> 2) + 4 * hi; }
__device__ __forceinline__ s16x4 vtr(const LAS unsigned char* p) { return __builtin_bit_cast(s16x4, __builtin_amdgcn_ds_read_tr16_b64_v4i16((LAS s16x4*)p)); }
__device__ __forceinline__ void attn_unit_mfma(Frame& F, const Args& A, int layer, int u) {
    const int qi = u & 31, h = (u >> 5) % CH, b = u / (32 * CH);
    const int tid = opaque_i(F.tid), lane = tid & 63, wid = F.wave, r32 = lane & 31, hi = lane >> 5;
    LAS unsigned char* L = F.lds + RING_OFF;
    const bf16* PC = (const bf16*)(F.ws + WS_PC);
    bf16* Y = (bf16*)(F.ws + WS_XN);
    const size_t mb = (size_t)b * T;
    const int ci = wid >> 1, qin = 32 * (wid & 1) + r32;
    const size_t qrow = mb + (size_t)(4 * qi + ci) * 64 + 32 * (wid & 1);
    const int jmin = (qi >= 2) ? 0 : 8 - 4 * qi;
    {   const float* tab = A.in[22] + ((size_t)layer * CH + h) * 513;
        LAS float* lt = (LAS float*)(L + AT_TAB);
        for (int i = tid; i < 640; i += NTHR) lt[i] = tab[i < 512 ? i : 512] * LOG2E; }
    bf16x8 qr[4];
#pragma unroll
    for (int d0 = 0; d0 < 4; ++d0) qr[d0] = *(const bf16x8*)(PC + (qrow + r32) * PC_LD + h * 64 + d0 * 16 + hi * 8);
    const bf16* ksrc = PC + (mb + (size_t)(4 * qi - 8) * 64 + lane) * PC_LD + 384 + h * 64 + wid * 8;
    const bf16* vsrc = PC + (mb + (size_t)(4 * qi - 8) * 64 + 16 * (wid & 3) + (lane >> 2)) * PC_LD + 768 + h * 64 + (wid >> 2) * 32 + (lane & 3) * 8;
    v4u kreg = *(const v4u*)(ksrc + (size_t)jmin * 64 * PC_LD), vreg = *(const v4u*)(vsrc + (size_t)jmin * 64 * PC_LD);
    f32x16 o0 = {}, o1 = {};
    float mref = 0.f, lsum = 0.f; bool first = true;
    const float tabc = A.in[22][((size_t)layer * CH + h) * 513 + 512] * LOG2E;
    for (int j = jmin; j < 12; ++j) {
        const int slot = (j - jmin) & 1;
        *(LAS v4u*)(L + AT_K + slot * 8192 + wid * 1024 + lane * 16) = kreg;
        *(LAS v4u*)(L + AT_V + slot * 8192 + wid * 1024 + lane * 16) = vreg;
        __syncthreads();
        if (j < 11) { kreg = *(const v4u*)(ksrc + (size_t)(j + 1) * 64 * PC_LD); vreg = *(const v4u*)(vsrc + (size_t)(j + 1) * 64 * PC_LD); }
        if (j >= ci && j <= ci + 8) {
            const int cd = ci + 8 - j;
            const LAS unsigned char* kb = L + AT_K + slot * 8192 + hi * 1024 + r32 * 16;
            f32x16 p0 = {}, p1 = {};
#pragma unroll
            for (int d0 = 0; d0 < 4; ++d0) {
                const bf16x8 b0 = *(const LAS bf16x8*)(kb + d0 * 2048), b1 = *(const LAS bf16x8*)(kb + d0 * 2048 + 512);
                p0 = __builtin_amdgcn_mfma_f32_32x32x16_bf16(b0, qr[d0], p0, 0, 0, 0);
                p1 = __builtin_amdgcn_mfma_f32_32x32x16_bf16(b1, qr[d0], p1, 0, 0, 0);
            }
            if (cd >= 5) {
#pragma unroll
                for (int r = 0; r < 16; ++r) { p0[r] += tabc; p1[r] += tabc; }
            } else {
                const LAS unsigned char* tb = L + AT_TAB + 4 * (64 * cd + 256 + qin - 4 * hi - 63);
#pragma unroll
                for (int r = 0; r < 16; ++r) {
                    p0[r] += *(const LAS float*)(tb + 4 * (63 - ((r & 3) + 8 * (r >> 2))));
                    p1[r] += *(const LAS float*)(tb + 4 * (63 - ((r & 3) + 8 * (r >> 2) + 32)));
                }
            }
            if (first) {
                float mx = p0[0];
#pragma unroll
                for (int r = 0; r < 16; ++r) mx = fmaxf(mx, fmaxf(p0[r], p1[r]));
                const unsigned um = __float_as_uint(mx);
                auto rr = __builtin_amdgcn_permlane32_swap(um, um, false, false);
                const unsigned m0 = rr[0], m1 = rr[1];
                mref = fmaxf(__uint_as_float(m0), __uint_as_float(m1));
                first = false;
            }
            float sacc = 0.f;
#pragma unroll
            for (int r = 0; r < 16; ++r) { p0[r] = exp2f(p0[r] - mref); p1[r] = exp2f(p1[r] - mref); sacc += p0[r] + p1[r]; }
            lsum += sacc;
            v4u pw0, pw1, pw2, pw3;
            pw0.x = pg8::cvt_pk_bf16(p0[0], p0[1]); pw0.y = pg8::cvt_pk_bf16(p0[2], p0[3]); pw0.z = pg8::cvt_pk_bf16(p0[4], p0[5]); pw0.w = pg8::cvt_pk_bf16(p0[6], p0[7]);
            pw1.x = pg8::cvt_pk_bf16(p0[8], p0[9]); pw1.y = pg8::cvt_pk_bf16(p0[10], p0[11]); pw1.z = pg8::cvt_pk_bf16(p0[12], p0[13]); pw1.w = pg8::cvt_pk_bf16(p0[14], p0[15]);
            pw2.x = pg8::cvt_pk_bf16(p1[0], p1[1]); pw2.y = pg8::cvt_pk_bf16(p1[2], p1[3]); pw2.z = pg8::cvt_pk_bf16(p1[4], p1[5]); pw2.w = pg8::cvt_pk_bf16(p1[6], p1[7]);
            pw3.x = pg8::cvt_pk_bf16(p1[8], p1[9]); pw3.y = pg8::cvt_pk_bf16(p1[10], p1[11]); pw3.z = pg8::cvt_pk_bf16(p1[12], p1[13]); pw3.w = pg8::cvt_pk_bf16(p1[14], p1[15]);
            const LAS unsigned char* vb = L + AT_V + slot * 8192 + ((lane >> 4) & 1) * 32 + (lane & 3) * 8 + (4 * hi + ((lane & 15) >> 2)) * 64;
#define AT_PV(OACC, D0) do { \
            s16x4 lo0 = vtr(vb + (D0) * 4096), hi0 = vtr(vb + (D0) * 4096 + 512), lo1 = vtr(vb + (D0) * 4096 + 1024), hi1 = vtr(vb + (D0) * 4096 + 1536), \
                  lo2 = vtr(vb + (D0) * 4096 + 2048), hi2 = vtr(vb + (D0) * 4096 + 2560), lo3 = vtr(vb + (D0) * 4096 + 3072), hi3 = vtr(vb + (D0) * 4096 + 3584); \
            OACC = __builtin_amdgcn_mfma_f32_32x32x16_bf16(__builtin_bit_cast(bf16x8, pw0), ((bf16x8){lo0[0], lo0[1], lo0[2], lo0[3], hi0[0], hi0[1], hi0[2], hi0[3]}), OACC, 0, 0, 0); \
            OACC = __builtin_amdgcn_mfma_f32_32x32x16_bf16(__builtin_bit_cast(bf16x8, pw1), ((bf16x8){lo1[0], lo1[1], lo1[2], lo1[3], hi1[0], hi1[1], hi1[2], hi1[3]}), OACC, 0, 0, 0); \
            OACC = __builtin_amdgcn_mfma_f32_32x32x16_bf16(__builtin_bit_cast(bf16x8, pw2), ((bf16x8){lo2[0], lo2[1], lo2[2], lo2[3], hi2[0], hi2[1], hi2[2], hi2[3]}), OACC, 0, 0, 0); \
            OACC = __builtin_amdgcn_mfma_f32_32x32x16_bf16(__builtin_bit_cast(bf16x8, pw3), ((bf16x8){lo3[0], lo3[1], lo3[2], lo3[3], hi3[0], hi3[1], hi3[2], hi3[3]}), OACC, 0, 0, 0); } while (0)
            AT_PV(o0, 0); AT_PV(o1, 1);
#undef AT_PV
        }
    }
    {   const unsigned ul = __float_as_uint(lsum);
        auto rr = __builtin_amdgcn_permlane32_swap(ul, ul, false, false);
        const unsigned l0 = rr[0], l1 = rr[1];
        const float lt = __uint_as_float(l0) + __uint_as_float(l1);
        LAS float* wsf = (LAS float*)(L + AT_WSF) + wid * 32;
        if (hi == 0) wsf[r32] = lt;
        LDS_WAIT(); asm volatile("" ::: "memory");
#pragma unroll
        for (int r = 0; r < 16; ++r) {
            const int q = crow(r, hi);
            const float rl = 1.0f / wsf[q];
            const size_t row = qrow + q;
            const float g0 = bf2f(PC[row * PC_LD + 1152 + h * 64 + r32]), g1 = bf2f(PC[row * PC_LD + 1152 + h * 64 + 32 + r32]);
            Y[row * D + 640 + h * 64 + r32] = (bf16)f2bf(silu_f(g0) * o0[r] * rl);
            Y[row * D + 640 + h * 64 + 32 + r32] = (bf16)f2bf(silu_f(g1) * o1[r] * rl);
        }
    }
    __syncthreads();
}
__device__ __forceinline__ float softplus_f(float x) { return fmaxf(x, 0.f) + log1pf(__expf(-fabsf(x))); }
__device__ __forceinline__ void rwkv_pre_simple(Frame& F, const Args& A, int layer) {
    LAS float* lw = (LAS float*)(F.lds + RING_OFF);
    LAS float* la = lw + 64;
    LAS float* vs = la + 64;
    LAS float* h1 = vs + 384;
    LAS float* k2 = h1 + 32;
    const bf16* PB = (const bf16*)(F.ws + WS_PB);
    bf16* OPS = (bf16*)(F.ws + WS_OPS);
    const float* mu = A.in[9] + layer * BSHIFT;
    const float* w0 = A.in[10] + layer * 384; const float* w2 = A.in[11] + (size_t)layer * 64 * 384;
    const float* a0 = A.in[12] + layer * 384; const float* a2 = A.in[13] + (size_t)layer * 64 * 384;
    const float* kkp = A.in[14] + layer * 384; const float* kap = A.in[15] + layer * 384;
    const float* v0 = A.in[19]; const float* v1 = A.in[20]; const float* v2 = A.in[21];
    const int per = M / F.G;
    const int tid = F.tid;
    for (int m = F.vcu * per; m < (F.vcu + 1) * per; ++m) {
        const int t = m % T, b = m / T;
        const bf16* pc = PB + (size_t)m * PB_LD; const bf16* pp = pc - PB_LD;
        float xr = 0.f, xk = 0.f, xv = 0.f;
        if (tid < 384) {
            const float c0 = bf2f(pc[tid]), c1 = bf2f(pc[384 + tid]), c2 = bf2f(pc[768 + tid]);
            const float p0 = t ? bf2f(pp[tid]) : 0.f, p1 = t ? bf2f(pp[384 + tid]) : 0.f, p2 = t ? bf2f(pp[768 + tid]) : 0.f;
            xr = c0 + (p0 - c0) * mu[tid]; xk = c1 + (p1 - c1) * mu[384 + tid]; xv = c2 + (p2 - c2) * mu[768 + tid];
            vs[tid] = xv;
        } else {
            const int i = tid - 384, col = 1152 + i;
            const float c0 = bf2f(pc[col]), p0 = t ? bf2f(pp[col]) : 0.f;
            const float xl = c0 + (p0 - c0) * mu[col];
            if (i < 64) lw[i] = tanhf(xl); else la[i - 64] = xl;
        }
        __syncthreads();
        float wlin = 0.f, alin = 0.f;
        if (tid < 384) {
#pragma unroll 8
            for (int i = 0; i < 64; ++i) { wlin += lw[i] * w2[i * 384 + tid]; alin += la[i] * a2[i * 384 + tid]; }
        } else if (layer && tid < 384 + 32) {
            const int n = tid - 384; float acc = 0.f;
            for (int j = 0; j < 384; ++j) acc += vs[j] * v1[j * 32 + n];
            h1[n] = acc;
        }
        float kk = 0.f;
        if (tid < 384) { kk = xk * kkp[tid]; k2[tid] = kk * kk; }
        __syncthreads();
        if (tid < 384) {
            const int hh = tid >> 6, cc = tid & 63;
            const size_t oidx = ((size_t)(b * BH + hh) * T + t) * 384 + cc;
            if (layer) {
                float vl = 0.f;
#pragma unroll 8
                for (int n = 0; n < 32; ++n) vl += h1[n] * v2[n * 384 + tid];
                const float vf = bf2f(OPS[oidx + 3 * 64]);
                xv = xv + (vf - xv) * sigmoid_f(v0[tid] + vl);
            }
            const float w = -softplus_f(-(w0[tid] + wlin)) - 0.5f;
            const float dw = -expm1f(-__expf(w));
            const float a = sigmoid_f(a0[tid] + alin);
            float hs = 0.f;
#pragma unroll 8
            for (int i = 0; i < 64; ++i) hs += k2[hh * 64 + i];
            const float kn = kk / fmaxf(sqrtf(hs), 1e-12f);
            const float kq = xk * (1.f + (a - 1.f) * kap[tid]);
            OPS[oidx] = (bf16)f2bf(xr); OPS[oidx + 64] = (bf16)f2bf(dw); OPS[oidx + 128] = (bf16)f2bf(kq);
            OPS[oidx + 192] = (bf16)f2bf(xv); OPS[oidx + 256] = (bf16)f2bf(-kn); OPS[oidx + 320] = (bf16)f2bf(kn * a);
        }
        __syncthreads();
    }
}


constexpr int PR_A1 = 0, PR_A2 = 9216, PR_A4 = 18432, PR_A3 = 24576;
__device__ __forceinline__ float rowred16(float x) { x += dppx<0xB1>(x); x += dppx<0x4E>(x); x += dppx<0x141>(x); x += dppx<0x140>(x); return x; }
template <int layer> __device__ __forceinline__ void rwkv_pre_tile(Frame& F, const Args& A, int tile) {
    LAS unsigned char* L = F.lds + RING_OFF;
    const bf16* PB = (const bf16*)(F.ws + WS_PB);
    bf16* OPS = (bf16*)(F.ws + WS_OPS);
    const bf16* LW = (const bf16*)(F.ws + WS_LORA);
    const float* mu = A.in[9] + layer * BSHIFT;
    const int tid = opaque_i(F.tid), lane = tid & 63, wid = F.wave, lc = lane & 15, lq = lane >> 4;
    const size_t m0 = (size_t)tile * 64;
    const int b = (int)(m0 / T), t0 = (int)(m0 % T);
    {
        const int tt = tid >> 3, cg = tid & 7;
        const bool hasp = (t0 + tt) != 0;
        const bf16* pc = PB + (m0 + tt) * PB_LD; const bf16* pp = pc - PB_LD;
        {   const int c0 = 1152 + 16 * cg;
            unsigned outw[8];
#pragma unroll
            for (int i = 0; i < 2; ++i) {
                const v4u c = *(const v4u*)(pc + c0 + 8 * i); v4u p = (v4u){0u, 0u, 0u, 0u}; if (hasp) p = *(const v4u*)(pp + c0 + 8 * i);
                const unsigned cw[4] = {c.x, c.y, c.z, c.w}, pw[4] = {p.x, p.y, p.z, p.w};
#pragma unroll
                for (int e = 0; e < 4; ++e) {
                    const int col = c0 + 8 * i + 2 * e;
                    float x0 = bflo(cw[e]), x1 = bfhi(cw[e]);
                    x0 = x0 + (bflo(pw[e]) - x0) * mu[col]; x1 = x1 + (bfhi(pw[e]) - x1) * mu[col + 1];
                    if (cg < 4) { x0 = tanhf(x0); x1 = tanhf(x1); }
                    outw[4 * i + e] = pk2(x0, x1);
                }
            }
            LAS v4u* d = (LAS v4u*)(L + (cg < 4 ? PR_A1 : PR_A2) + tt * 144 + (cg & 3) * 32);
            d[0] = (v4u){outw[0], outw[1], outw[2], outw[3]}; d[1] = (v4u){outw[4], outw[5], outw[6], outw[7]};
        }
        if (layer) {
#pragma unroll
            for (int i = 0; i < 6; ++i) {
                const int c0 = 768 + 48 * cg + 8 * i;
                const v4u c = *(const v4u*)(pc + c0); v4u p = (v4u){0u, 0u, 0u, 0u}; if (hasp) p = *(const v4u*)(pp + c0);
                const unsigned cw[4] = {c.x, c.y, c.z, c.w}, pw[4] = {p.x, p.y, p.z, p.w}; unsigned ow[4];
#pragma unroll
                for (int e = 0; e < 4; ++e) { float x0 = bflo(cw[e]), x1 = bfhi(cw[e]);
                    x0 = x0 + (bflo(pw[e]) - x0) * mu[c0 + 2 * e]; x1 = x1 + (bfhi(pw[e]) - x1) * mu[c0 + 2 * e + 1]; ow[e] = pk2(x0, x1); }
                *(LAS v4u*)(L + PR_A3 + tt * 784 + (48 * cg + 8 * i) * 2) = (v4u){ow[0], ow[1], ow[2], ow[3]};
            }
        }
    }
    __syncthreads();
    if (layer) {
        const int tq = wid >> 1, nt = wid & 1;
        f32x4m acc = {0.f, 0.f, 0.f, 0.f};
#pragma unroll
        for (int ks = 0; ks < 12; ++ks) {
            const bf16x8 a3 = *(const LAS bf16x8*)(L + PR_A3 + (16 * tq + lc) * 784 + (32 * ks + 8 * lq) * 2);
            const bf16x8 bv = *(const bf16x8*)(LW + LO_V1T + (16 * nt + lc) * 384 + 32 * ks + 8 * lq);
            acc = __builtin_amdgcn_mfma_f32_16x16x32_bf16(a3, bv, acc, 0, 0, 0);
        }
#pragma unroll
        for (int r = 0; r < 4; ++r) *(LAS bf16*)(L + PR_A4 + (16 * tq + 4 * lq + r) * 80 + (16 * nt + lc) * 2) = (bf16)f2bf(acc[r]);
        __syncthreads();
    }
    const float* w0 = A.in[10] + layer * 384; const float* a0 = A.in[12] + layer * 384;
    const float* kkp = A.in[14] + layer * 384; const float* kap = A.in[15] + layer * 384; const float* v0 = A.in[19];
#pragma unroll 1
    for (int ui = 0; ui < 3; ++ui) {
        const int id = 3 * wid + ui, hh = id >> 2, tq = id & 3;
        f32x4m wl[4], al[4], vl[4];
#pragma unroll
        for (int ct = 0; ct < 4; ++ct) { wl[ct] = (f32x4m){0.f, 0.f, 0.f, 0.f}; al[ct] = wl[ct]; vl[ct] = wl[ct]; }
#pragma unroll
        for (int ks = 0; ks < 2; ++ks) {
            const bf16x8 a1 = *(const LAS bf16x8*)(L + PR_A1 + (16 * tq + lc) * 144 + (32 * ks + 8 * lq) * 2);
            const bf16x8 a2f = *(const LAS bf16x8*)(L + PR_A2 + (16 * tq + lc) * 144 + (32 * ks + 8 * lq) * 2);
#pragma unroll
            for (int ct = 0; ct < 4; ++ct) {
                const int col = hh * 64 + ct * 16 + lc;
                const bf16x8 bw = *(const bf16x8*)(LW + LO_W2T + ((size_t)layer * 384 + col) * 64 + 32 * ks + 8 * lq);
                const bf16x8 ba = *(const bf16x8*)(LW + LO_A2T + ((size_t)layer * 384 + col) * 64 + 32 * ks + 8 * lq);
                wl[ct] = __builtin_amdgcn_mfma_f32_16x16x32_bf16(a1, bw, wl[ct], 0, 0, 0);
                al[ct] = __builtin_amdgcn_mfma_f32_16x16x32_bf16(a2f, ba, al[ct], 0, 0, 0);
            }
        }
        if (layer) {
            const bf16x8 a4 = *(const LAS bf16x8*)(L + PR_A4 + (16 * tq + lc) * 80 + 8 * lq * 2);
#pragma unroll
            for (int ct = 0; ct < 4; ++ct) {
                const int col = hh * 64 + ct * 16 + lc;
                const bf16x8 bv = *(const bf16x8*)(LW + LO_V2T + col * 32 + 8 * lq);
                vl[ct] = __builtin_amdgcn_mfma_f32_16x16x32_bf16(a4, bv, vl[ct], 0, 0, 0);
            }
        }
        float kkv[4][4], av[4][4], ss[4] = {0.f, 0.f, 0.f, 0.f};
        const size_t obase = ((size_t)(b * BH + hh) * T + t0 + 16 * tq + 4 * lq) * 384;
#pragma unroll
        for (int ct = 0; ct < 4; ++ct) {
            const int col = hh * 64 + ct * 16 + lc, cc = ct * 16 + lc;
            const float mur = mu[col], muk = mu[384 + col], muv = mu[768 + col], w0c = w0[col], a0c = a0[col], kkc = kkp[col], kac = kap[col];
            const float v0c = layer ? v0[col] : 0.f;
#pragma unroll
            for (int r = 0; r < 4; ++r) {
                const int tok = 16 * tq + 4 * lq + r;
                const bf16* pc = PB + (m0 + tok) * PB_LD + col; const bf16* pp = pc - PB_LD;
                const bool hasp = (t0 + tok) != 0;
                const float c0 = bf2f(pc[0]), c1 = bf2f(pc[384]), c2 = bf2f(pc[768]);
                const float p0 = hasp ? bf2f(pp[0]) : 0.f, p1 = hasp ? bf2f(pp[384]) : 0.f, p2 = hasp ? bf2f(pp[768]) : 0.f;
                const float xr = c0 + (p0 - c0) * mur, xk = c1 + (p1 - c1) * muk; float xv = c2 + (p2 - c2) * muv;
                const size_t oidx = obase + (size_t)r * 384 + cc;
                if (layer) { const float vf = bf2f(OPS[oidx + 192]); xv = xv + (vf - xv) * sigmoid_f(v0c + vl[ct][r]); }
                const float w = -softplus_f(-(w0c + wl[ct][r])) - 0.5f;
                const float dw = -expm1f(-__expf(w));
                const float a = sigmoid_f(a0c + al[ct][r]);
                const float kk = xk * kkc;
                kkv[ct][r] = kk; av[ct][r] = a; ss[r] += kk * kk;
                OPS[oidx] = (bf16)f2bf(xr); OPS[oidx + 64] = (bf16)f2bf(dw); OPS[oidx + 128] = (bf16)f2bf(xk * (1.f + (a - 1.f) * kac)); OPS[oidx + 192] = (bf16)f2bf(xv);
            }
        }
#pragma unroll
        for (int r = 0; r < 4; ++r) ss[r] = 1.0f / fmaxf(sqrtf(rowred16(ss[r])), 1e-12f);
#pragma unroll
        for (int ct = 0; ct < 4; ++ct)
#pragma unroll
            for (int r = 0; r < 4; ++r) { const size_t oidx = obase + (size_t)r * 384 + ct * 16 + lc; const float kn = kkv[ct][r] * ss[r];
                OPS[oidx + 256] = (bf16)f2bf(-kn); OPS[oidx + 320] = (bf16)f2bf(kn * av[ct][r]); }
    }
    __syncthreads();
}

constexpr int P2_A1 = 0, P2_A2 = 9216, P2_A4 = 18432, P2_RN = 23552, P2_XS = 24576, P2_XST = 272, P2_OT = 77824, P2_A3 = 24576;
template <int layer> __device__ __forceinline__ void rwkv_pre_tile2(Frame& F, const Args& A, int tile) {
    LAS unsigned char* L = F.lds + RING_OFF;
    const bf16* PB = (const bf16*)(F.ws + WS_PB);
    bf16* OPS = (bf16*)(F.ws + WS_OPS);
    const bf16* LW = (const bf16*)(F.ws + WS_LORA);
    const float* mu = A.in[9] + layer * BSHIFT;
    const int tid = opaque_i(F.tid), lane = tid & 63, wid = F.wave, lc = lane & 15, lq = lane >> 4;
    const int tr = wid >> 1, tc0 = 2 * (wid & 1);
    const size_t m0 = (size_t)tile * 64;
    const int b = (int)(m0 / T), t0 = (int)(m0 % T);
    const int tt = tid >> 3, cg = tid & 7;
    const bool hasp = (t0 + tt) != 0;
    const bf16* pc = PB + (m0 + tt) * PB_LD; const bf16* pp = pc - PB_LD;
    {
        {   const int c0 = 1152 + 16 * cg;
            unsigned outw[8];
#pragma unroll
            for (int i = 0; i < 2; ++i) {
                const v4u c = *(const v4u*)(pc + c0 + 8 * i); v4u p = (v4u){0u, 0u, 0u, 0u}; if (hasp) p = *(const v4u*)(pp + c0 + 8 * i);
                const unsigned cw[4] = {c.x, c.y, c.z, c.w}, pw[4] = {p.x, p.y, p.z, p.w};
#pragma unroll
                for (int e = 0; e < 4; ++e) {
                    const int col = c0 + 8 * i + 2 * e;
                    float x0 = bflo(cw[e]), x1 = bfhi(cw[e]);
                    x0 = x0 + (bflo(pw[e]) - x0) * mu[col]; x1 = x1 + (bfhi(pw[e]) - x1) * mu[col + 1];
                    if (cg < 4) { x0 = tanhf(x0); x1 = tanhf(x1); }
                    outw[4 * i + e] = pk2(x0, x1);
                }
            }
            LAS v4u* d = (LAS v4u*)(L + (cg < 4 ? P2_A1 : P2_A2) + tt * 144 + (cg & 3) * 32);
            d[0] = (v4u){outw[0], outw[1], outw[2], outw[3]}; d[1] = (v4u){outw[4], outw[5], outw[6], outw[7]};
        }
        if (layer) {
#pragma unroll
            for (int i = 0; i < 6; ++i) {
                const int c0 = 768 + 48 * cg + 8 * i;
                const v4u c = *(const v4u*)(pc + c0); v4u p = (v4u){0u, 0u, 0u, 0u}; if (hasp) p = *(const v4u*)(pp + c0);
                const unsigned cw[4] = {c.x, c.y, c.z, c.w}, pw[4] = {p.x, p.y, p.z, p.w}; unsigned ow[4];
#pragma unroll
                for (int e = 0; e < 4; ++e) { float x0 = bflo(cw[e]), x1 = bfhi(cw[e]);
                    x0 = x0 + (bflo(pw[e]) - x0) * mu[c0 + 2 * e]; x1 = x1 + (bfhi(pw[e]) - x1) * mu[c0 + 2 * e + 1]; ow[e] = pk2(x0, x1); }
                *(LAS v4u*)(L + P2_A3 + tt * 784 + (48 * cg + 8 * i) * 2) = (v4u){ow[0], ow[1], ow[2], ow[3]};
            }
        }
    }
    __syncthreads();
    if (layer) {
        const int tq = wid >> 1, nt = wid & 1;
        f32x4m acc = {0.f, 0.f, 0.f, 0.f};
#pragma unroll
        for (int ks = 0; ks < 12; ++ks) {
            const bf16x8 a3 = *(const LAS bf16x8*)(L + P2_A3 + (16 * tq + lc) * 784 + (32 * ks + 8 * lq) * 2);
            const bf16x8 bv = *(const bf16x8*)(LW + LO_V1T + (16 * nt + lc) * 384 + 32 * ks + 8 * lq);
            acc = __builtin_amdgcn_mfma_f32_16x16x32_bf16(a3, bv, acc, 0, 0, 0);
        }
#pragma unroll
        for (int r = 0; r < 4; ++r) *(LAS bf16*)(L + P2_A4 + (16 * tq + 4 * lq + r) * 80 + (16 * nt + lc) * 2) = (bf16)f2bf(acc[r]);
        __syncthreads();
    }
    const float* w0 = A.in[10] + layer * 384; const float* a0 = A.in[12] + layer * 384;
    const float* kkp = A.in[14] + layer * 384; const float* kap = A.in[15] + layer * 384; const float* v0 = A.in[19];
#pragma unroll 1
    for (int hh = 0; hh < BH; ++hh) {
        {
            float ss = 0.f;
#pragma unroll
            for (int i = 0; i < 3; ++i) {
                const int c0 = i * 384 + hh * 64 + cg * 8;
                const v4u c = *(const v4u*)(pc + c0); v4u p = (v4u){0u, 0u, 0u, 0u}; if (hasp) p = *(const v4u*)(pp + c0);
                const f32x4m m0v = *(const f32x4m*)(mu + c0), m1v = *(const f32x4m*)(mu + c0 + 4);
                f32x4m x0 = {bflo(c.x), bfhi(c.x), bflo(c.y), bfhi(c.y)}, x1 = {bflo(c.z), bfhi(c.z), bflo(c.w), bfhi(c.w)};
                const f32x4m q0 = {bflo(p.x), bfhi(p.x), bflo(p.y), bfhi(p.y)}, q1 = {bflo(p.z), bfhi(p.z), bflo(p.w), bfhi(p.w)};
                x0 = x0 + (q0 - x0) * m0v; x1 = x1 + (q1 - x1) * m1v;
                LAS f32x4m* d = (LAS f32x4m*)(L + P2_XS + (i * 64 + tt) * P2_XST + cg * 32);
                d[0] = x0; d[1] = x1;
                if (i == 1) { const f32x4m k0 = *(const f32x4m*)(kkp + hh * 64 + cg * 8), k1 = *(const f32x4m*)(kkp + hh * 64 + cg * 8 + 4);
                    const f32x4m y0 = x0 * k0, y1 = x1 * k1; ss = (y0.x * y0.x + y0.y * y0.y) + (y0.z * y0.z + y0.w * y0.w) + (y1.x * y1.x + y1.y * y1.y) + (y1.z * y1.z + y1.w * y1.w); }
            }
            ss += dppx<0xB1>(ss); ss += dppx<0x4E>(ss); ss += dppx<0x141>(ss);
            if (cg == 0) *(LAS float*)(L + P2_RN + tt * 4) = 1.0f / fmaxf(sqrtf(ss), 1e-12f);
        }
        __syncthreads();
        f32x4m wl[2], al[2], vl[2];
        {
            bf16x8 a1[2], a2f[2];
#pragma unroll
            for (int ks = 0; ks < 2; ++ks) { a1[ks] = *(const LAS bf16x8*)(L + P2_A1 + (16 * tr + lc) * 144 + (32 * ks + 8 * lq) * 2); a2f[ks] = *(const LAS bf16x8*)(L + P2_A2 + (16 * tr + lc) * 144 + (32 * ks + 8 * lq) * 2); }
#pragma unroll
            for (int j = 0; j < 2; ++j) {
                const int col = hh * 64 + 16 * (tc0 + j) + lc;
                wl[j] = (f32x4m){0.f, 0.f, 0.f, 0.f}; al[j] = wl[j]; vl[j] = wl[j];
#pragma unroll
                for (int ks = 0; ks < 2; ++ks) {
                    const bf16x8 bw = *(const bf16x8*)(LW + LO_W2T + ((size_t)layer * 384 + col) * 64 + 32 * ks + 8 * lq);
                    const bf16x8 ba = *(const bf16x8*)(LW + LO_A2T + ((size_t)layer * 384 + col) * 64 + 32 * ks + 8 * lq);
                    wl[j] = __builtin_amdgcn_mfma_f32_16x16x32_bf16(a1[ks], bw, wl[j], 0, 0, 0);
                    al[j] = __builtin_amdgcn_mfma_f32_16x16x32_bf16(a2f[ks], ba, al[j], 0, 0, 0);
                }
                if (layer) {
                    const bf16x8 a4 = *(const LAS bf16x8*)(L + P2_A4 + (16 * tr + lc) * 80 + 8 * lq * 2);
                    const bf16x8 bv = *(const bf16x8*)(LW + LO_V2T + col * 32 + 8 * lq);
                    vl[j] = __builtin_amdgcn_mfma_f32_16x16x32_bf16(a4, bv, vl[j], 0, 0, 0);
                }
            }
        }
        {
            const size_t gbase = ((size_t)(b * BH + hh) * T + t0) * 384;
            float vfv[2][4];
            if (layer) {
#pragma unroll
                for (int j = 0; j < 2; ++j)
#pragma unroll
                    for (int r = 0; r < 4; ++r) vfv[j][r] = bf2f(OPS[gbase + (size_t)(16 * tr + 4 * lq + r) * 384 + 192 + 16 * (tc0 + j) + lc]);
            }
#pragma unroll
            for (int j = 0; j < 2; ++j) {
                const int cc = 16 * (tc0 + j) + lc, col = hh * 64 + cc;
                const float w0c = w0[col], a0c = a0[col], kkc = kkp[col], kac = kap[col];
                const float v0c = layer ? v0[col] : 0.f;
#pragma unroll
                for (int r = 0; r < 4; ++r) {
                    const int tok = 16 * tr + 4 * lq + r;
                    const float xr = *(const LAS float*)(L + P2_XS + tok * P2_XST + cc * 4);
                    const float xk = *(const LAS float*)(L + P2_XS + (64 + tok) * P2_XST + cc * 4);
                    float xv = *(const LAS float*)(L + P2_XS + (128 + tok) * P2_XST + cc * 4);
                    const float rn = *(const LAS float*)(L + P2_RN + tok * 4);
                    if (layer) xv = xv + (vfv[j][r] - xv) * sigmoid_f(v0c + vl[j][r]);
                    const float w = -softplus_f(-(w0c + wl[j][r])) - 0.5f;
                    const float dw = -expm1f(-__expf(w));
                    const float a = sigmoid_f(a0c + al[j][r]);
                    const float kn = xk * kkc * rn;
                    LAS bf16* o = (LAS bf16*)(L + P2_OT + (tok * 384 + cc) * 2);
                    o[0] = (bf16)f2bf(xr); o[64] = (bf16)f2bf(dw); o[128] = (bf16)f2bf(xk * (1.f + (a - 1.f) * kac)); o[192] = (bf16)f2bf(xv);
                    o[256] = (bf16)f2bf(-kn); o[320] = (bf16)f2bf(kn * a);
                }
            }
        }
        __syncthreads();
        {
            unsigned char* gd = (unsigned char*)(OPS + ((size_t)(b * BH + hh) * T + t0) * 384);
#pragma unroll
            for (int i = 0; i < 6; ++i) *(v4u*)(gd + (size_t)(tid + 512 * i) * 16) = *(const LAS v4u*)(L + P2_OT + (tid + 512 * i) * 16);
        }
    }
    __syncthreads();
}
__device__ __forceinline__ float allred32(float x) {
    x += __shfl_xor(x, 1); x += __shfl_xor(x, 2); x += __shfl_xor(x, 4); x += __shfl_xor(x, 8); x += __shfl_xor(x, 16);
    return x;
}
__device__ __forceinline__ void rwkv_scan_simple(Frame& F, int unit) {
    const int bh = unit >> 2, qt = unit & 3, b = bh / BH, h = bh % BH;
    const int row = 16 * qt + 2 * F.wave + (F.lane >> 5), kp = F.lane & 31;
    const unsigned* op = (const unsigned*)(F.ws + WS_OPS) + (size_t)bh * T * 192;
    unsigned char* yb = F.ws + WS_PB + (size_t)b * T * (PB_LD * 2) + (size_t)(h * 64 + row) * 4;
    float s0 = 0.f, s1 = 0.f, ykeep = 0.f;
    for (int t0 = 0; t0 < T; t0 += 32) {
#pragma unroll 4
        for (int tt = 0; tt < 32; ++tt) {
            const unsigned* o = op + (size_t)(t0 + tt) * 192;
            const unsigned ur = o[kp], udw = o[32 + kp], uk = o[64 + kp], ua = o[128 + kp], ub = o[160 + kp];
            const float vv = bf2f(((const unsigned short*)(o + 96))[row]);
            const float sa = allred32(s0 * bflo(ua) + s1 * bfhi(ua));
            s0 = s0 * (1.f - bflo(udw)) + (sa * bflo(ub) + vv * bflo(uk));
            s1 = s1 * (1.f - bfhi(udw)) + (sa * bfhi(ub) + vv * bfhi(uk));
            const float y = allred32(s0 * bflo(ur) + s1 * bfhi(ur));
            if (kp == tt) ykeep = y;
        }
        *(float*)(yb + (size_t)(t0 + kp) * (PB_LD * 2)) = ykeep;
    }
}

__device__ __forceinline__ float allred32_dpp(float x) {
    x += dppx<0xB1>(x); x += dppx<0x4E>(x); x += dppx<0x141>(x); x += dppx<0x140>(x);
    const unsigned u = __float_as_uint(x);
    auto r = __builtin_amdgcn_permlane16_swap(u, u, false, false);
    const unsigned r0 = r[0], r1 = r[1];
    return __uint_as_float(r0) + __uint_as_float(r1);
}
constexpr int SC_CH = 32, SC_VEC = (SC_CH / 2) * 512, SC_VOFF = 5 * SC_VEC, SC_BUF = SC_VOFF + (SC_CH / 2) * 128;
typedef float f32x2g __attribute__((ext_vector_type(2)));
__device__ __forceinline__ void scan_write_chunk(LAS unsigned char* Lb, const v4u (&st)[3], int tid, int qt) {
#pragma unroll
    for (int i = 0; i < 3; ++i) {
        const int p = tid + 512 * i, step = p / 48, q = p - step * 48, vec = q >> 3, e0 = (q & 7) * 8;
        float f[8] = {bflo(st[i].x), bfhi(st[i].x), bflo(st[i].y), bfhi(st[i].y), bflo(st[i].z), bfhi(st[i].z), bflo(st[i].w), bfhi(st[i].w)};
        if (vec == 1) {
#pragma unroll
            for (int j = 0; j < 8; ++j) f[j] = 1.0f - f[j];
        }
        const int slot = (0x207314 >> (4 * vec)) & 7;
        if (vec != 3) {
            LAS unsigned char* d = Lb + slot * SC_VEC + (step >> 1) * 512 + (e0 >> 1) * 16 + (step & 1) * 8;
#pragma unroll
            for (int j = 0; j < 4; ++j) *(LAS f32x2g*)(d + j * 16) = (f32x2g){f[2 * j], f[2 * j + 1]};
        } else if ((e0 >> 4) == qt) {
            LAS unsigned char* d = Lb + SC_VOFF + (step >> 1) * 128 + (e0 & 15) * 8 + (step & 1) * 4;
#pragma unroll
            for (int j = 0; j < 8; ++j) *(LAS float*)(d + j * 8) = f[j];
        }
    }
}
__device__ __forceinline__ void rwkv_scan_lds(Frame& F, int unit) {
    const int bh = unit >> 2, qt = unit & 3, b = bh / BH, h = bh % BH;
    const int half = F.lane >> 5, kp = F.lane & 31, rloc = 2 * F.wave + half, row = 16 * qt + rloc;
    LAS unsigned char* L = F.lds + RING_OFF;
    const unsigned char* ops = F.ws + WS_OPS + (size_t)bh * T * 768;
    unsigned char* yb = F.ws + WS_PB + (size_t)b * T * (PB_LD * 2) + (size_t)(h * 64 + row) * 4;
    v4u st[3];
    __syncthreads();
#pragma unroll
    for (int i = 0; i < 3; ++i) st[i] = *(const v4u*)(ops + (size_t)(F.tid + 512 * i) * 16);
    scan_write_chunk(L, st, F.tid, qt);
    __syncthreads();
    float s0 = 0.f, s1 = 0.f;
    constexpr int NCH = T / SC_CH;
    for (int c = 0; c < NCH; ++c) {
        if (c + 1 < NCH) {
#pragma unroll
            for (int i = 0; i < 3; ++i) st[i] = *(const v4u*)(ops + (size_t)(c + 1) * (SC_CH * 768) + (size_t)(F.tid + 512 * i) * 16);
        }
        const LAS unsigned char* Lb = L + (c & 1) * SC_BUF + kp * 16;
        const LAS unsigned char* Lv = L + (c & 1) * SC_BUF + SC_VOFF + rloc * 8;
        float ykeep = 0.f;
#pragma unroll
        for (int tp = 0; tp < SC_CH / 2; ++tp) {
            const f32x4 a4 = *(const LAS f32x4*)(Lb + tp * 512), w4 = *(const LAS f32x4*)(Lb + SC_VEC + tp * 512), b4 = *(const LAS f32x4*)(Lb + 2 * SC_VEC + tp * 512),
                        k4 = *(const LAS f32x4*)(Lb + 3 * SC_VEC + tp * 512), r4 = *(const LAS f32x4*)(Lb + 4 * SC_VEC + tp * 512);
            const f32x2g v2 = *(const LAS f32x2g*)(Lv + tp * 128);
            {   const float sa = allred32_dpp(s0 * a4.x + s1 * a4.y);
                s0 = s0 * w4.x + (sa * b4.x + v2.x * k4.x);
                s1 = s1 * w4.y + (sa * b4.y + v2.x * k4.y);
                const float y = allred32_dpp(s0 * r4.x + s1 * r4.y);
                if (kp == 2 * tp) ykeep = y; }
            {   const float sa = allred32_dpp(s0 * a4.z + s1 * a4.w);
                s0 = s0 * w4.z + (sa * b4.z + v2.y * k4.z);
                s1 = s1 * w4.w + (sa * b4.w + v2.y * k4.w);
                const float y = allred32_dpp(s0 * r4.z + s1 * r4.w);
                if (kp == 2 * tp + 1) ykeep = y; }
        }
        *(float*)(yb + (size_t)(c * SC_CH + kp) * (PB_LD * 2)) = ykeep;
        if (c + 1 < NCH) scan_write_chunk(L + ((c + 1) & 1) * SC_BUF, st, F.tid, qt);
        __syncthreads();
    }
}

constexpr int CK_ST = 144;
constexpr int CK_SLOT = 64 * CK_ST;
#define CK_SL(i) ((i) * CK_SLOT)
constexpr int CK_NF = 14 * CK_SLOT;
constexpr int CK_G63 = CK_NF + 4096;
constexpr int CK_GT = CK_G63 + 256;
static_assert(23808 + CK_GT + 2048 <= RING_BYTES, "fused rwkv LDS");
__device__ __forceinline__ void mm64(f32x4m (&acc)[2], const LAS unsigned char* X, const LAS unsigned char* YT, int tr, int tc0, int lc, int lq) {
#pragma unroll
    for (int ks = 0; ks < 2; ++ks) {
        const bf16x8 a = *(const LAS bf16x8*)(X + (16 * tr + lc) * CK_ST + (32 * ks + 8 * lq) * 2);
#pragma unroll
        for (int j = 0; j < 2; ++j) {
            const bf16x8 b = *(const LAS bf16x8*)(YT + (16 * (tc0 + j) + lc) * CK_ST + (32 * ks + 8 * lq) * 2);
            acc[j] = __builtin_amdgcn_mfma_f32_16x16x32_bf16(a, b, acc[j], 0, 0, 0);
        }
    }
}
__device__ __forceinline__ void ldA(bf16x8 (&a)[2], const LAS unsigned char* X, int tr, int lc, int lq) {
#pragma unroll
    for (int ks = 0; ks < 2; ++ks) a[ks] = *(const LAS bf16x8*)(X + (16 * tr + lc) * CK_ST + (32 * ks + 8 * lq) * 2);
}
__device__ __forceinline__ void ldB(bf16x8 (&b)[2][2], const LAS unsigned char* YT, int tc0, int lc, int lq) {
#pragma unroll
    for (int j = 0; j < 2; ++j)
#pragma unroll
        for (int ks = 0; ks < 2; ++ks) b[j][ks] = *(const LAS bf16x8*)(YT + (16 * (tc0 + j) + lc) * CK_ST + (32 * ks + 8 * lq) * 2);
}
__device__ __forceinline__ void mmr(f32x4m (&acc)[2], const bf16x8 (&a)[2], const bf16x8 (&b)[2][2]) {
#pragma unroll
    for (int ks = 0; ks < 2; ++ks)
#pragma unroll
        for (int j = 0; j < 2; ++j) acc[j] = __builtin_amdgcn_mfma_f32_16x16x32_bf16(a[ks], b[j][ks], acc[j], 0, 0, 0);
}
__device__ __forceinline__ void st_rm(LAS unsigned char* B, const f32x4m (&acc)[2], int tr, int tc0, int lc, int lq) {
#pragma unroll
    for (int j = 0; j < 2; ++j)
#pragma unroll
        for (int r = 0; r < 4; ++r) *(LAS bf16*)(B + (16 * tr + 4 * lq + r) * CK_ST + (16 * (tc0 + j) + lc) * 2) = (bf16)f2bf(acc[j][r]);
}
__device__ __forceinline__ void st_tr(LAS unsigned char* B, const f32x4m (&acc)[2], int tr, int tc0, int lc, int lq) {
#pragma unroll
    for (int j = 0; j < 2; ++j) *(LAS unsigned long long*)(B + (16 * (tc0 + j) + lc) * CK_ST + (16 * tr + 4 * lq) * 2) =
        (unsigned long long)pk2(acc[j][0], acc[j][1]) | ((unsigned long long)pk2(acc[j][2], acc[j][3]) << 32);
}
__device__ __forceinline__ void st_gtr(bf16* Gm, const f32x4m (&acc)[2], int tr, int tc0, int lc, int lq) {
#pragma unroll
    for (int j = 0; j < 2; ++j) *(unsigned long long*)(Gm + (16 * (tc0 + j) + lc) * 64 + 16 * tr + 4 * lq) =
        (unsigned long long)pk2(acc[j][0], acc[j][1]) | ((unsigned long long)pk2(acc[j][2], acc[j][3]) << 32);
}
#define CK_ZERO(acc) do { acc[0] = (f32x4m){0.f, 0.f, 0.f, 0.f}; acc[1] = acc[0]; } while (0)
constexpr int FZ_CB = 23808;
constexpr int FZ_XS = FZ_CB, FZ_A3 = FZ_CB, FZ_OT = FZ_CB + 8 * 9216;
template <int layer> __device__ __forceinline__ void rwkv_fused_tile(Frame& F, const Args& A, int tile) {
    LAS unsigned char* L = F.lds + RING_OFF;
    const bf16* PB = (const bf16*)(F.ws + WS_PB);
    const bf16* VFr = (const bf16*)(F.ws + WS_VF);
    const bf16* LW = (const bf16*)(F.ws + WS_LORA);
    const float* mu = A.in[9] + layer * BSHIFT;
    const int tid = opaque_i(F.tid), lane = tid & 63, wid = F.wave, lc = lane & 15, lq = lane >> 4;
    const int tr = wid >> 1, tc0 = 2 * (wid & 1);
    const size_t m0 = (size_t)tile * 64;
    const int b = (int)(m0 / T), t0 = (int)(m0 % T);
    {
        const int tt = tid >> 3, cg = tid & 7;
        const bool hasp = (t0 + tt) != 0;
        const bf16* pc = PB + (m0 + tt) * PB_LD; const bf16* pp = pc - PB_LD;
        {   const int c0 = 1152 + 16 * cg;
            unsigned outw[8];
#pragma unroll
            for (int i = 0; i < 2; ++i) {
                const v4u c = *(const v4u*)(pc + c0 + 8 * i); v4u p = (v4u){0u, 0u, 0u, 0u}; if (hasp) p = *(const v4u*)(pp + c0 + 8 * i);
                const unsigned cw[4] = {c.x, c.y, c.z, c.w}, pw[4] = {p.x, p.y, p.z, p.w};
#pragma unroll
                for (int e = 0; e < 4; ++e) {
                    const int col = c0 + 8 * i + 2 * e;
                    float x0 = bflo(cw[e]), x1 = bfhi(cw[e]);
                    x0 = x0 + (bflo(pw[e]) - x0) * mu[col]; x1 = x1 + (bfhi(pw[e]) - x1) * mu[col + 1];
                    if (cg < 4) { x0 = tanh_fast(x0); x1 = tanh_fast(x1); }
                    outw[4 * i + e] = pk2(x0, x1);
                }
            }
            LAS v4u* d = (LAS v4u*)(L + (cg < 4 ? P2_A1 : P2_A2) + tt * 144 + (cg & 3) * 32);
            d[0] = (v4u){outw[0], outw[1], outw[2], outw[3]}; d[1] = (v4u){outw[4], outw[5], outw[6], outw[7]};
        }
        if (layer) {
#pragma unroll
            for (int i = 0; i < 6; ++i) {
                const int c0 = 768 + 48 * cg + 8 * i;
                const v4u c = *(const v4u*)(pc + c0); v4u p = (v4u){0u, 0u, 0u, 0u}; if (hasp) p = *(const v4u*)(pp + c0);
                const unsigned cw[4] = {c.x, c.y, c.z, c.w}, pw[4] = {p.x, p.y, p.z, p.w}; unsigned ow[4];
#pragma unroll
                for (int e = 0; e < 4; ++e) { float x0 = bflo(cw[e]), x1 = bfhi(cw[e]);
                    x0 = x0 + (bflo(pw[e]) - x0) * mu[c0 + 2 * e]; x1 = x1 + (bfhi(pw[e]) - x1) * mu[c0 + 2 * e + 1]; ow[e] = pk2(x0, x1); }
                *(LAS v4u*)(L + FZ_A3 + tt * 784 + (48 * cg + 8 * i) * 2) = (v4u){ow[0], ow[1], ow[2], ow[3]};
            }
        }
    }
    __syncthreads();
    if (layer) {
        const int tq = wid >> 1, nt = wid & 1;
        f32x4m acc = {0.f, 0.f, 0.f, 0.f};
#pragma unroll
        for (int ks = 0; ks < 12; ++ks) {
            const bf16x8 a3 = *(const LAS bf16x8*)(L + FZ_A3 + (16 * tq + lc) * 784 + (32 * ks + 8 * lq) * 2);
            const bf16x8 bv = *(const bf16x8*)(LW + LO_V1T + (16 * nt + lc) * 384 + 32 * ks + 8 * lq);
            acc = __builtin_amdgcn_mfma_f32_16x16x32_bf16(a3, bv, acc, 0, 0, 0);
        }
#pragma unroll
        for (int r = 0; r < 4; ++r) *(LAS bf16*)(L + P2_A4 + (16 * tq + 4 * lq + r) * 80 + (16 * nt + lc) * 2) = (bf16)f2bf(acc[r]);
        __syncthreads();
    }
    const float* w0 = A.in[10] + layer * 384; const float* a0 = A.in[12] + layer * 384;
    const float* kkp = A.in[14] + layer * 384; const float* kap = A.in[15] + layer * 384; const float* v0 = A.in[19];
#pragma unroll 1
    for (int hh_ = 0; hh_ < BH; ++hh_) {
        const int hh = __builtin_amdgcn_readfirstlane(opaque_i(hh_));
        bf16x8 fbw[2][2], fba[2][2], fbv[2];
        unsigned short vfr[2][4];
        if (layer) {
#pragma unroll
            for (int j = 0; j < 2; ++j)
#pragma unroll
                for (int r = 0; r < 4; ++r) vfr[j][r] = VFr[((size_t)(b * BH + hh) * T + t0 + 16 * tr + 4 * lq + r) * 64 + 16 * (tc0 + j) + lc];
        }
#pragma unroll
        for (int j = 0; j < 2; ++j) {
            const int col = hh * 64 + 16 * (tc0 + j) + lc;
#pragma unroll
            for (int ks = 0; ks < 2; ++ks) {
                fbw[j][ks] = *(const bf16x8*)(LW + LO_W2T + ((size_t)layer * 384 + col) * 64 + 32 * ks + 8 * lq);
                fba[j][ks] = *(const bf16x8*)(LW + LO_A2T + ((size_t)layer * 384 + col) * 64 + 32 * ks + 8 * lq);
            }
            if (layer) fbv[j] = *(const bf16x8*)(LW + LO_V2T + col * 32 + 8 * lq);
        }
        {
            const int tid1 = opaque_i(tid), tt = tid1 >> 3, cg = tid1 & 7;
            const bool hasp = (t0 + tt) != 0;
            const bf16* pc = PB + (m0 + tt) * PB_LD; const bf16* pp = pc - PB_LD;
            float ss = 0.f;
#pragma unroll
            for (int i = 0; i < 3; ++i) {
                const int c0 = i * 384 + hh * 64 + cg * 8;
                const v4u c = *(const v4u*)(pc + c0); v4u p = (v4u){0u, 0u, 0u, 0u}; if (hasp) p = *(const v4u*)(pp + c0);
                const f32x4m m0v = *(const f32x4m*)(mu + c0), m1v = *(const f32x4m*)(mu + c0 + 4);
                f32x4m x0 = {bflo(c.x), bfhi(c.x), bflo(c.y), bfhi(c.y)}, x1 = {bflo(c.z), bfhi(c.z), bflo(c.w), bfhi(c.w)};
                const f32x4m q0 = {bflo(p.x), bfhi(p.x), bflo(p.y), bfhi(p.y)}, q1 = {bflo(p.z), bfhi(p.z), bflo(p.w), bfhi(p.w)};
                x0 = x0 + (q0 - x0) * m0v; x1 = x1 + (q1 - x1) * m1v;
                LAS f32x4m* d = (LAS f32x4m*)(L + FZ_XS + (i * 64 + tt) * P2_XST + cg * 32);
                d[0] = x0; d[1] = x1;
                if (i == 1) { const f32x4m k0 = *(const f32x4m*)(kkp + hh * 64 + cg * 8), k1 = *(const f32x4m*)(kkp + hh * 64 + cg * 8 + 4);
                    const f32x4m y0 = x0 * k0, y1 = x1 * k1; ss = (y0.x * y0.x + y0.y * y0.y) + (y0.z * y0.z + y0.w * y0.w) + (y1.x * y1.x + y1.y * y1.y) + (y1.z * y1.z + y1.w * y1.w); }
            }
            ss += dppx<0xB1>(ss); ss += dppx<0x4E>(ss); ss += dppx<0x141>(ss);
            if (cg == 0) *(LAS float*)(L + P2_RN + tt * 4) = 1.0f / fmaxf(sqrtf(ss), 1e-12f);
        }
        __syncthreads();
        f32x4m wl[2], al[2], vl[2];
        {
            bf16x8 a1[2], a2f[2];
#pragma unroll
            for (int ks = 0; ks < 2; ++ks) { a1[ks] = *(const LAS bf16x8*)(L + P2_A1 + (16 * tr + lc) * 144 + (32 * ks + 8 * lq) * 2); a2f[ks] = *(const LAS bf16x8*)(L + P2_A2 + (16 * tr + lc) * 144 + (32 * ks + 8 * lq) * 2); }
#pragma unroll
            for (int j = 0; j < 2; ++j) {
                const int col = hh * 64 + 16 * (tc0 + j) + lc;
                wl[j] = (f32x4m){0.f, 0.f, 0.f, 0.f}; al[j] = wl[j]; vl[j] = wl[j];
#pragma unroll
                for (int ks = 0; ks < 2; ++ks) {
                    wl[j] = __builtin_amdgcn_mfma_f32_16x16x32_bf16(a1[ks], fbw[j][ks], wl[j], 0, 0, 0);
                    al[j] = __builtin_amdgcn_mfma_f32_16x16x32_bf16(a2f[ks], fba[j][ks], al[j], 0, 0, 0);
                }
                if (layer) {
                    const bf16x8 a4 = *(const LAS bf16x8*)(L + P2_A4 + (16 * tr + lc) * 80 + 8 * lq * 2);
                    vl[j] = __builtin_amdgcn_mfma_f32_16x16x32_bf16(a4, fbv[j], vl[j], 0, 0, 0);
                }
            }
        }
        {
#pragma unroll
            for (int j = 0; j < 2; ++j) {
                const int cc = 16 * (tc0 + j) + lc, col = hh * 64 + cc;
                const float w0c = w0[col], a0c = a0[col], kkc = kkp[col], kac = kap[col];
                const float v0c = layer ? v0[col] : 0.f;
#pragma unroll
                for (int r = 0; r < 4; ++r) {
                    const int tok = 16 * tr + 4 * lq + r;
                    const float xr = *(const LAS float*)(L + FZ_XS + tok * P2_XST + cc * 4);
                    const float xk = *(const LAS float*)(L + FZ_XS + (64 + tok) * P2_XST + cc * 4);
                    float xv = *(const LAS float*)(L + FZ_XS + (128 + tok) * P2_XST + cc * 4);
                    const float rn = *(const LAS float*)(L + P2_RN + tok * 4);
                    if (layer) xv = xv + (bf2f(vfr[j][r]) - xv) * sigmoid_f(v0c + vl[j][r]);
                    const float ld = -0.60653065971f * sigmoid_f(w0c + wl[j][r]);
                    const float a = sigmoid_f(a0c + al[j][r]);
                    const float kn = xk * kkc * rn;
                    LAS bf16* o = (LAS bf16*)(L + FZ_OT + (tok * 384 + cc) * 2);
                    o[0] = (bf16)f2bf(xr); o[64] = (bf16)f2bf(ld); o[128] = (bf16)f2bf(xk * (1.f + (a - 1.f) * kac)); o[192] = (bf16)f2bf(xv);
                    o[256] = (bf16)f2bf(-kn); o[320] = (bf16)f2bf(kn * a);
                }
            }
        }
        __syncthreads();
        {
        const int bh = b * BH + hh, n = t0 >> 6;
        LAS unsigned char* Lc = L + FZ_CB;
        bf16* CH = (bf16*)(F.ws + WS_CHK) + ((size_t)bh * 128 + n) * (4 * 4096);
        const float* rkp = A.in[16] + layer * 384 + hh * 64;
    {
        const int k = lane, t8 = 8 * wid;
        float av[8], bv[8], kv[8], rv[8], vv[8], lp[8];
        float run = 0.f;
#pragma unroll
        for (int s8 = 0; s8 < 8; ++s8) {
            const LAS bf16* o = (const LAS bf16*)(L + FZ_OT) + (t8 + s8) * 384 + k;
            rv[s8] = bf2f(o[0]); const float ld = bf2f(o[64]); kv[s8] = bf2f(o[128]); vv[s8] = bf2f(o[192]); av[s8] = bf2f(o[256]); bv[s8] = bf2f(o[320]);
            run += ld; lp[s8] = run;
        }
        LAS float* gt = (LAS float*)(Lc + CK_GT);
        gt[wid * 64 + k] = run;
        __syncthreads();
        for (int i = tid; i < 2 * CK_SLOT / 16; i += NTHR) *(LAS v4u*)(Lc + CK_SL(12) + i * 16) = (v4u){0u, 0u, 0u, 0u};
        float off = 0.f, tot = 0.f;
#pragma unroll
        for (int w = 0; w < 8; ++w) { const float g = gt[w * 64 + k]; tot += g; if (w < wid) off += g; }
        if (wid == 0) *(LAS float*)(Lc + CK_G63 + k * 4) = __expf(tot);
        unsigned pa[4], pbc[4], pkc[4], pv[4];
        float a2[8], bc[8], kc[8];
#pragma unroll
        for (int s8 = 0; s8 < 8; ++s8) {
            const int t = t8 + s8;
            const float Lt = off + lp[s8], Lm = (s8 == 0) ? off : off + lp[s8 - 1];
            const float eP = __expf(Lm), eN = __expf(-Lt), eR = __expf(Lt), eC = __expf(tot - Lt);
            a2[s8] = av[s8] * eP; bc[s8] = bv[s8] * eC; kc[s8] = kv[s8] * eC;
            *(LAS bf16*)(Lc + CK_SL(0) + t * CK_ST + k * 2) = (bf16)f2bf(a2[s8]);
            *(LAS bf16*)(Lc + CK_SL(1) + t * CK_ST + k * 2) = (bf16)f2bf(bv[s8] * eN);
            *(LAS bf16*)(Lc + CK_SL(2) + t * CK_ST + k * 2) = (bf16)f2bf(kv[s8] * eN);
            *(LAS bf16*)(Lc + CK_SL(4) + t * CK_ST + k * 2) = (bf16)f2bf(rv[s8] * eR);
        }
#pragma unroll
        for (int i = 0; i < 4; ++i) { pa[i] = pk2(a2[2 * i], a2[2 * i + 1]); pbc[i] = pk2(bc[2 * i], bc[2 * i + 1]); pkc[i] = pk2(kc[2 * i], kc[2 * i + 1]); pv[i] = pk2(vv[2 * i], vv[2 * i + 1]); }
        *(LAS v4u*)(Lc + CK_SL(3) + k * CK_ST + t8 * 2) = (v4u){pa[0], pa[1], pa[2], pa[3]};
        *(LAS v4u*)(Lc + CK_SL(5) + k * CK_ST + t8 * 2) = (v4u){pbc[0], pbc[1], pbc[2], pbc[3]};
        *(LAS v4u*)(Lc + CK_SL(6) + k * CK_ST + t8 * 2) = (v4u){pkc[0], pkc[1], pkc[2], pkc[3]};
        *(LAS v4u*)(Lc + CK_SL(7) + k * CK_ST + t8 * 2) = (v4u){pv[0], pv[1], pv[2], pv[3]};
        {
            const float rkc = rkp[k];
            bf16* bvg = (bf16*)(F.ws + WS_BV) + ((size_t)bh * T + (size_t)n * 64 + t8) * 64 + k;
            bf16* vfg = (bf16*)(F.ws + WS_VF) + ((size_t)bh * T + (size_t)n * 64 + t8) * 64 + k;
#pragma unroll
            for (int s8 = 0; s8 < 8; ++s8) {
                float bon = rv[s8] * kv[s8] * rkc;
                bon = rowred16(bon);
                { const unsigned u_ = __float_as_uint(bon); auto r_ = __builtin_amdgcn_permlane16_swap(u_, u_, false, false); const unsigned a_ = r_[0], b_ = r_[1]; bon = __uint_as_float(a_) + __uint_as_float(b_); }
                { const unsigned u_ = __float_as_uint(bon); auto r_ = __builtin_amdgcn_permlane32_swap(u_, u_, false, false); const unsigned a_ = r_[0], b_ = r_[1]; bon = __uint_as_float(a_) + __uint_as_float(b_); }
                bvg[s8 * 64] = (bf16)f2bf(bon * vv[s8]);
                if (layer == 0) vfg[s8 * 64] = (bf16)f2bf(vv[s8]);
            }
        }
    }
    __syncthreads();
    {
        bf16x8 xb[2], xk[2], ya[2][2], yr[2][2];
        ldA(xb, Lc + CK_SL(1), tr, lc, lq); ldA(xk, Lc + CK_SL(2), tr, lc, lq); ldB(ya, Lc + CK_SL(0), tc0, lc, lq); ldB(yr, Lc + CK_SL(4), tc0, lc, lq);
        f32x4m mab[2], mak[2], nbr[2], nkr[2];
        CK_ZERO(mab); CK_ZERO(mak); CK_ZERO(nbr); CK_ZERO(nkr);
        mmr(mab, xb, ya); mmr(mak, xk, ya); mmr(nbr, xb, yr); mmr(nkr, xk, yr);
#pragma unroll
        for (int j = 0; j < 2; ++j)
#pragma unroll
            for (int r = 0; r < 4; ++r) {
                const int i = 16 * tr + 4 * lq + r, t = 16 * (tc0 + j) + lc;
                if (!(i < t)) { mab[j][r] = 0.f; mak[j][r] = 0.f; }
                if (!(i <= t)) { nbr[j][r] = 0.f; nkr[j][r] = 0.f; }
            }
#pragma unroll
        for (int j = 0; j < 2; ++j) if (tr == tc0 + j) {
#pragma unroll
            for (int r = 0; r < 4; ++r) { *(LAS float*)(Lc + CK_NF + tr * 1024 + (4 * lq + r) * 64 + lc * 4) = mab[j][r]; mab[j][r] = 0.f; }
        }
        st_tr(Lc + CK_SL(8), mab, tr, tc0, lc, lq);
        st_rm(Lc + CK_SL(9), mak, tr, tc0, lc, lq);
        st_tr(Lc + CK_SL(10), nbr, tr, tc0, lc, lq);
        st_tr(Lc + CK_SL(11), nkr, tr, tc0, lc, lq);
    }
    __syncthreads();
    {
        const int bl = lane >> 4, i = lane & 15;
        const LAS f32x4m* Nb = (const LAS f32x4m*)(Lc + CK_NF + bl * 1024 + i * 64);
        const f32x4m n0 = Nb[0], n1 = Nb[1], n2 = Nb[2], n3 = Nb[3];
        const float Nrow[16] = {n0[0], n0[1], n0[2], n0[3], n1[0], n1[1], n1[2], n1[3], n2[0], n2[1], n2[2], n2[3], n3[0], n3[1], n3[2], n3[3]};
        float Tr[16];
#define S2_T(t) do { float s0_ = (i == (t)) ? 1.f : 0.f, s1_ = 0.f; float nt_ = Nrow[t]; if ((t) > 0) asm volatile("" : "+v"(nt_) : "v"(Tr[(t) > 0 ? (t) - 1 : 0])); \
            S2_J(t, 0) S2_J(t, 1) S2_J(t, 2) S2_J(t, 3) S2_J(t, 4) S2_J(t, 5) S2_J(t, 6) S2_J(t, 7) S2_J(t, 8) S2_J(t, 9) S2_J(t, 10) S2_J(t, 11) S2_J(t, 12) S2_J(t, 13) S2_J(t, 14) \
            Tr[t] = s0_ + s1_; __builtin_amdgcn_sched_barrier(0); } while (0)
#define S2_J(t, j) if ((j) < (t)) { const float nb_ = __int_as_float(__builtin_amdgcn_update_dpp(0, __float_as_int(nt_), 0x150 + (j), 0xf, 0xf, true)); if ((j) & 1) s1_ += Tr[j] * nb_; else s0_ += Tr[j] * nb_; }
        S2_T(0); S2_T(1); S2_T(2); S2_T(3); S2_T(4); S2_T(5); S2_T(6); S2_T(7); S2_T(8); S2_T(9); S2_T(10); S2_T(11); S2_T(12); S2_T(13); S2_T(14); S2_T(15);
#undef S2_T
#undef S2_J
        unsigned w[8];
#pragma unroll
        for (int q = 0; q < 8; ++q) w[q] = pk2(Tr[2 * q], Tr[2 * q + 1]);
        if (wid == 0) {
        LAS unsigned char* d = Lc + CK_SL(12) + (16 * bl + i) * CK_ST + 16 * bl * 2;
        *(LAS v4u*)d = (v4u){w[0], w[1], w[2], w[3]}; *(LAS v4u*)(d + 16) = (v4u){w[4], w[5], w[6], w[7]};
#pragma unroll
        for (int t = 0; t < 16; ++t) *(LAS bf16*)(Lc + CK_SL(13) + (16 * bl + t) * CK_ST + (16 * bl + i) * 2) = (bf16)f2bf(Tr[t]);
        }
    }
    __syncthreads();
    f32x4m e1[2];
    {
        bf16x8 xa[2], yb[2][2]; ldA(xa, Lc + CK_SL(12), tr, lc, lq); ldB(yb, Lc + CK_SL(8), tc0, lc, lq);
        CK_ZERO(e1); mmr(e1, xa, yb);
        st_rm(Lc + CK_SL(0), e1, tr, tc0, lc, lq);
        st_tr(Lc + CK_SL(1), e1, tr, tc0, lc, lq);
    }
    __syncthreads();
    f32x4m e2[2];
    {
        bf16x8 xa[2], yb[2][2]; ldA(xa, Lc + CK_SL(0), tr, lc, lq); ldB(yb, Lc + CK_SL(1), tc0, lc, lq);
        CK_ZERO(e2); mmr(e2, xa, yb);
        st_tr(Lc + CK_SL(2), e2, tr, tc0, lc, lq);
    }
    __syncthreads();
    {
        bf16x8 xa[2], yb[2][2]; ldA(xa, Lc + CK_SL(0), tr, lc, lq); ldB(yb, Lc + CK_SL(2), tc0, lc, lq);
        f32x4m f[2]; CK_ZERO(f); mmr(f, xa, yb);
#pragma unroll
        for (int j = 0; j < 2; ++j)
#pragma unroll
            for (int r = 0; r < 4; ++r) { const int i = 16 * tr + 4 * lq + r, t = 16 * (tc0 + j) + lc; f[j][r] += e1[j][r] + e2[j][r] + ((i == t) ? 1.f : 0.f); }
        st_rm(Lc + CK_SL(8), f, tr, tc0, lc, lq);
    }
    __syncthreads();
    {
        bf16x8 xa[2], yb[2][2]; ldA(xa, Lc + CK_SL(8), tr, lc, lq); ldB(yb, Lc + CK_SL(13), tc0, lc, lq);
        f32x4m tt[2]; CK_ZERO(tt); mmr(tt, xa, yb);
        st_tr(Lc + CK_SL(12), tt, tr, tc0, lc, lq);
    }
    __syncthreads();
    {
        bf16x8 xa[2], xm[2], yb[2][2]; ldA(xa, Lc + CK_SL(3), tr, lc, lq); ldA(xm, Lc + CK_SL(9), tr, lc, lq); ldB(yb, Lc + CK_SL(12), tc0, lc, lq);
        f32x4m p1[2], w2[2]; CK_ZERO(p1); CK_ZERO(w2);
        mmr(p1, xa, yb); mmr(w2, xm, yb);
        st_rm(Lc + CK_SL(13), p1, tr, tc0, lc, lq);
        __syncthreads();
        st_tr(Lc + CK_SL(9), w2, tr, tc0, lc, lq);
    }
    __syncthreads();
    {
        bf16x8 xv[2], xp[2], yw[2][2], yc[2][2], yn[2][2];
        ldA(xv, Lc + CK_SL(7), tr, lc, lq); ldA(xp, Lc + CK_SL(13), tr, lc, lq); ldB(yw, Lc + CK_SL(9), tc0, lc, lq); ldB(yc, Lc + CK_SL(5), tc0, lc, lq); ldB(yn, Lc + CK_SL(10), tc0, lc, lq);
        f32x4m ub[2], g[2], rh[2]; CK_ZERO(ub); CK_ZERO(g); CK_ZERO(rh);
        mmr(ub, xv, yw); mmr(g, xp, yc); mmr(rh, xp, yn);
#pragma unroll
        for (int j = 0; j < 2; ++j)
#pragma unroll
            for (int r = 0; r < 4; ++r) { const int row = 16 * tr + 4 * lq + r, col = 16 * (tc0 + j) + lc;
                if (row == col) g[j][r] += *(const LAS float*)(Lc + CK_G63 + row * 4);
                rh[j][r] += bf2f(*(const LAS bf16*)(Lc + CK_SL(4) + col * CK_ST + row * 2)); }
        st_gtr(CH + 0 * 4096, g, tr, tc0, lc, lq);
        st_gtr(CH + 2 * 4096, rh, tr, tc0, lc, lq);
        st_rm(Lc + CK_SL(3), ub, tr, tc0, lc, lq);
    }
    __syncthreads();
    {
        bf16x8 xu[2], xv[2], yc[2][2], yk[2][2], yn[2][2], ym[2][2];
        ldA(xu, Lc + CK_SL(3), tr, lc, lq); ldA(xv, Lc + CK_SL(7), tr, lc, lq);
        ldB(yc, Lc + CK_SL(5), tc0, lc, lq); ldB(yk, Lc + CK_SL(6), tc0, lc, lq); ldB(yn, Lc + CK_SL(10), tc0, lc, lq); ldB(ym, Lc + CK_SL(11), tc0, lc, lq);
        f32x4m h[2], y0[2]; CK_ZERO(h); CK_ZERO(y0);
        mmr(h, xu, yc); mmr(h, xv, yk); mmr(y0, xu, yn); mmr(y0, xv, ym);
        st_gtr(CH + 1 * 4096, h, tr, tc0, lc, lq);
        st_gtr(CH + 3 * 4096, y0, tr, tc0, lc, lq);
    }
    __syncthreads();
        }
    }
}
__device__ __forceinline__ void chunk_chain(Frame& F, int unit) {
    LAS unsigned char* L = F.lds + RING_OFF;
    const int bh = unit >> 2, rq = unit & 3;
    const int tid = opaque_i(F.tid), lane = tid & 63, wid = F.wave, lc = lane & 15, lq = lane >> 4;
    const int tc = wid & 3; const bool act = wid < 4;
    const bf16* CHb = (const bf16*)(F.ws + WS_CHK) + (size_t)bh * 128 * (4 * 4096);
    bf16* SS = (bf16*)(F.ws + WS_SST) + (size_t)bh * 128 * 4096 + (size_t)(16 * rq) * 64;
    if (tid < 144) *(LAS v4u*)(L + tid * 16) = (v4u){0u, 0u, 0u, 0u};
    __syncthreads();
#define CC_LOAD(GF, HF, nn) do { const bf16* CH_ = CHb + (size_t)((nn) < 128 ? (nn) : 127) * (4 * 4096); \
        _Pragma("unroll") for (int ks = 0; ks < 2; ++ks) GF[ks] = *(const bf16x8*)(CH_ + 0 * 4096 + (16 * tc + lc) * 64 + 32 * ks + 8 * lq); \
        HF = *(const unsigned long long*)(CH_ + 1 * 4096 + (16 * tc + lc) * 64 + 16 * rq + 4 * lq); } while (0)
#define CC_STEP(GF, HF, nn) do { \
        if (tid < 128) { const v4u sv = *(const LAS v4u*)(L + (tid >> 3) * CK_ST + (tid & 7) * 16); *(v4u*)(SS + (size_t)(nn) * 4096 + (tid >> 3) * 64 + (tid & 7) * 8) = sv; } \
        f32x4m sn; { const unsigned h0 = (unsigned)HF, h1 = (unsigned)(HF >> 32); sn = (f32x4m){bflo(h0), bfhi(h0), bflo(h1), bfhi(h1)}; } \
        _Pragma("unroll") for (int ks = 0; ks < 2; ++ks) { \
            const bf16x8 a = *(const LAS bf16x8*)(L + lc * CK_ST + (32 * ks + 8 * lq) * 2); \
            sn = __builtin_amdgcn_mfma_f32_16x16x32_bf16(a, GF[ks], sn, 0, 0, 0); } \
        CC_LOAD(GF, HF, (nn) + 8); \
        __syncthreads(); \
        if (act) { _Pragma("unroll") for (int r = 0; r < 4; ++r) *(LAS bf16*)(L + (4 * lq + r) * CK_ST + (16 * tc + lc) * 2) = (bf16)f2bf(sn[r]); } \
        __syncthreads(); } while (0)
    bf16x8 g0[2], g1[2], g2[2], g3[2], g4[2], g5[2], g6[2], g7[2]; unsigned long long h0_, h1_, h2_, h3_, h4_, h5_, h6_, h7_;
    CC_LOAD(g0, h0_, 0); CC_LOAD(g1, h1_, 1); CC_LOAD(g2, h2_, 2); CC_LOAD(g3, h3_, 3); CC_LOAD(g4, h4_, 4); CC_LOAD(g5, h5_, 5); CC_LOAD(g6, h6_, 6); CC_LOAD(g7, h7_, 7);
    for (int n = 0; n < 128; n += 8) {
        CC_STEP(g0, h0_, n); CC_STEP(g1, h1_, n + 1); CC_STEP(g2, h2_, n + 2); CC_STEP(g3, h3_, n + 3);
        CC_STEP(g4, h4_, n + 4); CC_STEP(g5, h5_, n + 5); CC_STEP(g6, h6_, n + 6); CC_STEP(g7, h7_, n + 7);
    }
#undef CC_LOAD
#undef CC_STEP
}
__device__ __forceinline__ void chunk_ypost(Frame& F, const Args& A, int layer) {
    const int lane = opaque_i(F.lane), lc = lane & 15, lq = lane >> 4;
    bf16* Y = (bf16*)(F.ws + WS_XN);
    const float* rk = A.in[16] + layer * 384; const float* lg = A.in[17] + layer * 384; const float* lb = A.in[18] + layer * 384;
    const int gw = F.vcu * NWAVES + F.wave, NGW = F.G * NWAVES;
    for (int it = gw; it < 48 * 128 * 4; it += NGW) {
        const int tc = it & 3, n = (it >> 2) & 127, bh = it >> 9, b = bh / BH, h = bh % BH;
        const bf16* CH = (const bf16*)(F.ws + WS_CHK) + ((size_t)bh * 128 + n) * (4 * 4096);
        const bf16* SS = (const bf16*)(F.ws + WS_SST) + ((size_t)bh * 128 + n) * 4096;
        const int tok = n * 64 + 16 * tc + lc; const size_t m = (size_t)b * T + tok;
        bf16x8 rf[2];
#pragma unroll
        for (int ks = 0; ks < 2; ++ks) rf[ks] = *(const bf16x8*)(CH + 2 * 4096 + (16 * tc + lc) * 64 + 32 * ks + 8 * lq);
        f32x4m acc[4];
#pragma unroll
        for (int tr = 0; tr < 4; ++tr) {
            const unsigned long long yf = *(const unsigned long long*)(CH + 3 * 4096 + (16 * tc + lc) * 64 + 16 * tr + 4 * lq);
            const unsigned y0 = (unsigned)yf, y1 = (unsigned)(yf >> 32);
            acc[tr] = (f32x4m){bflo(y0), bfhi(y0), bflo(y1), bfhi(y1)};
#pragma unroll
            for (int ks = 0; ks < 2; ++ks) {
                const bf16x8 a = *(const bf16x8*)(SS + (16 * tr + lc) * 64 + 32 * ks + 8 * lq);
                acc[tr] = __builtin_amdgcn_mfma_f32_16x16x32_bf16(a, rf[ks], acc[tr], 0, 0, 0);
            }
        }
        const bf16* bvp = (const bf16*)(F.ws + WS_BV) + ((size_t)bh * T + tok) * 64;
        float s1 = 0.f;
#pragma unroll
        for (int tr = 0; tr < 4; ++tr) s1 += (acc[tr][0] + acc[tr][1]) + (acc[tr][2] + acc[tr][3]);
#define RED4(x) do { { const unsigned u_ = __float_as_uint(x); auto r_ = __builtin_amdgcn_permlane16_swap(u_, u_, false, false); const unsigned a_ = r_[0], b_ = r_[1]; x = __uint_as_float(a_) + __uint_as_float(b_); } \
                     { const unsigned u_ = __float_as_uint(x); auto r_ = __builtin_amdgcn_permlane32_swap(u_, u_, false, false); const unsigned a_ = r_[0], b_ = r_[1]; x = __uint_as_float(a_) + __uint_as_float(b_); } } while (0)
        RED4(s1);
        const float mean = s1 * (1.f / 64.f); float q = 0.f;
#pragma unroll
        for (int tr = 0; tr < 4; ++tr)
#pragma unroll
            for (int r = 0; r < 4; ++r) { acc[tr][r] -= mean; q += acc[tr][r] * acc[tr][r]; }
        RED4(q);
#undef RED4
        const float rstd = 1.f / sqrtf(q * (1.f / 64.f) + GN_EPS);
        const unsigned char* prow = F.ws + WS_PB + m * (PB_LD * 2);
#pragma unroll
        for (int tr = 0; tr < 4; ++tr) {
            const int v0 = 16 * tr + 4 * lq;
            const unsigned long long uv = *(const unsigned long long*)(bvp + v0), ug = *(const unsigned long long*)(prow + (1280 + h * 64 + v0) * 2);
            const float vv[4] = {bflo((unsigned)uv), bfhi((unsigned)uv), bflo((unsigned)(uv >> 32)), bfhi((unsigned)(uv >> 32))};
            const float gg[4] = {bflo((unsigned)ug), bfhi((unsigned)ug), bflo((unsigned)(ug >> 32)), bfhi((unsigned)(ug >> 32))};
            const f32x4m lgv = *(const f32x4m*)(lg + h * 64 + v0), lbv = *(const f32x4m*)(lb + h * 64 + v0);
            float o[4];
#pragma unroll
            for (int r = 0; r < 4; ++r) o[r] = silu_f(gg[r]) * (acc[tr][r] * rstd * lgv[r] + lbv[r] + vv[r]);
            *(unsigned long long*)(Y + m * D + 256 + h * 64 + v0) = (unsigned long long)pk2(o[0], o[1]) | ((unsigned long long)pk2(o[2], o[3]) << 32);
        }
    }
}
__device__ __forceinline__ void rwkv_post_simple(Frame& F, const Args& A, int layer) {
    const unsigned char* PBb = F.ws + WS_PB;
    const bf16* OPS = (const bf16*)(F.ws + WS_OPS);
    bf16* Y = (bf16*)(F.ws + WS_XN);
    const float* rk = A.in[16] + layer * 384; const float* lg = A.in[17] + layer * 384; const float* lb = A.in[18] + layer * 384;
    const int sub = F.lane & 7;
    const long ngrp = (long)M * BH;
    for (long gi = ((long)F.vcu * NTHR + F.tid) >> 3; gi < ngrp; gi += ((long)F.G * NTHR) >> 3) {
        const int m = (int)(gi / BH), h = (int)(gi % BH), t = m % T, b = m / T;
        const unsigned char* prow = PBb + (size_t)m * (PB_LD * 2);
        const f32x4 y0 = *(const f32x4*)(prow + (h * 64 + sub * 8) * 4), y1 = *(const f32x4*)(prow + (h * 64 + sub * 8) * 4 + 16);
        float y[8] = {y0.x, y0.y, y0.z, y0.w, y1.x, y1.y, y1.z, y1.w};
        const size_t oidx = ((size_t)(b * BH + h) * T + t) * 384 + sub * 8;
        const v4u ur = *(const v4u*)(OPS + oidx), uk = *(const v4u*)(OPS + oidx + 128), uv = *(const v4u*)(OPS + oidx + 192);
        const v4u ug = *(const v4u*)(prow + (1280 + h * 64 + sub * 8) * 2);
        float r[8] = {bflo(ur.x), bfhi(ur.x), bflo(ur.y), bfhi(ur.y), bflo(ur.z), bfhi(ur.z), bflo(ur.w), bfhi(ur.w)};
        float k[8] = {bflo(uk.x), bfhi(uk.x), bflo(uk.y), bfhi(uk.y), bflo(uk.z), bfhi(uk.z), bflo(uk.w), bfhi(uk.w)};
        float v[8] = {bflo(uv.x), bfhi(uv.x), bflo(uv.y), bfhi(uv.y), bflo(uv.z), bfhi(uv.z), bflo(uv.w), bfhi(uv.w)};
        float g[8] = {bflo(ug.x), bfhi(ug.x), bflo(ug.y), bfhi(ug.y), bflo(ug.z), bfhi(ug.z), bflo(ug.w), bfhi(ug.w)};
        float s = 0.f, bon = 0.f;
#pragma unroll
        for (int i = 0; i < 8; ++i) { s += y[i]; bon += r[i] * k[i] * rk[h * 64 + sub * 8 + i]; }
        s += __shfl_xor(s, 1); s += __shfl_xor(s, 2); s += __shfl_xor(s, 4);
        bon += __shfl_xor(bon, 1); bon += __shfl_xor(bon, 2); bon += __shfl_xor(bon, 4);
        const float mean = s * (1.f / 64.f); float q = 0.f;
#pragma unroll
        for (int i = 0; i < 8; ++i) { y[i] -= mean; q += y[i] * y[i]; }
        q += __shfl_xor(q, 1); q += __shfl_xor(q, 2); q += __shfl_xor(q, 4);
        const float rstd = 1.f / sqrtf(q * (1.f / 64.f) + GN_EPS);
        float o[8];
#pragma unroll
        for (int i = 0; i < 8; ++i) { const int c = h * 64 + sub * 8 + i; o[i] = silu_f(g[i]) * (y[i] * rstd * lg[c] + lb[c] + bon * v[i]); }
        v4u w; w.x = pk2(o[0], o[1]); w.y = pk2(o[2], o[3]); w.z = pk2(o[4], o[5]); w.w = pk2(o[6], o[7]);
        *(v4u*)(Y + (size_t)m * D + 256 + h * 64 + sub * 8) = w;
    }
}


#ifndef USE_CHUNKED
#define USE_CHUNKED 1
#endif
#ifndef REP_PREP
#define REP_PREP 1
#endif
#ifndef REP_CHAIN
#define REP_CHAIN 1
#endif
#define IN(k) (lo <= (k) && (k) < hi)
#define SEAM(k) do { if (IN(k) && IN((k) + 1)) xcd_barrier(bar); } while (0)
template <int layer> __device__ __forceinline__ void layer_phases(Frame& F, const Args& args, const int lo, const int hi, const XcdBarrier& bar) {
    constexpr int pb = 1 + 6 * layer;
    const float* mod = (const float*)(F.ws + WS_CTL) + CW_MOD + (size_t)layer * 8 * 3072;
    if (IN(pb + 0)) { for (int rep = 0; rep < REP_XN; ++rep) p1a_xn(F, args, layer); } SEAM(pb + 0);
    if (IN(pb + 1)) {
        pg8::Gemm g{(const pg8::bf16_t*)(F.ws + WS_XN), (const pg8::bf16_t*)(F.ws + WS_WIN) + (size_t)layer * NPAD * D, M, NPAD, D};
        pg8::StaticOrder S; S.init(M, NPAD, F.G, (int)blockIdx.x);
        pg8::EpiProj E{(pg8::bf16_t*)(F.ws + WS_PA), (pg8::bf16_t*)(F.ws + WS_PB), (pg8::bf16_t*)(F.ws + WS_PC), QSCALE};
        for (int rep = 0; rep < REP_GEMM1; ++rep) pg8::gemm_phase<pg8::EpiProj, pg8::StaticOrder, true, true>(F.lds + RING_OFF, g, S, E);
    } SEAM(pb + 1);
    if (IN(pb + 2)) {
        for (int rep = 0; rep < REP_PRE; ++rep) for (int tile = F.vcu; tile < M / 64; tile += F.G) rwkv_fused_tile<layer>(F, args, tile);
        for (int rep = 0; rep < REP_SGU; ++rep) for (int nb = F.vcu; nb < M / 128; nb += F.G) sgu_unit_mfma(F, args, layer, nb);
        __syncthreads();
        for (int rep = 0; rep < REP_ATTN; ++rep) for (int u = F.vcu; u < BATCH * CH * 32; u += F.G) attn_unit_mfma(F, args, layer, u);
    } SEAM(pb + 2);
    if (IN(pb + 3)) { for (int rep = 0; rep < REP_SCAN; ++rep) {
#if USE_CHUNKED
            for (int rp = 0; rp < REP_CHAIN; ++rp) if (F.vcu < 192) chunk_chain(F, F.vcu);
#else
            if (F.vcu < 192) rwkv_scan_lds(F, F.vcu);
#endif
        } } SEAM(pb + 3);
    if (IN(pb + 4)) { for (int rep = 0; rep < REP_POST; ++rep) {
#if USE_CHUNKED
        chunk_ypost(F, args, layer);
#else
        rwkv_post_simple(F, args, layer);
#endif
    } } SEAM(pb + 4);
    if (IN(pb + 5)) {
        pg8::Gemm g{(const pg8::bf16_t*)(F.ws + WS_XN), (const pg8::bf16_t*)(F.ws + WS_WOUT) + (size_t)layer * D * D, M, D, D};
        pg8::StaticOrder S; S.init(M, D, F.G, (int)blockIdx.x);
        pg8::EpiRes E{layer ? (const float*)F.out : args.in[0], F.out, mod + 2048, layer, (const float*)(F.ws + WS_ROWSTAT), args.in[24], args.in[25], DN_ALPHA};
        for (int rep = 0; rep < (layer ? 1 : REP_GEMM2); ++rep) pg8::gemm_phase<pg8::EpiRes, pg8::StaticOrder, true, true>(F.lds + RING_OFF, g, S, E);
    } SEAM(pb + 5);
}
__global__ void __launch_bounds__(NTHR, 2) fwd_kernel(Args args) {
    extern __shared__ __attribute__((aligned(16))) unsigned char lds[];
    Frame F;
    F.lds = (LAS unsigned char*)lds;
    F.MISC = (volatile LAS unsigned*)(F.lds + MISC_OFF);
    F.tid = threadIdx.x; F.lane = F.tid & 63; F.wave = __builtin_amdgcn_readfirstlane(F.tid >> 6);
    F.G = gridDim.x; { const int bx = blockIdx.x; F.vcu = (F.G % 8 == 0) ? (bx % 8) * (F.G / 8) + bx / 8 : bx; }
    F.out = args.out; F.ws = args.ws;
    F.ctl = (gu32*)(args.ws + WS_CTL);
    for (int u = F.tid; u < (LDS_BYTES - LDSCTL_OFF) / 4; u += NTHR) ((LAS unsigned*)(F.lds + LDSCTL_OFF))[u] = 0u;
    __syncthreads();
    const int lo = args.ph_lo, hi = args.ph_hi;
    XcdBarrier bar; bar.bar = (unsigned*)(F.ctl + CW_BAR); bar.x = 0; bar.st = nullptr;
    if (hi - lo > 1) bar = xcd_barrier_post((unsigned*)(F.ctl + CW_BAR), F.MISC + 8);

    if (IN(0)) { p0_prologue(F, args); } SEAM(0);
    layer_phases<0>(F, args, lo, hi, bar);
    layer_phases<1>(F, args, lo, hi, bar);
    if (IN(13)) { p4_final(F, args); }
#undef IN
#undef SEAM
}

extern "C" void kernel_launch(void* const* d_in, const int* in_sizes, int n_in, void* d_out, int out_size, void* d_ws, size_t ws_size, hipStream_t stream) {
    static int grid = 0;
    if (grid == 0) {
        if (n_in != 26 || in_sizes[0] != M * D || out_size != M * D || ws_size < WS_END) { fprintf(stderr, "kernel_launch: unexpected shapes: n_in %d in0 %d out %d ws %zu (need %zu)\n", n_in, n_in > 0 ? in_sizes[0] : -1, out_size, ws_size, (size_t)WS_END); grid = -1; return; }
        int dev = 0, cus = 0;
        if (hipGetDevice(&dev) != hipSuccess || hipDeviceGetAttribute(&cus, hipDeviceAttributeMultiprocessorCount, dev) != hipSuccess) { grid = -1; return; }
        if (hipFuncSetAttribute((const void*)fwd_kernel, hipFuncAttributeMaxDynamicSharedMemorySize, LDS_BYTES) != hipSuccess) { fprintf(stderr, "kernel_launch: hipFuncSetAttribute failed\n"); grid = -1; return; }
        int per_cu = 0;
        if (hipOccupancyMaxActiveBlocksPerMultiprocessor(&per_cu, (const void*)fwd_kernel, NTHR, LDS_BYTES) != hipSuccess || per_cu < 1) fprintf(stderr, "kernel_launch: occupancy query says %d\n", per_cu);
        (void)hipGetLastError();
        grid = cus;
        if (grid != 256) fprintf(stderr, "kernel_launch: grid %d != 256\n", grid);
    }
    if (grid < 0) return;
    if (hipMemsetAsync((char*)d_ws + WS_CTL, 0, CTL_ZERO_BYTES, stream) != hipSuccess) return;
    Args a{};
    for (int i = 0; i < 26; ++i) a.in[i] = (const float*)d_in[i];
    a.out = (float*)d_out; a.ws = (unsigned char*)d_ws;
    if (MK_N_LAUNCHES == 1) {
        a.ph_lo = 0; a.ph_hi = 14; a.li = 0;
        hipLaunchKernelGGL(fwd_kernel, dim3(grid), dim3(NTHR), LDS_BYTES, stream, a);
    } else {
        for (int p = 0; p < 14; ++p) { a.ph_lo = p; a.ph_hi = p + 1; a.li = p;
            hipLaunchKernelGGL(fwd_kernel, dim3(grid), dim3(NTHR), LDS_BYTES, stream, a); }
    }
}
```
